# Optimizing an MI355X kernel written in HIP

```python
import math
import functools
import jax
import jax.numpy as jnp
from jax import lax
import numpy as np


D_MODEL = 2048
BATCH = 1
SEQ = 16384
DEPTH = 2

GRID_W = 64
CTX_LEN = 256
NA_DH = 128
NA_W = D_MODEL // 2
NA_H = NA_W // NA_DH
NA_KR = 8
NA_KC = 16
ML_DH = 128
ML_W = D_MODEL // 4
ML_H = ML_W // ML_DH
ML_CHUNK = 64
SSM_P = 64
SSM_W = D_MODEL // 4
SSM_H = SSM_W // SSM_P
SSM_G = 2
SSM_N = 128
SSM_CONV = 4
CONV_PAD_L = SSM_CONV // 2
CONV_PAD_R = SSM_CONV - 1 - CONV_PAD_L
SSM_CHUNK = 128
CONV_CH = SSM_W + 2 * SSM_G * SSM_N
MIX_W = NA_W + ML_W + SSM_W
IN_COLS = 3 * NA_W + 4 * ML_W + 4 * ML_H + SSM_W + CONV_CH + 2 * SSM_H
MOE_GROUPS = 4
MOE_PER_GROUP = 8
N_EXPERTS = MOE_GROUPS * MOE_PER_GROUP
MOE_TOPK = 2
MOE_FF = D_MODEL // 2
MOE_BLOCK = 128
ROPE_THETA = 10000.0
EPS = 1e-6

kernel_name = 'hybrid_na_mlstm_ssd_hmoe_block'

F32 = jnp.float32


def rms_norm(x, w):
    xf = x.astype(F32)
    y = xf * lax.rsqrt(jnp.mean(xf * xf, axis=-1, keepdims=True) + EPS)
    return (y * w.astype(F32)).astype(x.dtype)


def to_chunks(a, size):
    b, t = a.shape[0], a.shape[1]
    return jnp.moveaxis(a.reshape((b, t // size, size) + a.shape[2:]), 1, 0)


def from_chunks(a):
    nc, b, size = a.shape[0], a.shape[1], a.shape[2]
    return jnp.moveaxis(a, 0, 1).reshape((b, nc * size) + a.shape[3:])


def adaln_params(cond, w_mod, b_mod):
    m = jax.nn.silu(cond.astype(F32)) @ w_mod.astype(F32) + b_mod.astype(F32)
    return [p[:, None, :].astype(cond.dtype) for p in jnp.split(m, 6, axis=-1)]


def axial_rope(x, pos_r, pos_c):
    half = x.shape[-1] // 2
    nf = half // 2
    inv = ROPE_THETA ** (-jnp.arange(nf, dtype=F32) / nf)

    def rotate(xp, pos):
        ang = pos.astype(F32)[:, None] * inv
        cos = jnp.cos(ang)[None, :, None, :].astype(x.dtype)
        sin = jnp.sin(ang)[None, :, None, :].astype(x.dtype)
        x1, x2 = xp[..., :nf], xp[..., nf:]
        return jnp.concatenate([x1 * cos - x2 * sin, x1 * sin + x2 * cos], axis=-1)

    return jnp.concatenate([rotate(x[..., :half], pos_r), rotate(x[..., half:], pos_c)], axis=-1)


def softmax_attention(q, k, v):
    s = jnp.einsum('bqhd,bkhd->bhqk', q, k).astype(F32) * q.shape[-1] ** -0.5
    p = jax.nn.softmax(s, axis=-1).astype(v.dtype)
    return jnp.einsum('bhqk,bkhd->bqhd', p, v).reshape(q.shape[0], q.shape[1], -1)


def neighborhood_attention(q, k, v, kc, vc, rpb):
    b, t, nh, dh = q.shape
    rows = t // GRID_W
    kr = min(NA_KR, rows)
    qg, kg, vg = (a.reshape(b, rows, GRID_W, nh, dh) for a in (q, k, v))
    r_idx = jnp.arange(rows)
    row_start = jnp.clip(r_idx - kr // 2, 0, rows - kr)
    c_idx = jnp.arange(GRID_W)
    col_win = jnp.clip(c_idx - NA_KC // 2, 0, GRID_W - NA_KC)[:, None] + jnp.arange(NA_KC)
    col_off = col_win - c_idx[:, None] + NA_KC - 1
    scale = dh ** -0.5
    n_win = kr * NA_KC

    def row_block(args):
        q_row, rs, ri = args
        kw = lax.dynamic_slice_in_dim(kg, rs, kr, axis=1)[:, :, col_win]
        vw = lax.dynamic_slice_in_dim(vg, rs, kr, axis=1)[:, :, col_win]
        row_off = rs + jnp.arange(kr) - ri + NA_KR - 1
        bias = rpb[:, row_off[None, :, None], col_off[:, None, :]].astype(F32)
        s_win = jnp.einsum('bqhd,brqchd->bhqrc', q_row, kw).astype(F32) * scale + bias
        s_ctx = jnp.einsum('bqhd,bkhd->bhqk', q_row, kc).astype(F32) * scale
        s = jnp.concatenate([s_win.reshape(b, nh, GRID_W, n_win), s_ctx], axis=-1)
        p = jax.nn.softmax(s, axis=-1).astype(v.dtype)
        p_win = p[..., :n_win].reshape(b, nh, GRID_W, kr, NA_KC)
        return (jnp.einsum('bhqrc,brqchd->bqhd', p_win, vw)
                + jnp.einsum('bhqk,bkhd->bqhd', p[..., n_win:], vc))

    out = lax.map(row_block, (jnp.moveaxis(qg, 1, 0), row_start, r_idx))
    return jnp.moveaxis(out, 0, 1).reshape(b, t, nh * dh)


def mlstm_chunk_scan(q, k, v, ig, lf, state):
    size = ML_CHUNK
    mask = jnp.tril(jnp.ones((size, size), bool))

    def step(carry, inp):
        cmat, nvec, m = carry
        qc, kc, vc, igc, lfc = inp
        bt = jnp.cumsum(lfc, axis=1).transpose(0, 2, 1)
        it = igc.transpose(0, 2, 1)
        log_d = jnp.where(mask, bt[..., :, None] - bt[..., None, :] + it[..., None, :], -jnp.inf)
        inter = bt + m[..., None]
        m_t = jnp.maximum(jnp.max(log_d, axis=-1), inter)
        wts = jnp.einsum('blhd,bshd->bhls', qc, kc) * jnp.exp(log_d - m_t[..., None])
        sc = jnp.exp(inter - m_t)
        num = (jnp.einsum('bhls,bshd->blhd', wts, vc)
               + jnp.einsum('bhed,blhd->blhe', cmat, qc) * sc.transpose(0, 2, 1)[..., None])
        den = jnp.sum(wts, axis=-1) + jnp.einsum('bhd,blhd->bhl', nvec, qc) * sc
        den = jnp.maximum(jnp.abs(den), jnp.exp(-m_t))
        h = num / den.transpose(0, 2, 1)[..., None]
        b_last = bt[..., -1]
        tail = b_last[..., None] - bt + it
        m_new = jnp.maximum(b_last + m, jnp.max(tail, axis=-1))
        wgt = jnp.exp(tail - m_new[..., None])
        decay = jnp.exp(b_last + m - m_new)
        cmat = decay[..., None, None] * cmat + jnp.einsum('bhs,bshe,bshd->bhed', wgt, vc, kc)
        nvec = decay[..., None] * nvec + jnp.einsum('bhs,bshd->bhd', wgt, kc)
        return (cmat, nvec, m_new), h

    state, hs = lax.scan(step, state, tuple(to_chunks(a, size) for a in (q, k, v, ig, lf)))
    return from_chunks(hs), state


def ssd_chunk_scan(x, dt, bm, cm, state, a):
    size = SSM_CHUNK
    mask = jnp.tril(jnp.ones((size, size), bool))

    def step(s, inp):
        xc, dtc, bc, cc = inp
        la = jnp.cumsum(dtc * a, axis=1).transpose(0, 2, 1)
        decay = jnp.exp(jnp.where(mask, la[..., :, None] - la[..., None, :], -jnp.inf))
        xdt = xc * dtc[..., None]
        g = jnp.einsum('blhn,bshn->bhls', cc, bc) * decay
        y = (jnp.einsum('bhls,bshp->blhp', g, xdt)
             + jnp.einsum('blhn,bhpn->blhp', cc, s) * jnp.exp(la).transpose(0, 2, 1)[..., None])
        tail = jnp.exp(la[..., -1:] - la)
        s = s * jnp.exp(la[..., -1])[..., None, None] + jnp.einsum('bhs,bshn,bshp->bhpn', tail, bc, xdt)
        return s, y

    state, ys = lax.scan(step, state, tuple(to_chunks(t, size) for t in (x, dt, bm, cm)))
    return from_chunks(ys), state


def bidirectional_scan(fwd_fn, bwd_fn, lat_f, lat_b, ctx_f, ctx_b, state0):
    flip = lambda args: tuple(jnp.flip(t, axis=1) for t in args)
    yc_f, s_f = fwd_fn(*ctx_f, state0)
    yc_b, s_b = bwd_fn(*flip(ctx_b), state0)
    y_f, _ = fwd_fn(*lat_f, s_f)
    y_b, _ = bwd_fn(*flip(lat_b), s_b)
    return y_f + jnp.flip(y_b, axis=1), yc_f + jnp.flip(yc_b, axis=1)


def mlstm_mixer(lat, ctx, pos_r, pos_c, gate_b, norm_w, need_ctx):
    def prep(parts, rotary):
        mq, mk, mv, mo, mg = parts
        b, t = mq.shape[0], mq.shape[1]
        q, k, v = (a.astype(F32).reshape(b, t, ML_H, ML_DH) for a in (mq, mk, mv))
        if rotary:
            q = axial_rope(q, pos_r, pos_c)
            k = axial_rope(k, pos_r, pos_c)
        k = k * ML_DH ** -0.5
        g = mg.astype(F32).reshape(b, t, 4, ML_H) + gate_b.astype(F32)
        fwd = (q, k, v, g[:, :, 0], jax.nn.log_sigmoid(g[:, :, 1]))
        bwd = (q, k, v, g[:, :, 2], jax.nn.log_sigmoid(g[:, :, 3]))
        return fwd, bwd, mo

    def finish(hs, mo):
        mu = jnp.mean(hs, axis=-1, keepdims=True)
        var = jnp.mean(jnp.square(hs - mu), axis=-1, keepdims=True)
        hn = ((hs - mu) * lax.rsqrt(var + EPS)).reshape(mo.shape[0], mo.shape[1], ML_W) * norm_w.astype(F32)
        return (jax.nn.sigmoid(mo.astype(F32)) * hn).astype(mo.dtype)

    lat_f, lat_b, mo = prep(lat, True)
    ctx_f, ctx_b, mo_c = prep(ctx, False)
    b = mo.shape[0]
    state0 = (jnp.zeros((b, ML_H, ML_DH, ML_DH), F32), jnp.zeros((b, ML_H, ML_DH), F32), jnp.zeros((b, ML_H), F32))
    hl, hc = bidirectional_scan(mlstm_chunk_scan, mlstm_chunk_scan, lat_f, lat_b, ctx_f, ctx_b, state0)
    return finish(hl, mo), (finish(hc, mo_c) if need_ctx else None)


def depthwise_conv(x, w, bias):
    y = lax.conv_general_dilated(x, w[:, None, :], window_strides=(1,), padding=[(CONV_PAD_L, CONV_PAD_R)],
                                 dimension_numbers=('NWC', 'WIO', 'NWC'), feature_group_count=x.shape[-1])
    return y + bias


def ssd_mixer(lat, ctx, conv_w, conv_b, dt_bias, a_log, d_skip, norm_w, need_ctx):
    def prep(parts):
        z, xbc, dtr = parts
        b, t = z.shape[0], z.shape[1]
        xbc = jax.nn.silu(depthwise_conv(xbc, conv_w, conv_b)).astype(F32)
        xs, bm, cm = jnp.split(xbc, [SSM_W, SSM_W + SSM_G * SSM_N], axis=-1)
        xs = xs.reshape(b, t, SSM_H, SSM_P)
        expand = lambda m: jnp.repeat(m.reshape(b, t, SSM_G, SSM_N), SSM_H // SSM_G, axis=2)
        bm, cm = expand(bm), expand(cm)
        dt = jax.nn.softplus(dtr.astype(F32).reshape(b, t, 2, SSM_H) + dt_bias.astype(F32))
        return (xs, dt[:, :, 0], bm, cm), (xs, dt[:, :, 1], bm, cm), z, xs

    def finish(y, xs, z):
        b, t = z.shape[0], z.shape[1]
        y = (y + d_skip.astype(F32)[:, None] * xs).reshape(b, t, SSM_W) * jax.nn.silu(z.astype(F32))
        yg = y.reshape(b, t, SSM_G, SSM_W // SSM_G)
        yg = yg * lax.rsqrt(jnp.mean(yg * yg, axis=-1, keepdims=True) + EPS)
        return (yg.reshape(b, t, SSM_W) * norm_w.astype(F32)).astype(z.dtype)

    lat_f, lat_b, z, xs = prep(lat)
    ctx_f, ctx_b, z_c, xs_c = prep(ctx)
    a = -jnp.exp(a_log.astype(F32))
    fwd = functools.partial(ssd_chunk_scan, a=a[0])
    bwd = functools.partial(ssd_chunk_scan, a=a[1])
    state0 = jnp.zeros((z.shape[0], SSM_H, SSM_P, SSM_N), F32)
    y, yc = bidirectional_scan(fwd, bwd, lat_f, lat_b, ctx_f, ctx_b, state0)
    return finish(y, xs, z), (finish(yc, xs_c, z_c) if need_ctx else None)


def hybrid_mixer(h, hc, w_in, w_out, na_rpb, ml_gate_b, ml_norm_w, conv_w, conv_b, dt_bias, a_log, d_skip,
                 ssm_norm_w, need_ctx):
    b, t, _ = h.shape
    t_idx = jnp.arange(t)
    pos_r, pos_c = t_idx // GRID_W, t_idx % GRID_W
    sizes = (NA_W, NA_W, NA_W, ML_W, ML_W, ML_W, ML_W, 4 * ML_H, SSM_W, CONV_CH, 2 * SSM_H)
    cuts = [int(s) for s in np.cumsum(sizes)[:-1]]
    lat = jnp.split(h @ w_in, cuts, axis=-1)
    ctx = jnp.split(hc @ w_in, cuts, axis=-1)
    heads = lambda a: a.reshape(a.shape[0], a.shape[1], NA_H, NA_DH)
    q, k, v = (heads(a) for a in lat[0:3])
    qc, kc, vc = (heads(a) for a in ctx[0:3])
    o_na = neighborhood_attention(q, k, v, kc, vc, na_rpb)
    o_ml, o_ml_c = mlstm_mixer(lat[3:8], ctx[3:8], pos_r, pos_c, ml_gate_b, ml_norm_w, need_ctx)
    o_ss, o_ss_c = ssd_mixer(lat[8:11], ctx[8:11], conv_w, conv_b, dt_bias, a_log, d_skip, ssm_norm_w, need_ctx)
    y = jnp.concatenate([o_na, o_ml, o_ss], axis=-1) @ w_out
    if not need_ctx:
        return y, None
    o_na_c = softmax_attention(qc, kc, vc)
    yc = jnp.concatenate([o_na_c, o_ml_c, o_ss_c], axis=-1) @ w_out
    return y, yc


def hier_moe(tokens, wg, bg, we, be, w1, w3, w2):
    n, d = tokens.shape
    tf = tokens.astype(F32)
    pg = jax.nn.softmax(tf @ wg.astype(F32) + bg.astype(F32), axis=-1)
    g_sel = jnp.argmax(pg, axis=-1)
    g_w = jnp.max(pg, axis=-1)
    le = (tf @ we.astype(F32) + be.astype(F32)).reshape(n, MOE_GROUPS, MOE_PER_GROUP)
    le_g = jnp.take_along_axis(le, g_sel[:, None, None], axis=1)[:, 0]
    top_v, top_i = lax.top_k(le_g, MOE_TOPK)
    w = jax.nn.softmax(top_v, axis=-1) * g_w[:, None]
    e = g_sel[:, None] * MOE_PER_GROUP + top_i
    n_assign = n * MOE_TOPK
    e_flat, w_flat = e.reshape(-1), w.reshape(-1)
    tok_flat = jnp.repeat(jnp.arange(n), MOE_TOPK)
    order = jnp.argsort(e_flat)
    e_s, tok_s, w_s = e_flat[order], tok_flat[order], w_flat[order]
    counts = jnp.bincount(e_flat, length=N_EXPERTS)
    starts = jnp.cumsum(counts) - counts
    padded = (counts + MOE_BLOCK - 1) // MOE_BLOCK * MOE_BLOCK
    pends = jnp.cumsum(padded)
    pstarts = pends - padded
    dest = pstarts[e_s] + jnp.arange(n_assign) - starts[e_s]
    n_blocks = -(-n_assign // MOE_BLOCK) + N_EXPERTS
    n_slots = n_blocks * MOE_BLOCK
    slot_tok = jnp.full((n_slots,), n, jnp.int32).at[dest].set(tok_s)
    slot_w = jnp.zeros((n_slots,), F32).at[dest].set(w_s)
    block_e = jnp.minimum(jnp.searchsorted(pends, jnp.arange(n_blocks) * MOE_BLOCK, side='right'), N_EXPERTS - 1)
    x_pad = jnp.concatenate([tokens, jnp.zeros((1, d), tokens.dtype)], axis=0)
    xb = x_pad[slot_tok].reshape(n_blocks, MOE_BLOCK, d)

    def expert_block(args):
        xblk, eid = args
        hid = jax.nn.silu(xblk @ w1[eid]) * (xblk @ w3[eid])
        return hid @ w2[eid]

    yb = lax.map(expert_block, (xb, block_e)).reshape(n_slots, d)
    out = jnp.zeros((n + 1, d), tokens.dtype).at[slot_tok].add(yb * slot_w[:, None].astype(yb.dtype))
    return out[:n]


def setup_inputs(seed: int = 0) -> dict:
    key = jax.random.key(seed)
    ks = iter(jax.random.split(key, 40))
    nrm = lambda shape, s: jax.random.normal(next(ks), shape, F32) * s
    x = nrm((BATCH, SEQ, D_MODEL), 1.0)
    c = nrm((BATCH, D_MODEL), 1.0)
    ctx = nrm((BATCH, CTX_LEN, D_MODEL), 1.0)
    c_ctx = nrm((D_MODEL,), 1.0)
    w_mod = nrm((DEPTH, D_MODEL, 6 * D_MODEL), 0.5 * D_MODEL ** -0.5)
    b_mod = nrm((DEPTH, 6 * D_MODEL), 0.01)
    norm1_w = 1.0 + nrm((DEPTH, D_MODEL), 0.02)
    norm2_w = 1.0 + nrm((DEPTH, D_MODEL), 0.02)
    w_in = nrm((DEPTH, D_MODEL, IN_COLS), D_MODEL ** -0.5)
    w_out = nrm((DEPTH, MIX_W, D_MODEL), MIX_W ** -0.5)
    na_rpb = nrm((DEPTH, NA_H, 2 * NA_KR - 1, 2 * NA_KC - 1), 0.1)
    i_b = nrm((DEPTH, 2, ML_H), 0.1)
    f_b = 3.0 + 3.0 * jax.random.uniform(next(ks), (DEPTH, 2, ML_H), F32)
    ml_gate_b = jnp.stack([i_b[:, 0], f_b[:, 0], i_b[:, 1], f_b[:, 1]], axis=1)
    ml_norm_w = 1.0 + nrm((DEPTH, ML_W), 0.02)
    ssm_conv_w = nrm((DEPTH, SSM_CONV, CONV_CH), SSM_CONV ** -0.5)
    ssm_conv_b = nrm((DEPTH, CONV_CH), 0.01)
    dt0 = jnp.exp(jax.random.uniform(next(ks), (DEPTH, 2, SSM_H), F32, minval=math.log(1e-3), maxval=math.log(1e-1)))
    ssm_dt_bias = dt0 + jnp.log(-jnp.expm1(-dt0))
    ssm_a_log = jnp.log(jax.random.uniform(next(ks), (DEPTH, 2, SSM_H), F32, minval=1.0, maxval=16.0))
    ssm_d = 1.0 + nrm((DEPTH, SSM_H), 0.1)
    ssm_norm_w = 1.0 + nrm((DEPTH, SSM_W), 0.02)
    router_g_w = nrm((DEPTH, D_MODEL, MOE_GROUPS), D_MODEL ** -0.5)
    router_g_b = nrm((DEPTH, MOE_GROUPS), 0.01)
    router_e_w = nrm((DEPTH, D_MODEL, N_EXPERTS), D_MODEL ** -0.5)
    router_e_b = nrm((DEPTH, N_EXPERTS), 0.01)
    moe_w1 = nrm((DEPTH, N_EXPERTS, D_MODEL, MOE_FF), D_MODEL ** -0.5)
    moe_w3 = nrm((DEPTH, N_EXPERTS, D_MODEL, MOE_FF), D_MODEL ** -0.5)
    moe_w2 = nrm((DEPTH, N_EXPERTS, MOE_FF, D_MODEL), MOE_FF ** -0.5)
    final_norm_w = 1.0 + nrm((D_MODEL,), 0.02)
    return {'x': x, 'c': c, 'ctx': ctx, 'c_ctx': c_ctx, 'w_mod': w_mod, 'b_mod': b_mod,
            'norm1_w': norm1_w, 'norm2_w': norm2_w, 'w_in': w_in, 'w_out': w_out, 'na_rpb': na_rpb,
            'ml_gate_b': ml_gate_b, 'ml_norm_w': ml_norm_w, 'ssm_conv_w': ssm_conv_w, 'ssm_conv_b': ssm_conv_b,
            'ssm_dt_bias': ssm_dt_bias, 'ssm_a_log': ssm_a_log, 'ssm_d': ssm_d, 'ssm_norm_w': ssm_norm_w,
            'router_g_w': router_g_w, 'router_g_b': router_g_b, 'router_e_w': router_e_w,
            'router_e_b': router_e_b, 'moe_w1': moe_w1, 'moe_w3': moe_w3, 'moe_w2': moe_w2,
            'final_norm_w': final_norm_w}


def reference(x, c, ctx, c_ctx, w_mod, b_mod, norm1_w, norm2_w, w_in, w_out, na_rpb, ml_gate_b, ml_norm_w,
              ssm_conv_w, ssm_conv_b, ssm_dt_bias, ssm_a_log, ssm_d, ssm_norm_w, router_g_w, router_g_b,
              router_e_w, router_e_b, moe_w1, moe_w3, moe_w2, final_norm_w):
    for l in range(DEPTH):
        last = l == DEPTH - 1
        sh1, sc1, g1, sh2, sc2, g2 = adaln_params(c, w_mod[l], b_mod[l])
        csh1, csc1, cg1, csh2, csc2, cg2 = adaln_params(c_ctx[None], w_mod[l], b_mod[l])
        h = rms_norm(x, norm1_w[l]) * (1 + sc1) + sh1
        hc = rms_norm(ctx, norm1_w[l]) * (1 + csc1) + csh1
        y, yc = hybrid_mixer(h, hc, w_in[l], w_out[l], na_rpb[l], ml_gate_b[l], ml_norm_w[l], ssm_conv_w[l],
                             ssm_conv_b[l], ssm_dt_bias[l], ssm_a_log[l], ssm_d[l], ssm_norm_w[l], not last)
        x = x + g1 * y
        h2 = rms_norm(x, norm2_w[l]) * (1 + sc2) + sh2
        moe_args = (router_g_w[l], router_g_b[l], router_e_w[l], router_e_b[l], moe_w1[l], moe_w3[l], moe_w2[l])
        if last:
            x = x + g2 * hier_moe(h2.reshape(-1, D_MODEL), *moe_args).reshape(x.shape)
        else:
            ctx = ctx + cg1 * yc
            h2c = rms_norm(ctx, norm2_w[l]) * (1 + csc2) + csh2
            n_lat = x.shape[0] * x.shape[1]
            out = hier_moe(jnp.concatenate([h2.reshape(-1, D_MODEL), h2c.reshape(-1, D_MODEL)], axis=0), *moe_args)
            x = x + g2 * out[:n_lat].reshape(x.shape)
            ctx = ctx + cg2 * out[n_lat:].reshape(ctx.shape)
    return rms_norm(x, final_norm_w)
```

```cpp
#include <hip/hip_runtime.h>
#include <stdint.h>
#include <stdio.h>

#define LAS __attribute__((address_space(3)))
#define DI __device__ __forceinline__
typedef unsigned short bf16_t;
typedef short bf16x8 __attribute__((ext_vector_type(8)));
typedef short bf16x4 __attribute__((ext_vector_type(4)));
typedef float f32x4 __attribute__((ext_vector_type(4)));
typedef float f32x2 __attribute__((ext_vector_type(2)));
typedef unsigned u32x4 __attribute__((ext_vector_type(4)));
typedef unsigned u32x2 __attribute__((ext_vector_type(2)));
typedef __bf16 bfv2 __attribute__((ext_vector_type(2)));

constexpr int D = 2048, T = 16384, CTXL = 256, NT = T + CTXL;
constexpr int INC = 6688, NPROJ = 6656, NPAD = 6912;
constexpr int QO = 0, KO = 1024, VO = 2048, MQO = 3072, MKO = 3584, MVO = 4096, MOO = 4608, ZO = 5120, XBO = 5632;
constexpr int NCH = 260;
constexpr int NEXP = 32, FF = 1024;
constexpr int MAXMT = 162, NSLOT = MAXMT * 256;
constexpr int NTHR = 512;
constexpr int LDS_BYTES = 155648;
constexpr int LDS_MISC = LDS_BYTES - 256;

constexpr size_t al256(size_t x) { return (x + 255) & ~(size_t)255; }
constexpr size_t WS_BAR   = 0;
constexpr size_t WS_MODP  = 65536;
constexpr size_t WS_MOD   = WS_MODP  + al256((size_t)2 * 4 * 2 * 12288 * 4);
constexpr size_t WS_ROPE  = WS_MOD   + al256((size_t)2 * 2 * 12288 * 4);
constexpr size_t WS_TOKE  = WS_ROPE  + al256((size_t)(256 + 64) * 32 * 2 * 4);
constexpr size_t WS_TOKW  = WS_TOKE  + al256((size_t)NT * 2 * 4);
constexpr size_t WS_TOKR  = WS_TOKW  + al256((size_t)NT * 2 * 4);
constexpr size_t WS_TOKS  = WS_TOKR  + al256((size_t)NT * 2 * 4);
constexpr size_t WS_CNT   = WS_TOKS  + al256((size_t)NT * 2 * 4);
constexpr size_t WS_MTE   = WS_CNT   + al256((size_t)256 * 32 * 4);
constexpr size_t WS_SLOTW = WS_MTE   + al256((size_t)(MAXMT + 2) * 4);
constexpr size_t WS_GATES = WS_SLOTW + al256((size_t)NSLOT * 4);
constexpr size_t WS_MLG   = WS_GATES + al256((size_t)NT * 32 * 4);
constexpr size_t WS_DT    = WS_MLG   + al256((size_t)NT * 16 * 4);
constexpr size_t WS_DECML = WS_DT    + al256((size_t)NT * 16 * 4);
constexpr size_t WS_DECSS = WS_DECML + al256((size_t)8 * NCH * 4);
constexpr size_t WS_WIN   = WS_DECSS + al256((size_t)16 * NCH * 4);
constexpr size_t WS_WOUT  = WS_WIN   + (size_t)2 * NPAD * D * 2;
constexpr size_t WS_W13   = WS_WOUT  + (size_t)2 * D * D * 2;
constexpr size_t WS_W2    = WS_W13   + (size_t)2 * NEXP * 2048 * D * 2;
constexpr size_t WS_H     = WS_W2    + (size_t)2 * NEXP * D * FF * 2;
constexpr size_t WS_XBUF  = WS_H     + (size_t)NT * D * 2;
constexpr size_t WS_PROJ  = WS_XBUF  + (size_t)NT * D * 4;
constexpr size_t WS_XBCC  = WS_PROJ  + (size_t)NT * NPROJ * 2;
constexpr size_t WS_MIX   = WS_XBCC  + (size_t)NT * 1024 * 2;
constexpr size_t WS_STML  = WS_MIX   + (size_t)NT * D * 2;
constexpr size_t WS_STSS  = WS_STML  + (size_t)8 * NCH * 16512 * 4;
constexpr size_t WS_END   = WS_STSS  + (size_t)16 * NCH * 8192 * 4;
constexpr size_t WS_AMOE  = WS_PROJ;
constexpr size_t WS_HID   = WS_AMOE + (size_t)NSLOT * D * 2;
constexpr size_t WS_YMOE  = WS_MIX;
static_assert(WS_HID + (size_t)NSLOT * FF * 2 <= WS_MIX, "moe alias 1");
static_assert(WS_YMOE + (size_t)NSLOT * D * 2 <= WS_STSS, "moe alias 2");

struct Params {
    const float *x, *c, *ctx, *c_ctx, *w_mod, *b_mod, *norm1_w, *norm2_w, *w_in, *w_out, *na_rpb, *ml_gate_b, *ml_norm_w,
                *conv_w, *conv_b, *dt_bias, *a_log, *ssm_d, *ssm_norm_w, *rg_w, *rg_b, *re_w, *re_b, *w1, *w3, *w2, *final_w;
    float* out; unsigned char* ws; int ph_lo, ph_hi;
};

DI unsigned pk2(float lo, float hi) { f32x2 v = {lo, hi}; bfv2 b = __builtin_convertvector(v, bfv2); return __builtin_bit_cast(unsigned, b); }
DI float bflo(unsigned u) { return __uint_as_float(u << 16); }
DI float bfhi(unsigned u) { return __uint_as_float(u & 0xffff0000u); }
DI float bf2f(bf16_t b) { return __uint_as_float(((unsigned)b) << 16); }
DI bf16_t f2bf(float f) { return (bf16_t)(pk2(f, 0.f) & 0xffffu); }
DI float wsum(float v) { v += __shfl_xor(v, 32); v += __shfl_xor(v, 16); v += __shfl_xor(v, 8); v += __shfl_xor(v, 4); v += __shfl_xor(v, 2); v += __shfl_xor(v, 1); return v; }
DI float gsum4(float v) { v += __shfl_xor(v, 16); v += __shfl_xor(v, 32); return v; }
DI f32x4 mfma16(bf16x8 a, bf16x8 b, f32x4 c) { return __builtin_amdgcn_mfma_f32_16x16x32_bf16(a, b, c, 0, 0, 0); }
DI float siluf(float v) { return v / (1.0f + __expf(-v)); }
DI float sigmf(float v) { return 1.0f / (1.0f + __expf(-v)); }
DI bf16x8 pack8(const float (&v)[8]) { u32x4 p; p.x = pk2(v[0], v[1]); p.y = pk2(v[2], v[3]); p.z = pk2(v[4], v[5]); p.w = pk2(v[6], v[7]); return __builtin_bit_cast(bf16x8, p); }
DI void unpack8(u32x4 u, float (&v)[8]) { v[0] = bflo(u.x); v[1] = bfhi(u.x); v[2] = bflo(u.y); v[3] = bfhi(u.y); v[4] = bflo(u.z); v[5] = bfhi(u.z); v[6] = bflo(u.w); v[7] = bfhi(u.w); }
DI bf16x8 frag_row(LAS unsigned char* L, unsigned tb, unsigned pb, int r0, int k0, int lane) {
    return *(LAS bf16x8*)(L + tb + (unsigned)(r0 + (lane & 15)) * pb + (unsigned)(k0 + 8 * (lane >> 4)) * 2u);
}
DI bf16x8 frag_tr(unsigned lbase, unsigned tb, unsigned pb, int rA, int rB, int c0, int lane) {
    const int q = (lane & 15) >> 2, pq = lane & 3;
    const unsigned a0 = lbase + tb + (unsigned)(rA + q) * pb + (unsigned)(c0 + 4 * pq) * 2u;
    const unsigned a1 = lbase + tb + (unsigned)(rB + q) * pb + (unsigned)(c0 + 4 * pq) * 2u;
    bf16x4 lo, hi;
    asm volatile("ds_read_b64_tr_b16 %0, %2\n\tds_read_b64_tr_b16 %1, %3\n\ts_waitcnt lgkmcnt(0)" : "=&v"(lo), "=&v"(hi) : "v"(a0), "v"(a1) : "memory");
    bf16x8 r; r[0] = lo[0]; r[1] = lo[1]; r[2] = lo[2]; r[3] = lo[3]; r[4] = hi[0]; r[5] = hi[1]; r[6] = hi[2]; r[7] = hi[3]; return r;
}
DI float wscan(float v, int rev, int lane) {
#pragma unroll
    for (int off = 1; off < 64; off <<= 1) {
        const float t = rev ? __shfl_down(v, off) : __shfl_up(v, off);
        const bool ok = rev ? (lane + off < 64) : (lane >= off);
        v += ok ? t : 0.f;
    }
    return v;
}

namespace pg8 {
#define PG8_LAS __attribute__((address_space(3)))
typedef unsigned short bf16_t;
typedef short bf16x8 __attribute__((ext_vector_type(8)));
typedef float f32x4 __attribute__((ext_vector_type(4)));
typedef unsigned u32x4 __attribute__((ext_vector_type(4)));
constexpr int BM = 256, BK = 64, HALF = 128, HTB = HALF * BK * 2, STAGE_BYTES = 8 * HTB, NXCD = 8, WGM = 8;
__host__ __device__ __forceinline__ int lds_byte(int r, int c) { const int st = (r >> 4) * 2 + (c >> 5), rr = r & 15, cc = c & 31, ob = rr * 64 + cc * 2; return st * 1024 + (ob ^ (((ob >> 9) & 1) << 5)); }
__host__ __device__ __forceinline__ void stage_rc(int b, int& R, int& C) { const int st = b / 1024, sb = b % 1024, swz = sb ^ (((sb >> 9) & 1) << 5); R = (st >> 1) * 16 + swz / 64; C = (st & 1) * 32 + (swz % 64) / 2; }
__host__ __device__ __forceinline__ int perm32(int rho) { const int n = rho >> 4, i = rho & 15; return 8 * (i >> 2) + 4 * n + (i & 3); }
struct Unit { int pm, pn; };
struct Gemm { const bf16_t* A; const bf16_t* Bt; int M, N, K; };
struct StaticOrder {
    int nM, nN, nwg, G, c;
    __host__ __device__ void init(int M, int N, int G_, int c_) { nM = M / BM; nN = N / BM; nwg = nM * nN; G = G_; c = c_; }
    __host__ __device__ bool next(int i, Unit& u) const {
        const long L = (long)i * G + c; if (L >= nwg) return false;
        int wgid = (int)L; { const int q = nwg / NXCD, r = nwg % NXCD, xcd = wgid % NXCD, off = wgid / NXCD; wgid = (xcd < r ? xcd * (q + 1) : r * (q + 1) + (xcd - r) * q) + off; }
        const int nig = WGM * nN, gid = wgid / nig, fm = gid * WGM, gsz = (nM - fm) < WGM ? (nM - fm) : WGM;
        u.pm = fm + ((wgid % nig) % gsz); u.pn = (wgid % nig) / gsz; return true;
    }
    __device__ __forceinline__ void a_ready(const Unit&) const {}
    __device__ __forceinline__ void done(const Unit&) const {}
};
struct MoeOrder {
    const int* mte; int nunits, G, c;
    __device__ bool next(int i, Unit& u) const { const int L = i * G + c; if (L >= nunits) return false; const int mt = L >> 3; u.pm = mt; u.pn = mte[mt] * 8 + (L & 7); return true; }
    __device__ __forceinline__ void a_ready(const Unit&) const {}
    __device__ __forceinline__ void done(const Unit&) const {}
};
DI unsigned pk2(float lo, float hi) { return ::pk2(lo, hi); }

struct EpiProj {
    static constexpr bool PERM = true, AFTER_DRAIN = false;
    bf16_t* O; float* gates;
    __device__ __forceinline__ void operator()(const f32x4 (&acc)[2][2][4][2], const Unit& u, int wr, int wc, int fr, int fq) const {
        const int row0 = u.pm * BM + wr * 64 + fr;
        if (u.pn < 26) {
            const int col0 = u.pn * BM + wc * 32 + 8 * fq;
#pragma unroll
            for (int ai = 0; ai < 2; ++ai)
#pragma unroll
                for (int m = 0; m < 4; ++m) { bf16_t* rowp = O + (size_t)(row0 + ai * HALF + m * 16) * 6656 + col0;
#pragma unroll
                    for (int bj = 0; bj < 2; ++bj) { const f32x4 v0 = acc[ai][bj][m][0], v1 = acc[ai][bj][m][1];
                        u32x4 w; w.x = pk2(v0[0], v0[1]); w.y = pk2(v0[2], v0[3]); w.z = pk2(v1[0], v1[1]); w.w = pk2(v1[2], v1[3]);
                        *(u32x4*)(rowp + bj * HALF) = w; } }
        } else if (wc == 0) {
#pragma unroll
            for (int ai = 0; ai < 2; ++ai)
#pragma unroll
                for (int m = 0; m < 4; ++m) { float* rowp = gates + (size_t)(row0 + ai * HALF + m * 16) * 32 + 8 * fq;
                    *(f32x4*)(rowp) = acc[ai][0][m][0]; *(f32x4*)(rowp + 4) = acc[ai][0][m][1]; }
        }
    }
};
struct EpiRes {
    static constexpr bool PERM = false, AFTER_DRAIN = false;
    const float* base_lat; const float* base_ctx; float* out; const float* g_lat; const float* g_ctx;
    __device__ __forceinline__ void operator()(const f32x4 (&acc)[2][2][4][2], const Unit& u, int wr, int wc, int fr, int fq) const {
        const bool isctx = u.pm >= 64;
        const float* base = isctx ? base_ctx - (size_t)16384 * 2048 : base_lat; const float* gv = isctx ? g_ctx : g_lat;
        const int row0 = u.pm * BM + wr * 64 + fr, col0 = u.pn * BM + wc * 32 + 4 * fq;
        f32x4 gg[2][2];
#pragma unroll
        for (int bj = 0; bj < 2; ++bj)
#pragma unroll
            for (int n = 0; n < 2; ++n) gg[bj][n] = *(const f32x4*)(gv + col0 + bj * HALF + n * 16);
#pragma unroll
        for (int ai = 0; ai < 2; ++ai)
#pragma unroll
            for (int m = 0; m < 4; ++m) { const size_t off = (size_t)(row0 + ai * HALF + m * 16) * 2048 + col0;
#pragma unroll
                for (int bj = 0; bj < 2; ++bj)
#pragma unroll
                    for (int n = 0; n < 2; ++n) { const f32x4 b = *(const f32x4*)(base + off + bj * HALF + n * 16);
                        *(f32x4*)(out + off + bj * HALF + n * 16) = b + gg[bj][n] * acc[ai][bj][m][n]; } }
    }
};
struct EpiGateUp {
    static constexpr bool PERM = true, AFTER_DRAIN = false;
    bf16_t* O;
    __device__ __forceinline__ void operator()(const f32x4 (&acc)[2][2][4][2], const Unit& u, int wr, int wc, int fr, int fq) const {
        const int row0 = u.pm * BM + wr * 64 + fr, col0 = (u.pn & 7) * 128 + wc * 32 + 8 * fq;
#pragma unroll
        for (int ai = 0; ai < 2; ++ai)
#pragma unroll
            for (int m = 0; m < 4; ++m) { float h[8];
#pragma unroll
                for (int n = 0; n < 2; ++n)
#pragma unroll
                    for (int j = 0; j < 4; ++j) { const float gt = acc[ai][0][m][n][j], up = acc[ai][1][m][n][j]; h[n * 4 + j] = gt / (1.0f + __expf(-gt)) * up; }
                u32x4 w; w.x = pk2(h[0], h[1]); w.y = pk2(h[2], h[3]); w.z = pk2(h[4], h[5]); w.w = pk2(h[6], h[7]);
                *(u32x4*)(O + (size_t)(row0 + ai * HALF + m * 16) * 1024 + col0) = w; }
    }
};
struct EpiDown {
    static constexpr bool PERM = true, AFTER_DRAIN = false;
    bf16_t* O; const float* sw;
    __device__ __forceinline__ void operator()(const f32x4 (&acc)[2][2][4][2], const Unit& u, int wr, int wc, int fr, int fq) const {
        const int row0 = u.pm * BM + wr * 64 + fr, col0 = (u.pn & 7) * BM + wc * 32 + 8 * fq;
#pragma unroll
        for (int ai = 0; ai < 2; ++ai)
#pragma unroll
            for (int m = 0; m < 4; ++m) { const int row = row0 + ai * HALF + m * 16; const float s = sw[row]; bf16_t* rowp = O + (size_t)row * 2048 + col0;
#pragma unroll
                for (int bj = 0; bj < 2; ++bj) { const f32x4 v0 = acc[ai][bj][m][0] * s, v1 = acc[ai][bj][m][1] * s;
                    u32x4 w; w.x = pk2(v0[0], v0[1]); w.y = pk2(v0[2], v0[3]); w.z = pk2(v1[0], v1[1]); w.w = pk2(v1[2], v1[3]);
                    *(u32x4*)(rowp + bj * HALF) = w; } }
    }
};

template <class Epi, class Sched, bool STAMP = false>
__device__ __forceinline__ void gemm_phase(PG8_LAS unsigned char* lds, const Gemm g, const Sched& S, const Epi& E, unsigned long long* stamps) {
    int tid_ = threadIdx.x; asm volatile("" : "+v"(tid_)); const int tid = tid_, wid = __builtin_amdgcn_readfirstlane(tid >> 6), lane = tid & 63, wr = wid >> 2, wc = wid & 3, fr = lane & 15, fq = lane >> 4;
    const int K = g.K, nt = K / BK;
    int ts_lo = 0, ts_hi = 0, nts = 0; const unsigned long long rt_entry = STAMP ? (unsigned long long)wall_clock64() : 0ull;
#define PG8_STAMP() do { if (STAMP && wid == 0 && nts < 64) { const unsigned long long _c = (unsigned long long)clock64(); \
        ts_lo = (lane == nts) ? (int)(unsigned)_c : ts_lo; ts_hi = (lane == nts) ? (int)(unsigned)(_c >> 32) : ts_hi; ++nts; } } while (0)
    PG8_STAMP();
    unsigned voffA[2], voffB[2];
#pragma unroll
    for (int i = 0; i < 2; ++i) { int R, C; stage_rc(tid * 16 + i * 8192, R, C); const int Rb = Epi::PERM ? ((R & ~31) + perm32(R & 31)) : R;
        voffA[i] = (unsigned)(R * K + C) * 2u; voffB[i] = (unsigned)(Rb * K + C) * 2u; }
    const size_t kstep = (size_t)(BK * 2);
    const size_t hstep = (size_t)HALF * K * 2;
    const size_t tstep = 2 * hstep;
    const unsigned ldsw = (unsigned)wid * 1024u;
    const int aoff = lds_byte(wr * 64 + fr, fq * 8), boff = lds_byte(wc * 32 + fr, fq * 8);
#define PG8_SA(b, h) (((b) * 2 + (h)) * HTB)
#define PG8_SB(b, h) ((4 + (b) * 2 + (h)) * HTB)
#define PG8_STAGE(bufoff, gbase, voff) do { _Pragma("unroll") for (int _i = 0; _i < 2; ++_i) \
        __builtin_amdgcn_global_load_lds((const unsigned*)((const char*)(gbase) + (voff)[_i]), (PG8_LAS unsigned*)(lds + (bufoff) + ldsw + _i * 8192), 16, 0, 0); } while (0)
#define PG8_LDA(dst, b, h) do { _Pragma("unroll") for (int m = 0; m < 4; ++m) _Pragma("unroll") for (int k = 0; k < 2; ++k) dst[m][k] = *(const PG8_LAS bf16x8*)(lds + PG8_SA(b, h) + aoff + m * 2048 + k * 1024); } while (0)
#define PG8_LDB(dst, b, h) do { _Pragma("unroll") for (int n = 0; n < 2; ++n) _Pragma("unroll") for (int k = 0; k < 2; ++k) dst[n][k] = *(const PG8_LAS bf16x8*)(lds + PG8_SB(b, h) + boff + n * 2048 + k * 1024); } while (0)
#define PG8_MMA(ai, bj, At, Bt) do { __builtin_amdgcn_s_setprio(1); _Pragma("unroll") for (int m = 0; m < 4; ++m) _Pragma("unroll") for (int n = 0; n < 2; ++n) _Pragma("unroll") for (int k = 0; k < 2; ++k) \
        acc[ai][bj][m][n] = __builtin_amdgcn_mfma_f32_16x16x32_bf16(Bt[n][k], At[m][k], acc[ai][bj][m][n], 0, 0, 0); __builtin_amdgcn_s_setprio(0); } while (0)
#define PG8_WAIT_V(n) asm volatile("s_waitcnt vmcnt(" #n ")" ::: "memory")
#define PG8_WAIT_L(n) asm volatile("s_waitcnt lgkmcnt(" #n ")" ::: "memory")
#define PG8_BAR __builtin_amdgcn_s_barrier()
#define PG8_SCHED __builtin_amdgcn_sched_barrier(0)
    Unit cur, nxt; int ui = 0;
    if (!S.next(0, cur)) return;
    f32x4 acc[2][2][4][2];
#pragma unroll
    for (int a = 0; a < 2; ++a)
#pragma unroll
        for (int b = 0; b < 2; ++b)
#pragma unroll
            for (int m = 0; m < 4; ++m)
#pragma unroll
                for (int n = 0; n < 2; ++n) acc[a][b][m][n] = (f32x4){0.f, 0.f, 0.f, 0.f};
    bf16x8 At[4][2], B0[2][2], B1[2][2];
    const char* cA = (const char*)g.A + (size_t)cur.pm * tstep; const char* cB = (const char*)g.Bt + (size_t)cur.pn * tstep;
    S.a_ready(cur);
    PG8_STAGE(PG8_SB(0, 0), cB, voffB); PG8_STAGE(PG8_SA(0, 0), cA, voffA); PG8_STAGE(PG8_SB(0, 1), cB + hstep, voffB); PG8_STAGE(PG8_SA(0, 1), cA + hstep, voffA);
    if (wr == 1) PG8_BAR;
    PG8_WAIT_V(4); PG8_BAR;
    PG8_STAGE(PG8_SB(1, 0), cB + kstep, voffB); PG8_STAGE(PG8_SA(1, 0), cA + kstep, voffA); PG8_STAGE(PG8_SB(1, 1), cB + hstep + kstep, voffB);
    PG8_WAIT_V(6); PG8_BAR;
    PG8_STAMP();
    for (;;) {
        const bool has_next = S.next(ui + 1, nxt);
        const char* nA = has_next ? (const char*)g.A + (size_t)nxt.pm * tstep : cA; const char* nB = has_next ? (const char*)g.Bt + (size_t)nxt.pn * tstep : cB;
        for (int t = 0; t < nt; t += 2) {
            const bool last = (t == nt - 2);
            const char* a1 = cA + (size_t)(t + 1) * kstep;
            const char* a2 = last ? nA : cA + (size_t)(t + 2) * kstep; const char* b2 = last ? nB : cB + (size_t)(t + 2) * kstep;
            const char* a3 = a2 + kstep; const char* b3 = b2 + kstep;
            if (last && has_next) S.a_ready(nxt);
            PG8_LDB(B0, 0, 0); PG8_SCHED; PG8_LDA(At, 0, 0); PG8_STAGE(PG8_SA(1, 1), a1 + hstep, voffA);
            PG8_WAIT_L(8); PG8_BAR; PG8_WAIT_L(0); PG8_MMA(0, 0, At, B0); PG8_BAR; PG8_SCHED;
            PG8_LDB(B1, 0, 1); PG8_STAGE(PG8_SB(0, 0), b2, voffB);
            PG8_BAR; PG8_WAIT_L(0); PG8_MMA(0, 1, At, B1); PG8_BAR;
            PG8_LDA(At, 0, 1); PG8_STAGE(PG8_SA(0, 0), a2, voffA);
            PG8_BAR; PG8_WAIT_L(0); PG8_MMA(1, 0, At, B0); PG8_BAR; PG8_SCHED;
            PG8_STAGE(PG8_SB(0, 1), b2 + hstep, voffB);
            PG8_WAIT_V(6); PG8_BAR; PG8_MMA(1, 1, At, B1); PG8_BAR;
            PG8_LDB(B0, 1, 0); PG8_SCHED; PG8_LDA(At, 1, 0); PG8_STAGE(PG8_SA(0, 1), a2 + hstep, voffA);
            PG8_WAIT_L(8); PG8_BAR; PG8_WAIT_L(0); PG8_MMA(0, 0, At, B0); PG8_BAR; PG8_SCHED;
            PG8_LDB(B1, 1, 1); PG8_STAGE(PG8_SB(1, 0), b3, voffB);
            PG8_BAR; PG8_WAIT_L(0); PG8_MMA(0, 1, At, B1); PG8_BAR;
            PG8_LDA(At, 1, 1); PG8_STAGE(PG8_SA(1, 0), a3, voffA);
            PG8_BAR; PG8_WAIT_L(0); PG8_MMA(1, 0, At, B0); PG8_BAR; PG8_SCHED;
            PG8_STAGE(PG8_SB(1, 1), b3 + hstep, voffB);
            PG8_WAIT_V(6); PG8_BAR; PG8_MMA(1, 1, At, B1); PG8_BAR;
        }
        PG8_STAMP();
        if constexpr (!Epi::AFTER_DRAIN) { E(acc, cur, wr, wc, fr, fq); S.done(cur); }
        PG8_STAMP();
        if (!has_next) break;
#pragma unroll
        for (int a = 0; a < 2; ++a)
#pragma unroll
            for (int b = 0; b < 2; ++b)
#pragma unroll
                for (int m = 0; m < 4; ++m)
#pragma unroll
                    for (int n = 0; n < 2; ++n) acc[a][b][m][n] = (f32x4){0.f, 0.f, 0.f, 0.f};
        cur = nxt; cA = nA; cB = nB; ++ui;
    }
    PG8_WAIT_V(0);
    if (wr == 0) PG8_BAR;
    PG8_BAR;
    if constexpr (Epi::AFTER_DRAIN) { E.fused(acc, cur, wr, wc, fr, fq, lds, wid, lane); S.done(cur); }
    PG8_STAMP();
    if (STAMP && wid == 0) { stamps[lane] = lane < nts ? (((unsigned long long)(unsigned)ts_hi << 32) | (unsigned)ts_lo) : 0ull;
        if (lane == 62) stamps[62] = rt_entry; if (lane == 63) stamps[63] = (unsigned long long)wall_clock64(); }
#undef PG8_STAMP
#undef PG8_SA
#undef PG8_SB
#undef PG8_STAGE
#undef PG8_LDA
#undef PG8_LDB
#undef PG8_MMA
#undef PG8_WAIT_V
#undef PG8_WAIT_L
#undef PG8_BAR
#undef PG8_SCHED
}
}

#define XB_TMO      128
#define XB_XCNT(j)  (256  + 64 * (j))
#define XB_XSUB(j)  (1280 + 64 * (j))
#define XB_XGEN(j)  (2304 + 64 * (j))
#define XB_TOP      3328
#define XB_TOPGEN   3392
#define XCD_BAR_WORDS 3456
#define XB_SPIN_CAP (1u << 18)
__device__ __forceinline__ unsigned xb_ld(unsigned* p)              { return __hip_atomic_load(p, __ATOMIC_RELAXED, __HIP_MEMORY_SCOPE_AGENT); }
__device__ __forceinline__ unsigned xb_add(unsigned* p, unsigned v) { return __hip_atomic_fetch_add(p, v, __ATOMIC_RELAXED, __HIP_MEMORY_SCOPE_AGENT); }
__device__ __forceinline__ unsigned xb_xcc_id() { return (unsigned)__builtin_amdgcn_s_getreg((3 << 11) | 20) & 0xFu; }
#define XB_SPIN(cond, bar) do { unsigned _sp = 0; while (cond) { __builtin_amdgcn_s_sleep(1); \
    if ((++_sp & 255u) == 0u) { if (xb_ld(&(bar)[XB_TMO])) break; if (_sp > XB_SPIN_CAP) { atomicAdd(&(bar)[XB_TMO], 1u); break; } } } } while (0)
struct XcdBarrier { unsigned* bar; unsigned x; volatile LAS unsigned* st; };
__device__ __forceinline__ XcdBarrier xcd_barrier_post(unsigned* bar, volatile LAS unsigned* st) {
    XcdBarrier b; b.bar = bar; b.x = xb_xcc_id(); b.st = st;
    if (threadIdx.x == 0) (void)xb_add(&bar[XB_XCNT(b.x)], 1u);
    return b;
}
__device__ __forceinline__ void xcd_barrier_complete(unsigned* bar, unsigned x, unsigned& nloc, unsigned& nx) {
    const unsigned G = gridDim.x * gridDim.y * gridDim.z;
    unsigned sum, cnt, mine, sp = 0u;
    for (;;) {
        sum = 0u; cnt = 0u; mine = 0u;
#pragma unroll
        for (unsigned j = 0; j < 16; ++j) { const unsigned c = xb_ld(&bar[XB_XCNT(j)]); sum += c; cnt += (c > 0u) ? 1u : 0u; mine = (j == x) ? c : mine; }
        if (sum == G) break;
        __builtin_amdgcn_s_sleep(1);
        if ((++sp & 255u) == 0u) { if (xb_ld(&bar[XB_TMO])) break; if (sp > XB_SPIN_CAP) { atomicAdd(&bar[XB_TMO], 1u); break; } }
    }
    nloc = mine > 0u ? mine : 1u; nx = cnt > 0u ? cnt : 1u;
}
__device__ __forceinline__ void xcd_barrier(const XcdBarrier& b) {
    asm volatile("s_waitcnt vmcnt(0)" ::: "memory");
    __syncthreads();
    if (threadIdx.x == 0) {
        unsigned* bar = b.bar;
        __builtin_amdgcn_s_waitcnt(0);
        unsigned nloc = b.st[0], nx = b.st[1];
        if (nloc == 0u) { xcd_barrier_complete(bar, b.x, nloc, nx); b.st[0] = nloc; b.st[1] = nx; }
        const unsigned old = xb_add(&bar[XB_XSUB(b.x)], 1u);
        const unsigned gen = old / nloc;
        if (old + 1u == (gen + 1u) * nloc) {
            __builtin_amdgcn_fence(__ATOMIC_RELEASE, "agent");
            asm volatile("s_waitcnt vmcnt(0)" ::: "memory");
            const unsigned og = xb_add(&bar[XB_TOP], 1u);
            const unsigned tg = og / nx;
            if (og + 1u == (tg + 1u) * nx) xb_add(&bar[XB_TOPGEN], 1u);
            else XB_SPIN(xb_ld(&bar[XB_TOPGEN]) == tg, bar);
            __builtin_amdgcn_fence(__ATOMIC_ACQUIRE, "agent");
            xb_add(&bar[XB_XGEN(b.x)], 1u);
            asm volatile("s_waitcnt vmcnt(0)" ::: "memory");
        } else {
            XB_SPIN(xb_ld(&bar[XB_XGEN(b.x)]) == gen, bar);
            __builtin_amdgcn_fence(__ATOMIC_ACQUIRE, "agent");
            asm volatile("s_waitcnt vmcnt(0)" ::: "memory");
        }
    }
    __syncthreads();
}

struct Frame {
    LAS unsigned char* L; unsigned lb; int tid, lane, wave, bid, G; unsigned char* ws;
    DI Frame fresh() const { Frame f = *this; asm volatile("" : "+v"(f.tid), "+s"(f.wave), "+s"(f.bid), "+s"(f.lb)); f.lane = f.tid & 63; f.L = (LAS unsigned char*)(uintptr_t)f.lb; return f; }
    DI float* modp() const { return (float*)(ws + WS_MODP); }
    DI float* mod() const { return (float*)(ws + WS_MOD); }
    DI float* rope() const { return (float*)(ws + WS_ROPE); }
    DI float* tokw() const { return (float*)(ws + WS_TOKW); }
    DI float* slotw() const { return (float*)(ws + WS_SLOTW); }
    DI float* gates() const { return (float*)(ws + WS_GATES); }
    DI float* mlg() const { return (float*)(ws + WS_MLG); }
    DI float* dt() const { return (float*)(ws + WS_DT); }
    DI float* decml() const { return (float*)(ws + WS_DECML); }
    DI float* decss() const { return (float*)(ws + WS_DECSS); }
    DI float* xbuf() const { return (float*)(ws + WS_XBUF); }
    DI float* stml() const { return (float*)(ws + WS_STML); }
    DI float* stss() const { return (float*)(ws + WS_STSS); }
    DI int* toke() const { return (int*)(ws + WS_TOKE); }
    DI int* tokr() const { return (int*)(ws + WS_TOKR); }
    DI int* toks() const { return (int*)(ws + WS_TOKS); }
    DI int* cnt() const { return (int*)(ws + WS_CNT); }
    DI int* mte() const { return (int*)(ws + WS_MTE); }
    DI bf16_t* win() const { return (bf16_t*)(ws + WS_WIN); }
    DI bf16_t* wout() const { return (bf16_t*)(ws + WS_WOUT); }
    DI bf16_t* w13() const { return (bf16_t*)(ws + WS_W13); }
    DI bf16_t* w2() const { return (bf16_t*)(ws + WS_W2); }
    DI bf16_t* h() const { return (bf16_t*)(ws + WS_H); }
    DI bf16_t* proj() const { return (bf16_t*)(ws + WS_PROJ); }
    DI bf16_t* xbcc() const { return (bf16_t*)(ws + WS_XBCC); }
    DI bf16_t* mix() const { return (bf16_t*)(ws + WS_MIX); }
    DI bf16_t* amoe() const { return (bf16_t*)(ws + WS_AMOE); }
    DI bf16_t* hid() const { return (bf16_t*)(ws + WS_HID); }
    DI bf16_t* ymoe() const { return (bf16_t*)(ws + WS_YMOE); }
};

constexpr int NJ_ADA = 384, NJ_WIN = 2 * 27 * 32, NJ_WOUT = 2 * 8 * 32, NJ_W13 = 64 * 8 * 32, NJ_W2 = 64 * 8 * 16;
constexpr int NJ_TOTAL = NJ_ADA + 1 + NJ_WIN + NJ_WOUT + NJ_W13 + NJ_W2;
DI int win_col(int n) { return n < 5120 ? n : (n < 6656 ? n + 16 : (n < 6672 ? n - 1536 : (n < 6688 ? n : -1))); }

DI void phase_prologue(const Params& p, const Frame& F) {
    LAS float* TL = (LAS float*)F.L;
    for (int job = F.bid; job < NJ_TOTAL; job += F.G) {
        __syncthreads();
        if (job < NJ_ADA) {
            const int l = job / 192, kq = (job / 48) & 3, cb = job % 48;
            LAS float* sl = TL; LAS float* sc = TL + 512; LAS float* red = TL + 1024;
            { const int k = kq * 512 + F.tid; const float a = p.c[k], b = p.c_ctx[k]; sl[F.tid] = siluf(a); sc[F.tid] = siluf(b); }
            __syncthreads();
            const int cg = F.tid & 63, ks = F.tid >> 6;
            f32x4 a0 = {0.f, 0.f, 0.f, 0.f}, a1 = {0.f, 0.f, 0.f, 0.f};
            const float* wp = p.w_mod + ((size_t)l * 2048 + kq * 512 + ks * 64) * 12288 + cb * 256 + cg * 4;
#pragma unroll 8
            for (int k = 0; k < 64; ++k) { const f32x4 w = *(const f32x4*)(wp + (size_t)k * 12288); a0 += sl[ks * 64 + k] * w; a1 += sc[ks * 64 + k] * w; }
            *(LAS f32x4*)(red + (ks * 2 + 0) * 256 + cg * 4) = a0; *(LAS f32x4*)(red + (ks * 2 + 1) * 256 + cg * 4) = a1;
            __syncthreads();
            { const int which = F.tid >> 8, col = F.tid & 255; float s = 0.f;
#pragma unroll
              for (int k8 = 0; k8 < 8; ++k8) s += red[(k8 * 2 + which) * 256 + col];
              F.modp()[((size_t)(l * 4 + kq) * 2 + which) * 12288 + cb * 256 + col] = s; }
            continue;
        }
        if (job == NJ_ADA) {
            for (int i = F.tid; i < 320 * 32; i += NTHR) { const int pos = i >> 5, f = i & 31; const int pp = pos < 256 ? pos : pos - 256;
                const float inv = expf(-logf(10000.0f) * (float)f / 32.0f); float sn, cs; sincosf((float)pp * inv, &sn, &cs);
                F.rope()[(size_t)pos * 64 + f] = cs; F.rope()[(size_t)pos * 64 + 32 + f] = sn; }
            continue;
        }
        int j = job - NJ_ADA - 1; int kind, K, ldS; const float* s0; const float* s1 = nullptr; bf16_t* dst; int n0, k0;
        if (j < NJ_WIN) { kind = 0; const int l = j / (27 * 32), r = j % (27 * 32); n0 = (r / 32) * 256; k0 = (r % 32) * 64; K = 2048; ldS = INC; s0 = p.w_in + (size_t)l * 2048 * INC; dst = F.win() + (size_t)l * NPAD * 2048; }
        else if ((j -= NJ_WIN) < NJ_WOUT) { kind = 1; const int l = j / 256, r = j % 256; n0 = (r / 32) * 256; k0 = (r % 32) * 64; K = 2048; ldS = 2048; s0 = p.w_out + (size_t)l * 2048 * 2048 + n0; dst = F.wout() + (size_t)l * 2048 * 2048; }
        else if ((j -= NJ_WOUT) < NJ_W13) { kind = 2; const int le = j / 256, r = j % 256; const int jt = r / 32; n0 = jt * 256; k0 = (r % 32) * 64; K = 2048; ldS = 1024;
            s0 = p.w1 + (size_t)le * 2048 * 1024 + jt * 128; s1 = p.w3 + (size_t)le * 2048 * 1024 + jt * 128; dst = F.w13() + (size_t)le * 2048 * 2048; }
        else { j -= NJ_W13; kind = 1; const int le = j / 128, r = j % 128; n0 = (r / 16) * 256; k0 = (r % 16) * 64; K = 1024; ldS = 2048; s0 = p.w2 + (size_t)le * 1024 * 2048 + n0; dst = F.w2() + (size_t)le * 2048 * 1024; }
        f32x4 v[8];
#pragma unroll
        for (int i = 0; i < 8; ++i) { const int idx = F.tid + NTHR * i, kk = idx >> 6, c4 = (idx & 63) * 4; const float* sp;
            if (kind == 0) { const int sc = win_col(n0 + c4); sp = sc >= 0 ? s0 + (size_t)(k0 + kk) * ldS + sc : nullptr; }
            else if (kind == 1) sp = s0 + (size_t)(k0 + kk) * ldS + c4;
            else sp = (c4 < 128 ? s0 + c4 : s1 + (c4 - 128)) + (size_t)(k0 + kk) * ldS;
            v[i] = sp ? *(const f32x4*)sp : (f32x4){0.f, 0.f, 0.f, 0.f}; }
#pragma unroll
        for (int i = 0; i < 8; ++i) { const int idx = F.tid + NTHR * i, kk = idx >> 6, c4 = (idx & 63) * 4;
            TL[kk * 257 + c4] = v[i][0]; TL[kk * 257 + c4 + 1] = v[i][1]; TL[kk * 257 + c4 + 2] = v[i][2]; TL[kk * 257 + c4 + 3] = v[i][3]; }
        __syncthreads();
#pragma unroll
        for (int i = 0; i < 4; ++i) { const int idx = F.tid + NTHR * i, n = idx >> 3, k8 = (idx & 7) * 8; float t[8];
#pragma unroll
            for (int e = 0; e < 8; ++e) t[e] = TL[(k8 + e) * 257 + n];
            u32x4 w; w.x = pk2(t[0], t[1]); w.y = pk2(t[2], t[3]); w.z = pk2(t[4], t[5]); w.w = pk2(t[6], t[7]);
            *(u32x4*)(dst + (size_t)(n0 + n) * K + k0 + k8) = w; }
    }
}

DI float mod_from_partials(const Params& p, const Frame& F, int l, int which, int idx) {
    float s = p.b_mod[(size_t)l * 12288 + idx];
#pragma unroll
    for (int kq = 0; kq < 4; ++kq) s += F.modp()[((size_t)(l * 4 + kq) * 2 + which) * 12288 + idx];
    return s;
}

template <int MODE> DI void phase_rows(const Params& p, const Frame& F) {
    constexpr int l = MODE == 0 ? 0 : 1;
    LAS float* nw = (LAS float*)F.L; LAS float* scl = nw + 2048; LAS float* shf = scl + 4096; LAS float* g2v = shf + 4096;
    __syncthreads();
    for (int i = F.tid; i < 2048; i += NTHR) {
        nw[i] = MODE == 2 ? p.final_w[i] : p.norm1_w[l * 2048 + i];
        if (MODE != 2) { for (int w = 0; w < 2; ++w) { scl[w * 2048 + i] = 1.0f + mod_from_partials(p, F, l, w, 2048 + i); shf[w * 2048 + i] = mod_from_partials(p, F, l, w, i); } }
        if (MODE != 0) { for (int w = 0; w < 2; ++w) g2v[w * 2048 + i] = F.mod()[((size_t)(MODE - 1) * 2 + w) * 12288 + 5 * 2048 + i]; }
    }
    if (MODE != 2) {
        for (int i = F.bid * NTHR + F.tid; i < 2 * 12288; i += F.G * NTHR) F.mod()[(size_t)l * 2 * 12288 + i] = mod_from_partials(p, F, l, i / 12288, i % 12288);
    }
    __syncthreads();
    const int nrows = MODE == 2 ? T : NT;
    for (int row = F.bid * 8 + F.wave; row < nrows; row += F.G * 8) {
        const int w = row >= T ? 1 : 0;
        const float* src = MODE == 0 ? (w ? p.ctx + (size_t)(row - T) * 2048 : p.x + (size_t)row * 2048) : F.xbuf() + (size_t)row * 2048;
        f32x4 v[8];
#pragma unroll
        for (int j = 0; j < 8; ++j) v[j] = *(const f32x4*)(src + j * 256 + F.lane * 4);
        if (MODE != 0) {
            const int s0 = F.toks()[row * 2], s1 = F.toks()[row * 2 + 1];
            const bf16_t* y0 = F.ymoe() + (size_t)s0 * 2048; const bf16_t* y1 = F.ymoe() + (size_t)s1 * 2048;
#pragma unroll
            for (int j = 0; j < 8; ++j) { const int c = j * 256 + F.lane * 4; const u32x2 a = *(const u32x2*)(y0 + c), b = *(const u32x2*)(y1 + c);
                const f32x4 g = *(LAS f32x4*)(g2v + w * 2048 + c);
                v[j][0] += g[0] * (bflo(a.x) + bflo(b.x)); v[j][1] += g[1] * (bfhi(a.x) + bfhi(b.x)); v[j][2] += g[2] * (bflo(a.y) + bflo(b.y)); v[j][3] += g[3] * (bfhi(a.y) + bfhi(b.y)); }
            if (MODE == 1) {
#pragma unroll
                for (int j = 0; j < 8; ++j) *(f32x4*)(F.xbuf() + (size_t)row * 2048 + j * 256 + F.lane * 4) = v[j];
            }
        }
        float ss = 0.f;
#pragma unroll
        for (int j = 0; j < 8; ++j) ss += v[j][0] * v[j][0] + v[j][1] * v[j][1] + v[j][2] * v[j][2] + v[j][3] * v[j][3];
        ss = wsum(ss);
        const float rstd = rsqrtf(ss * (1.0f / 2048.0f) + 1e-6f);
#pragma unroll
        for (int j = 0; j < 8; ++j) { const int c = j * 256 + F.lane * 4; const f32x4 nwv = *(LAS f32x4*)(nw + c);
            f32x4 o = v[j] * rstd * nwv;
            if (MODE == 2) *(f32x4*)(p.out + (size_t)row * 2048 + c) = o;
            else { o = o * *(LAS f32x4*)(scl + w * 2048 + c) + *(LAS f32x4*)(shf + w * 2048 + c);
                u32x2 pk; pk.x = pk2(o[0], o[1]); pk.y = pk2(o[2], o[3]); *(u32x2*)(F.h() + (size_t)row * 2048 + c) = pk; } }
    }
}

DI void phase_prep(const Params& p, const Frame& F, int l) {
    for (int row = F.bid * 8 + F.wave; row < NT; row += F.G * 8) {
        const bool lat = row < T; const int lane = F.lane;
        bf16_t* pr = F.proj() + (size_t)row * NPROJ;
#pragma unroll
        for (int j = 0; j < 2; ++j) {
            const int head = lane >> 4, half = (lane >> 3) & 1, i4 = (lane & 7) * 4;
            bf16_t* base = pr + (j ? MKO : MQO) + head * 128 + half * 64 + i4;
            const u32x2 a = *(const u32x2*)base, b = *(const u32x2*)(base + 32);
            float x1[4] = {bflo(a.x), bfhi(a.x), bflo(a.y), bfhi(a.y)}, x2[4] = {bflo(b.x), bfhi(b.x), bflo(b.y), bfhi(b.y)}, o1[4], o2[4];
            if (lat) { const int pos = half ? 256 + (row & 63) : (row >> 6); const f32x4 cs = *(const f32x4*)(F.rope() + (size_t)pos * 64 + i4), sn = *(const f32x4*)(F.rope() + (size_t)pos * 64 + 32 + i4);
#pragma unroll
                for (int e = 0; e < 4; ++e) { o1[e] = x1[e] * cs[e] - x2[e] * sn[e]; o2[e] = x1[e] * sn[e] + x2[e] * cs[e]; } }
            else {
#pragma unroll
                for (int e = 0; e < 4; ++e) { o1[e] = x1[e]; o2[e] = x2[e]; } }
            if (j) {
#pragma unroll
                for (int e = 0; e < 4; ++e) { o1[e] *= 0.08838834764831845f; o2[e] *= 0.08838834764831845f; } }
            u32x2 wa, wb; wa.x = pk2(o1[0], o1[1]); wa.y = pk2(o1[2], o1[3]); wb.x = pk2(o2[0], o2[1]); wb.y = pk2(o2[2], o2[3]);
            *(u32x2*)base = wa; *(u32x2*)(base + 32) = wb;
        }
        if (lane < 16) { float v = F.gates()[(size_t)row * 32 + lane] + p.ml_gate_b[l * 16 + lane];
            if ((lane >> 2) & 1) v = fminf(v, 0.f) - log1pf(expf(-fabsf(v)));
            F.mlg()[(size_t)row * 16 + lane] = v; }
        else if (lane < 32) { const int idx = lane - 16; const float v = F.gates()[(size_t)row * 32 + lane] + p.dt_bias[l * 16 + idx];
            F.dt()[(size_t)row * 16 + idx] = fmaxf(v, 0.f) + log1pf(expf(-fabsf(v))); }
        const int tl = lat ? row : row - T, nseq = lat ? T : CTXL, rb = lat ? 0 : T;
#pragma unroll
        for (int j = 0; j < 2; ++j) {
            const int ch = (lane + 64 * j) * 8; float acc[8];
            { const f32x4 b0 = *(const f32x4*)(p.conv_b + l * 1024 + ch), b1 = *(const f32x4*)(p.conv_b + l * 1024 + ch + 4);
              acc[0] = b0[0]; acc[1] = b0[1]; acc[2] = b0[2]; acc[3] = b0[3]; acc[4] = b1[0]; acc[5] = b1[1]; acc[6] = b1[2]; acc[7] = b1[3]; }
#pragma unroll
            for (int tap = 0; tap < 4; ++tap) { const int tt = tl + tap - 2;
                if (tt >= 0 && tt < nseq) { float xv[8]; unpack8(*(const u32x4*)(F.proj() + (size_t)(rb + tt) * NPROJ + XBO + ch), xv);
                    const f32x4 w0 = *(const f32x4*)(p.conv_w + ((size_t)l * 4 + tap) * 1024 + ch), w1 = *(const f32x4*)(p.conv_w + ((size_t)l * 4 + tap) * 1024 + ch + 4);
                    acc[0] += w0[0] * xv[0]; acc[1] += w0[1] * xv[1]; acc[2] += w0[2] * xv[2]; acc[3] += w0[3] * xv[3];
                    acc[4] += w1[0] * xv[4]; acc[5] += w1[1] * xv[5]; acc[6] += w1[2] * xv[6]; acc[7] += w1[3] * xv[7]; } }
#pragma unroll
            for (int e = 0; e < 8; ++e) acc[e] = siluf(acc[e]);
            *(u32x4*)(F.xbcc() + (size_t)row * 1024 + ch) = __builtin_bit_cast(u32x4, pack8(acc));
        }
    }
}

DI void na_task(const Params& p, const Frame& F, int l, int task) {
    constexpr unsigned KT = 0, VT = 34816, RPB = 69632, PB = 272;
    LAS unsigned char* L = F.L; const int lane = F.lane, g = lane >> 4, n = lane & 15;
    const bool isctx = task >= 1024;
    const int r = isctx ? 0 : task >> 2, hp = task & 3;
    const int nwin = isctx ? 0 : 8, qrow0 = isctx ? T + ((task - 1024) >> 2) * 64 : r * 64;
    const int rs = r - 4 < 0 ? 0 : (r - 4 > 248 ? 248 : r - 4);
    const int wg = F.wave >> 2, qt = F.wave & 3, head = hp * 2 + wg;
    const int qtok = qrow0 + qt * 16 + n;
    const bf16_t* proj = F.proj();
    bf16x8 qf[4];
#pragma unroll
    for (int ks = 0; ks < 4; ++ks) qf[ks] = *(const bf16x8*)(proj + (size_t)qtok * NPROJ + QO + head * 128 + ks * 32 + g * 8);
    __syncthreads();
    if (!isctx) { LAS float* rp = (LAS float*)(L + RPB); for (int i = F.tid; i < 930; i += NTHR) rp[i] = p.na_rpb[((size_t)(l * 8 + hp * 2 + i / 465)) * 465 + i % 465]; }
    f32x4 o[8];
#pragma unroll
    for (int i = 0; i < 8; ++i) o[i] = (f32x4){0.f, 0.f, 0.f, 0.f};
    float m_run = -INFINITY, l_run = 0.f;
    const int cb = qt == 0 ? 0 : (qt == 1 ? 8 : (qt == 2 ? 24 : 32));
    const int qc = qt * 16 + n, cs = qc - 8 < 0 ? 0 : (qc - 8 > 48 ? 48 : qc - 8);
    const unsigned ktw = KT + wg * 17408, vtw = VT + wg * 17408;
    for (int step = 0; step < nwin + 4; ++step) {
        __syncthreads();
        const int ktok0 = step < nwin ? (rs + step) * 64 : T + (step - nwin) * 64;
#pragma unroll
        for (int i = 0; i < 8; ++i) { const int ci = F.tid + NTHR * i, which = ci >> 11, rem = ci & 2047, wgs = rem >> 10, key = (rem >> 4) & 63, c16 = rem & 15;
            const u32x4 v = *(const u32x4*)(proj + (size_t)(ktok0 + key) * NPROJ + (which ? VO : KO) + (hp * 2 + wgs) * 128 + c16 * 8);
            *(LAS u32x4*)(L + (which ? VT : KT) + wgs * 17408 + key * PB + c16 * 16) = v; }
        __syncthreads();
        const bool masked = step < nwin;
        const int nsub = masked ? 1 : 2;
        for (int sub = 0; sub < nsub; ++sub) {
            const int kb = masked ? cb : sub * 32;
            f32x4 s0 = {0.f, 0.f, 0.f, 0.f}, s1 = {0.f, 0.f, 0.f, 0.f};
#pragma unroll
            for (int ks = 0; ks < 4; ++ks) { const bf16x8 k0 = frag_row(L, ktw, PB, kb, ks * 32, lane), k1 = frag_row(L, ktw, PB, kb + 16, ks * 32, lane);
                s0 = mfma16(k0, qf[ks], s0); s1 = mfma16(k1, qf[ks], s1); }
            float sv[8];
#pragma unroll
            for (int e = 0; e < 4; ++e) { sv[e] = s0[e] * 0.08838834764831845f; sv[4 + e] = s1[e] * 0.08838834764831845f; }
            if (masked) { const LAS float* rp = (const LAS float*)(L + RPB) + wg * 465 + (rs + step - r + 7) * 31;
#pragma unroll
                for (int e = 0; e < 8; ++e) { const int kc = kb + (e < 4 ? 4 * g + e : 16 + 4 * g + (e - 4)); const bool valid = (unsigned)(kc - cs) < 16u;
                    const int bi = valid ? kc - qc + 15 : 0; const float bias = rp[bi]; sv[e] = valid ? sv[e] + bias : -INFINITY; } }
            float mx = fmaxf(fmaxf(fmaxf(sv[0], sv[1]), fmaxf(sv[2], sv[3])), fmaxf(fmaxf(sv[4], sv[5]), fmaxf(sv[6], sv[7])));
            mx = fmaxf(mx, __shfl_xor(mx, 16)); mx = fmaxf(mx, __shfl_xor(mx, 32));
            const float m_new = fmaxf(m_run, mx), alpha = __expf(m_run - m_new);
            float pv[8], ps = 0.f;
#pragma unroll
            for (int e = 0; e < 8; ++e) { pv[e] = __expf(sv[e] - m_new); ps += pv[e]; }
            l_run = l_run * alpha + ps; m_run = m_new;
            const bf16x8 pf = pack8(pv);
#pragma unroll
            for (int dvt = 0; dvt < 8; ++dvt) { o[dvt] *= alpha; const bf16x8 vf = frag_tr(F.lb, vtw, PB, kb + 4 * g, kb + 16 + 4 * g, dvt * 16, lane); o[dvt] = mfma16(vf, pf, o[dvt]); }
        }
    }
    const float inv = 1.0f / gsum4(l_run);
#pragma unroll
    for (int dvt = 0; dvt < 8; ++dvt) { u32x2 w; w.x = pk2(o[dvt][0] * inv, o[dvt][1] * inv); w.y = pk2(o[dvt][2] * inv, o[dvt][3] * inv);
        *(u32x2*)(F.mix() + (size_t)qtok * 2048 + head * 128 + dvt * 16 + 4 * g) = w; }
}

DI void ml_state_task(const Params& p, const Frame& F, int tc, int h) {
    constexpr unsigned KT = 0, VF = 17408, VB = 34816, WF = 52224, PB = 272;
    LAS unsigned char* L = F.L; const int lane = F.lane, g = lane >> 4, n = lane & 15;
    LAS float* Wt = (LAS float*)(L + WF);
    __syncthreads();
    if (F.wave < 2) { const int d = F.wave, tok = tc * 64 + lane;
        const float ig = F.mlg()[(size_t)tok * 16 + d * 8 + h], lf = F.mlg()[(size_t)tok * 16 + d * 8 + 4 + h];
        const float b = wscan(lf, d, lane); const float G = __shfl(b, d ? 0 : 63);
        Wt[d * 64 + lane] = __expf(G - b + ig);
        if (lane == 0) F.decml()[(d * 4 + h) * NCH + tc] = __expf(G); }
    __syncthreads();
#pragma unroll
    for (int i = 0; i < 2; ++i) { const int ci = F.tid + NTHR * i, row = ci >> 4, c16 = ci & 15; const size_t tok = (size_t)tc * 64 + row;
        const u32x4 kv = *(const u32x4*)(F.proj() + tok * NPROJ + MKO + h * 128 + c16 * 8);
        *(LAS u32x4*)(L + KT + row * PB + c16 * 16) = kv;
        float v[8], a[8], b[8]; unpack8(*(const u32x4*)(F.proj() + tok * NPROJ + MVO + h * 128 + c16 * 8), v);
        const float wf = Wt[row], wb = Wt[64 + row];
#pragma unroll
        for (int e = 0; e < 8; ++e) { a[e] = v[e] * wf; b[e] = v[e] * wb; }
        *(LAS bf16x8*)(L + VF + row * PB + c16 * 16) = pack8(a); *(LAS bf16x8*)(L + VB + row * PB + c16 * 16) = pack8(b); }
    __syncthreads();
    const int w = F.wave;
#pragma unroll
    for (int d = 0; d < 2; ++d) { const unsigned vt = d ? VB : VF;
        const bf16x8 x0 = frag_tr(F.lb, vt, PB, 8 * g, 8 * g + 4, 16 * w, lane), x1 = frag_tr(F.lb, vt, PB, 32 + 8 * g, 32 + 8 * g + 4, 16 * w, lane);
        float* dst = F.stml() + ((size_t)(d * 4 + h) * NCH + tc) * 16512;
#pragma unroll 1
        for (int jt = 0; jt < 8; ++jt) { const bf16x8 y0 = frag_tr(F.lb, KT, PB, 8 * g, 8 * g + 4, 16 * jt, lane), y1 = frag_tr(F.lb, KT, PB, 32 + 8 * g, 32 + 8 * g + 4, 16 * jt, lane);
            f32x4 acc = {0.f, 0.f, 0.f, 0.f}; acc = mfma16(x0, y0, acc); acc = mfma16(x1, y1, acc);
#pragma unroll
            for (int e = 0; e < 4; ++e) dst[(16 * w + 4 * g + e) * 128 + 16 * jt + n] = acc[e]; } }
    if (F.tid < 256) { const int d = F.tid >> 7, dk = F.tid & 127; float s = 0.f;
        for (int t = 0; t < 64; ++t) s += Wt[d * 64 + t] * bf2f(*(LAS bf16_t*)(L + KT + t * PB + dk * 2));
        F.stml()[((size_t)(d * 4 + h) * NCH + tc) * 16512 + 16384 + dk] = s; }
}

DI void ml_out_task(const Params& p, const Frame& F, int l, int tc, int h) {
    constexpr unsigned QT = 0, KT = 17408, VT = 34816, CF = 54272, CB = 93440, GA = 132608, PB = 272, PV = 304;
    LAS unsigned char* L = F.L; const int lane = F.lane, g = lane >> 4, n = lane & 15;
    LAS float* Bg = (LAS float*)(L + GA);
    LAS float* Ig = Bg + 128;
    __syncthreads();
    if (F.wave < 2) { const int d = F.wave, tok = tc * 64 + lane;
        const float ig = F.mlg()[(size_t)tok * 16 + d * 8 + h], lf = F.mlg()[(size_t)tok * 16 + d * 8 + 4 + h];
        Bg[d * 64 + lane] = wscan(lf, d, lane); Ig[d * 64 + lane] = ig; }
#pragma unroll
    for (int i = 0; i < 2; ++i) { const int ci = F.tid + NTHR * i, row = ci >> 4, c16 = ci & 15; const size_t tok = (size_t)tc * 64 + row;
        *(LAS u32x4*)(L + QT + row * PB + c16 * 16) = *(const u32x4*)(F.proj() + tok * NPROJ + MQO + h * 128 + c16 * 8);
        *(LAS u32x4*)(L + KT + row * PB + c16 * 16) = *(const u32x4*)(F.proj() + tok * NPROJ + MKO + h * 128 + c16 * 8);
        *(LAS u32x4*)(L + VT + row * PV + c16 * 16) = *(const u32x4*)(F.proj() + tok * NPROJ + MVO + h * 128 + c16 * 8); }
    if (F.tid < 128) { const int row = F.tid >> 1, hf = F.tid & 1; u32x4 v = {0u, 0u, 0u, 0u}; if (!hf) v.x = 0x3f80u; *(LAS u32x4*)(L + VT + row * PV + 256 + hf * 16) = v; }
#pragma unroll
    for (int d = 0; d < 2; ++d) { const float* src = F.stml() + ((size_t)(d * 4 + h) * NCH + tc) * 16512; const unsigned ct = d ? CB : CF;
        for (int i = F.tid; i < 4128; i += NTHR) { const f32x4 v = *(const f32x4*)(src + i * 4); const int row = i >> 5, c4 = (i & 31) * 4;
            u32x2 w; w.x = pk2(v[0], v[1]); w.y = pk2(v[2], v[3]); *(LAS u32x2*)(L + ct + row * PB + c4 * 2) = w; }
        for (int i = F.tid; i < 15 * 17; i += NTHR) { const int row = 129 + i / 17, c = i % 17; *(LAS u32x4*)(L + ct + row * PB + c * 16) = (u32x4){0u, 0u, 0u, 0u}; } }
    __syncthreads();
    const int d = F.wave >> 2, qt = F.wave & 3;
    bf16x8 qf[4];
#pragma unroll
    for (int ks = 0; ks < 4; ++ks) qf[ks] = frag_row(L, QT, PB, 16 * qt, 32 * ks, lane);
    const int t = 16 * qt + n; const float bt = Bg[d * 64 + t];
    float wv[4][4];
#pragma unroll
    for (int st = 0; st < 4; ++st) {
        const bool need = d ? (st >= qt) : (st <= qt);
        f32x4 sa = {0.f, 0.f, 0.f, 0.f};
        if (need) {
#pragma unroll
            for (int ks = 0; ks < 4; ++ks) sa = mfma16(frag_row(L, KT, PB, 16 * st, 32 * ks, lane), qf[ks], sa); }
#pragma unroll
        for (int e = 0; e < 4; ++e) { const int s = 16 * st + 4 * g + e; const bool valid = need && (d ? (s >= t) : (s <= t));
            wv[st][e] = valid ? sa[e] * __expf(bt - Bg[d * 64 + s] + Ig[d * 64 + s]) : 0.f; }
    }
    f32x4 num[9];
#pragma unroll
    for (int it = 0; it < 9; ++it) num[it] = (f32x4){0.f, 0.f, 0.f, 0.f};
#pragma unroll
    for (int kk = 0; kk < 2; ++kk) {
        const bool need = d ? (2 * kk + 1 >= qt) : (2 * kk <= qt);
        if (need) { float pv[8];
#pragma unroll
            for (int e = 0; e < 4; ++e) { pv[e] = wv[2 * kk][e]; pv[4 + e] = wv[2 * kk + 1][e]; }
            const bf16x8 pf = pack8(pv);
#pragma unroll
            for (int it = 0; it < 9; ++it) num[it] = mfma16(frag_tr(F.lb, VT, PV, 32 * kk + 4 * g, 32 * kk + 16 + 4 * g, 16 * it, lane), pf, num[it]); }
    }
    const unsigned ct = d ? CB : CF; const float eb = __expf(bt);
#pragma unroll
    for (int it = 0; it < 9; ++it) { f32x4 ia = {0.f, 0.f, 0.f, 0.f};
#pragma unroll
        for (int ks = 0; ks < 4; ++ks) ia = mfma16(frag_row(L, ct, PB, 16 * it, 32 * ks, lane), qf[ks], ia);
        num[it] += eb * ia; }
    const float den = __shfl(num[8][0], n);
    const float dn = 1.0f / fmaxf(fabsf(den), 1.0f);
#pragma unroll
    for (int it = 0; it < 8; ++it) num[it] *= dn;
    __syncthreads();
    LAS float* HX = (LAS float*)(L + CF);
    if (d == 1) {
#pragma unroll
        for (int it = 0; it < 8; ++it) *(LAS f32x4*)(HX + t * 132 + 16 * it + 4 * g) = num[it]; }
    __syncthreads();
    if (d == 0 && (l == 0 || tc < 256)) {
        float sm = 0.f;
#pragma unroll
        for (int it = 0; it < 8; ++it) { num[it] += *(LAS f32x4*)(HX + t * 132 + 16 * it + 4 * g); sm += num[it][0] + num[it][1] + num[it][2] + num[it][3]; }
        const float mean = gsum4(sm) * (1.0f / 128.0f); float vs = 0.f;
#pragma unroll
        for (int it = 0; it < 8; ++it) { num[it] -= mean; vs += num[it][0] * num[it][0] + num[it][1] * num[it][1] + num[it][2] * num[it][2] + num[it][3] * num[it][3]; }
        const float rstd = rsqrtf(gsum4(vs) * (1.0f / 128.0f) + 1e-6f);
        const size_t tok = (size_t)tc * 64 + t;
#pragma unroll
        for (int it = 0; it < 8; ++it) { const int c = h * 128 + 16 * it + 4 * g;
            const u32x2 mo = *(const u32x2*)(F.proj() + tok * NPROJ + MOO + c); const f32x4 nwv = *(const f32x4*)(p.ml_norm_w + l * 512 + c);
            const float o0 = num[it][0] * rstd * nwv[0] * sigmf(bflo(mo.x)), o1 = num[it][1] * rstd * nwv[1] * sigmf(bfhi(mo.x));
            const float o2 = num[it][2] * rstd * nwv[2] * sigmf(bflo(mo.y)), o3 = num[it][3] * rstd * nwv[3] * sigmf(bfhi(mo.y));
            u32x2 w; w.x = pk2(o0, o1); w.y = pk2(o2, o3); *(u32x2*)(F.mix() + tok * 2048 + 1024 + c) = w; }
    }
}

DI void ss_state_task(const Params& p, const Frame& F, int l, int tc, int gi) {
    constexpr unsigned BT = 0, XS = 17408, WA = 91136, PB = 272, PX = 144;
    LAS unsigned char* L = F.L; const int lane = F.lane, g = lane >> 4, n = lane & 15, w = F.wave;
    LAS float* Wt = (LAS float*)(L + WA);
    const int hl = w & 3, d = w >> 2, hh = gi * 4 + hl;
    __syncthreads();
    { const int tok = tc * 64 + lane; const float dt = F.dt()[(size_t)tok * 16 + d * 8 + hh], a = -__expf(p.a_log[(l * 2 + d) * 8 + hh]);
      const float la = wscan(dt * a, d, lane); const float G = __shfl(la, d ? 0 : 63);
      Wt[w * 64 + lane] = __expf(G - la) * dt;
      if (lane == 0) F.decss()[(d * 8 + hh) * NCH + tc] = __expf(G); }
    __syncthreads();
#pragma unroll
    for (int i = 0; i < 2; ++i) { const int ci = F.tid + NTHR * i, row = ci >> 4, c16 = ci & 15;
        *(LAS u32x4*)(L + BT + row * PB + c16 * 16) = *(const u32x4*)(F.xbcc() + ((size_t)tc * 64 + row) * 1024 + 512 + gi * 128 + c16 * 8); }
#pragma unroll
    for (int i = 0; i < 8; ++i) { const int ci = F.tid + NTHR * i, ww = ci >> 9, row = (ci >> 3) & 63, c8 = ci & 7; float v[8];
        unpack8(*(const u32x4*)(F.xbcc() + ((size_t)tc * 64 + row) * 1024 + (gi * 4 + (ww & 3)) * 64 + c8 * 8), v);
        const float ws = Wt[ww * 64 + row];
#pragma unroll
        for (int e = 0; e < 8; ++e) v[e] *= ws;
        *(LAS bf16x8*)(L + XS + ww * 9216 + row * PX + c8 * 16) = pack8(v); }
    __syncthreads();
    float* dst = F.stss() + ((size_t)(d * 8 + hh) * NCH + tc) * 8192;
    const unsigned xt = XS + w * 9216;
    bf16x8 xf[4][2];
#pragma unroll
    for (int it = 0; it < 4; ++it) { xf[it][0] = frag_tr(F.lb, xt, PX, 8 * g, 8 * g + 4, 16 * it, lane); xf[it][1] = frag_tr(F.lb, xt, PX, 32 + 8 * g, 32 + 8 * g + 4, 16 * it, lane); }
#pragma unroll 1
    for (int jt = 0; jt < 8; ++jt) { const bf16x8 y0 = frag_tr(F.lb, BT, PB, 8 * g, 8 * g + 4, 16 * jt, lane), y1 = frag_tr(F.lb, BT, PB, 32 + 8 * g, 32 + 8 * g + 4, 16 * jt, lane);
        float* dj = dst + (4 * g) * 128 + 16 * jt + n;
#pragma unroll
        for (int it = 0; it < 4; ++it) { f32x4 acc = {0.f, 0.f, 0.f, 0.f}; acc = mfma16(xf[it][0], y0, acc); acc = mfma16(xf[it][1], y1, acc);
#pragma unroll
            for (int e = 0; e < 4; ++e) dj[(16 * it + e) * 128] = acc[e]; } }
}

DI void ss_out_task(const Params& p, const Frame& F, int l, int tc, int gi) {
    constexpr unsigned CT = 0, BT = 17408, XT = 34816, SS = 68608, LA = 138240, DS = 140288, SQ = 142336, PB = 272, PX = 528;
    LAS unsigned char* L = F.L; const int lane = F.lane, g = lane >> 4, n = lane & 15, w = F.wave;
    LAS float* La = (LAS float*)(L + LA); LAS float* Dt = (LAS float*)(L + DS); LAS float* Sq = (LAS float*)(L + SQ);
    __syncthreads();
    { const int hl = w & 3, d = w >> 2, hh = gi * 4 + hl; const int tok = tc * 64 + lane;
      const float dt = F.dt()[(size_t)tok * 16 + d * 8 + hh], a = -__expf(p.a_log[(l * 2 + d) * 8 + hh]);
      La[w * 64 + lane] = wscan(dt * a, d, lane); Dt[w * 64 + lane] = dt; }
#pragma unroll
    for (int i = 0; i < 2; ++i) { const int ci = F.tid + NTHR * i, row = ci >> 4, c16 = ci & 15; const size_t tok = (size_t)tc * 64 + row;
        *(LAS u32x4*)(L + CT + row * PB + c16 * 16) = *(const u32x4*)(F.xbcc() + tok * 1024 + 768 + gi * 128 + c16 * 8);
        *(LAS u32x4*)(L + BT + row * PB + c16 * 16) = *(const u32x4*)(F.xbcc() + tok * 1024 + 512 + gi * 128 + c16 * 8); }
#pragma unroll
    for (int i = 0; i < 4; ++i) { const int ci = F.tid + NTHR * i, row = ci >> 5, c32 = ci & 31;
        *(LAS u32x4*)(L + XT + row * PX + c32 * 16) = *(const u32x4*)(F.xbcc() + ((size_t)tc * 64 + row) * 1024 + gi * 256 + c32 * 8); }
    __syncthreads();
    const int qt = w & 3, hp2 = w >> 2, t = 16 * qt + n;
    bf16x8 cf[4];
#pragma unroll
    for (int ks = 0; ks < 4; ++ks) cf[ks] = frag_row(L, CT, PB, 16 * qt, 32 * ks, lane);
    f32x4 ga[4];
#pragma unroll
    for (int st = 0; st < 4; ++st) { ga[st] = (f32x4){0.f, 0.f, 0.f, 0.f};
#pragma unroll
        for (int ks = 0; ks < 4; ++ks) ga[st] = mfma16(frag_row(L, BT, PB, 16 * st, 32 * ks, lane), cf[ks], ga[st]); }
    f32x4 y[2][4];
#pragma unroll
    for (int a = 0; a < 2; ++a)
#pragma unroll
        for (int it = 0; it < 4; ++it) y[a][it] = (f32x4){0.f, 0.f, 0.f, 0.f};
#pragma unroll 1
    for (int d = 0; d < 2; ++d) {
        __syncthreads();
#pragma unroll 4
        for (int i = F.tid; i < 8192; i += NTHR) { const int hl = i >> 11, r = i & 2047, row = r >> 5, c4 = (r & 31) * 4;
            const f32x4 v = *(const f32x4*)(F.stss() + ((size_t)(d * 8 + gi * 4 + hl) * NCH + tc) * 8192 + r * 4);
            u32x2 wq; wq.x = pk2(v[0], v[1]); wq.y = pk2(v[2], v[3]); *(LAS u32x2*)(L + SS + hl * 17408 + row * PB + c4 * 2) = wq; }
        __syncthreads();
#pragma unroll
        for (int a = 0; a < 2; ++a) { const int hl = 2 * hp2 + a, wi = d * 4 + hl; const float lat = La[wi * 64 + t];
            float wv[4][4];
#pragma unroll
            for (int st = 0; st < 4; ++st)
#pragma unroll
                for (int e = 0; e < 4; ++e) { const int s = 16 * st + 4 * g + e; const bool valid = d ? (s >= t) : (s <= t);
                    wv[st][e] = valid ? ga[st][e] * __expf(lat - La[wi * 64 + s]) * Dt[wi * 64 + s] : 0.f; }
            const float el = __expf(lat);
#pragma unroll
            for (int it = 0; it < 4; ++it) { f32x4 ia = {0.f, 0.f, 0.f, 0.f};
#pragma unroll
                for (int ks = 0; ks < 4; ++ks) ia = mfma16(frag_row(L, SS + hl * 17408, PB, 16 * it, 32 * ks, lane), cf[ks], ia);
                y[a][it] += el * ia; }
#pragma unroll
            for (int kk = 0; kk < 2; ++kk) { float pv[8];
#pragma unroll
                for (int e = 0; e < 4; ++e) { pv[e] = wv[2 * kk][e]; pv[4 + e] = wv[2 * kk + 1][e]; }
                const bf16x8 pf = pack8(pv);
#pragma unroll
                for (int it = 0; it < 4; ++it) y[a][it] = mfma16(frag_tr(F.lb, XT, PX, 32 * kk + 4 * g, 32 * kk + 16 + 4 * g, hl * 64 + 16 * it, lane), pf, y[a][it]); }
        }
    }
    const size_t tok = (size_t)tc * 64 + t; float ssq = 0.f;
#pragma unroll
    for (int a = 0; a < 2; ++a) { const int hl = 2 * hp2 + a, hh = gi * 4 + hl; const float dsk = p.ssm_d[l * 8 + hh];
#pragma unroll
        for (int it = 0; it < 4; ++it) { const int pi = 16 * it + 4 * g;
            const u32x2 xv = *(LAS u32x2*)(L + XT + t * PX + (hl * 64 + pi) * 2); const u32x2 zv = *(const u32x2*)(F.proj() + tok * NPROJ + ZO + hh * 64 + pi);
            f32x4 v = y[a][it];
            v[0] = (v[0] + dsk * bflo(xv.x)) * siluf(bflo(zv.x)); v[1] = (v[1] + dsk * bfhi(xv.x)) * siluf(bfhi(zv.x));
            v[2] = (v[2] + dsk * bflo(xv.y)) * siluf(bflo(zv.y)); v[3] = (v[3] + dsk * bfhi(xv.y)) * siluf(bfhi(zv.y));
            y[a][it] = v; ssq += v[0] * v[0] + v[1] * v[1] + v[2] * v[2] + v[3] * v[3]; } }
    ssq = gsum4(ssq);
    if (g == 0) Sq[hp2 * 64 + t] = ssq;
    __syncthreads();
    if (l == 0 || tc < 256) {
        const float rstd = rsqrtf((Sq[t] + Sq[64 + t]) * (1.0f / 256.0f) + 1e-6f);
#pragma unroll
        for (int a = 0; a < 2; ++a) { const int hh = gi * 4 + 2 * hp2 + a;
#pragma unroll
            for (int it = 0; it < 4; ++it) { const int c = hh * 64 + 16 * it + 4 * g; const f32x4 nwv = *(const f32x4*)(p.ssm_norm_w + l * 512 + c); const f32x4 v = y[a][it] * rstd * nwv;
                u32x2 wq; wq.x = pk2(v[0], v[1]); wq.y = pk2(v[2], v[3]); *(u32x2*)(F.mix() + tok * 2048 + 1536 + c) = wq; } }
    }
}

DI void phase_scan(const Frame& F) {
    const int gid = F.bid * NTHR + F.tid;
    float* base; const float* dec; int d; bool act = true;
    if ((gid & 1) == 0) { const int item = gid >> 1;
        if (item < 32768) { const int ch = item >> 12, e = item & 4095; base = F.stml() + (size_t)ch * NCH * 16512 + e * 4; dec = F.decml() + ch * NCH; d = ch >> 2; }
        else { const int it2 = item - 32768, ch = it2 >> 11, e = it2 & 2047; base = F.stss() + (size_t)ch * NCH * 8192 + e * 4; dec = F.decss() + ch * NCH; d = ch >> 3; }
    } else { const int item = gid >> 1;
        if (item < 256) { const int ch = item >> 5, e = item & 31; base = F.stml() + (size_t)ch * NCH * 16512 + 16384 + e * 4; dec = F.decml() + ch * NCH; d = ch >> 2; }
        else { act = false; base = F.stml(); dec = F.decml(); d = 0; } }
    if (!act) return;
    const bool isml = ((gid & 1) == 1) || ((gid >> 1) < 32768);
    const size_t stride = isml ? 16512 : 8192;
    f32x4 s = {0.f, 0.f, 0.f, 0.f};
    for (int p0 = 0; p0 < NCH; p0 += 4) {
        f32x4 tmp[4]; float dc[4]; int tcs[4];
#pragma unroll
        for (int j = 0; j < 4; ++j) { const int pp = p0 + j; const int tc = d ? 259 - pp : (pp < 4 ? 256 + pp : pp - 4); tcs[j] = tc;
            tmp[j] = *(const f32x4*)(base + (size_t)tc * stride); dc[j] = dec[tc]; }
#pragma unroll
        for (int j = 0; j < 4; ++j) { *(f32x4*)(base + (size_t)tcs[j] * stride) = s; s = dc[j] * s + tmp[j]; }
    }
}

DI void phase_route(const Params& p, const Frame& F, int l) {
    LAS unsigned char* L = F.L; const int lane = F.lane;
    LAS bf16_t* RW = (LAS bf16_t*)L;
    LAS int* lcnt = (LAS int*)(L + 147456);
    __syncthreads();
    for (int i = F.tid; i < 36 * 2048; i += NTHR) { const int o = i >> 11, k = i & 2047;
        const float v = o < 4 ? p.rg_w[((size_t)l * 2048 + k) * 4 + o] : p.re_w[((size_t)l * 2048 + k) * 32 + (o - 4)];
        RW[o * 2048 + k] = f2bf(v); }
    if (F.tid < 32) lcnt[F.tid] = 0;
    __syncthreads();
    const int nrows = l == 0 ? NT : T;
    const float* modl = F.mod() + (size_t)l * 2 * 12288;
    for (int row = F.bid * 8 + F.wave; row < nrows; row += F.G * 8) {
        const int w = row >= T ? 1 : 0;
        const float* md = modl + (size_t)w * 12288;
        f32x4 v[8]; float ss = 0.f;
#pragma unroll
        for (int j = 0; j < 8; ++j) { v[j] = *(const f32x4*)(F.xbuf() + (size_t)row * 2048 + j * 256 + lane * 4); ss += v[j][0] * v[j][0] + v[j][1] * v[j][1] + v[j][2] * v[j][2] + v[j][3] * v[j][3]; }
        ss = wsum(ss); const float rstd = rsqrtf(ss * (1.0f / 2048.0f) + 1e-6f);
#pragma unroll
        for (int j = 0; j < 8; ++j) { const int c = j * 256 + lane * 4;
            const f32x4 nwv = *(const f32x4*)(p.norm2_w + l * 2048 + c), sc = *(const f32x4*)(md + 4 * 2048 + c), sh = *(const f32x4*)(md + 3 * 2048 + c);
            v[j] = v[j] * rstd * nwv * (1.0f + sc) + sh;
            u32x2 pk; pk.x = pk2(v[j][0], v[j][1]); pk.y = pk2(v[j][2], v[j][3]); *(u32x2*)(F.h() + (size_t)row * 2048 + c) = pk; }
        float mylg = 0.f;
#pragma unroll 2
        for (int o = 0; o < 36; ++o) { float a = 0.f;
#pragma unroll
            for (int j = 0; j < 8; ++j) { const u32x2 wv = *(LAS u32x2*)(RW + o * 2048 + j * 256 + lane * 4);
                a += v[j][0] * bflo(wv.x) + v[j][1] * bfhi(wv.x) + v[j][2] * bflo(wv.y) + v[j][3] * bfhi(wv.y); }
            a = wsum(a); mylg = (lane == o) ? a : mylg; }
        float gl[4];
#pragma unroll
        for (int o = 0; o < 4; ++o) gl[o] = __shfl(mylg, o) + p.rg_b[l * 4 + o];
        int gs = 0; float gm = gl[0];
#pragma unroll
        for (int o = 1; o < 4; ++o) { if (gl[o] > gm) { gm = gl[o]; gs = o; } }
        float gden = 0.f;
#pragma unroll
        for (int o = 0; o < 4; ++o) gden += __expf(gl[o] - gm);
        const float gw = 1.0f / gden;
        float le[8];
#pragma unroll
        for (int i = 0; i < 8; ++i) le[i] = __shfl(mylg, 4 + gs * 8 + i) + p.re_b[l * 32 + gs * 8 + i];
        int i1 = 0; float v1 = le[0];
#pragma unroll
        for (int i = 1; i < 8; ++i) if (le[i] > v1) { v1 = le[i]; i1 = i; }
        int i2 = -1; float v2 = -INFINITY;
#pragma unroll
        for (int i = 0; i < 8; ++i) if (i != i1 && le[i] > v2) { v2 = le[i]; i2 = i; }
        const float w1 = 1.0f / (1.0f + __expf(v2 - v1)), w2 = 1.0f - w1;
        if (lane == 0) { const int e1 = gs * 8 + i1, e2 = gs * 8 + i2;
            const int r1 = atomicAdd((int*)(lcnt + e1), 1), r2 = atomicAdd((int*)(lcnt + e2), 1);
            F.toke()[row * 2] = e1; F.toke()[row * 2 + 1] = e2; F.tokw()[row * 2] = w1 * gw; F.tokw()[row * 2 + 1] = w2 * gw; F.tokr()[row * 2] = r1; F.tokr()[row * 2 + 1] = r2; }
    }
    __syncthreads();
    if (F.tid < 32) F.cnt()[F.bid * 32 + F.tid] = lcnt[F.tid];
}

DI void phase_slot(const Params& p, const Frame& F, int l) {
    LAS int* tot = (LAS int*)F.L; LAS int* pre = tot + 32; LAS int* pst = tot + 64; LAS int* pend = tot + 96;
    __syncthreads();
    if (F.tid < 32) { int t = 0, pr = 0;
#pragma unroll 8
        for (int b = 0; b < F.G; ++b) { const int c = F.cnt()[b * 32 + F.tid]; t += c; pr += (b < F.bid) ? c : 0; } tot[F.tid] = t; pre[F.tid] = pr; }
    __syncthreads();
    if (F.tid == 0) { int acc = 0; for (int e = 0; e < 32; ++e) { pst[e] = acc; acc += (tot[e] + 255) & ~255; pend[e] = acc; } }
    __syncthreads();
    if (F.bid == 0 && F.tid == 0) { int idx = 0; for (int e = 0; e < 32; ++e) { const int nt = (pend[e] - pst[e]) >> 8; for (int k = 0; k < nt; ++k) F.mte()[idx++] = e; } F.mte()[MAXMT] = idx; }
    const int nrows = l == 0 ? NT : T;
    for (int row = F.bid * 8 + F.wave; row < nrows; row += F.G * 8) {
        const int e1 = F.toke()[row * 2], e2 = F.toke()[row * 2 + 1];
        const int s1 = pst[e1] + pre[e1] + F.tokr()[row * 2], s2 = pst[e2] + pre[e2] + F.tokr()[row * 2 + 1];
        if (F.lane == 0) { F.toks()[row * 2] = s1; F.toks()[row * 2 + 1] = s2; F.slotw()[s1] = F.tokw()[row * 2]; F.slotw()[s2] = F.tokw()[row * 2 + 1]; }
#pragma unroll
        for (int j = 0; j < 4; ++j) { const u32x4 v = *(const u32x4*)(F.h() + (size_t)row * 2048 + j * 512 + F.lane * 8);
            *(u32x4*)(F.amoe() + (size_t)s1 * 2048 + j * 512 + F.lane * 8) = v; *(u32x4*)(F.amoe() + (size_t)s2 * 2048 + j * 512 + F.lane * 8) = v; }
    }
    { const int e = F.bid >> 3, part = F.bid & 7;
      if (e < 32) for (int s = pst[e] + tot[e] + part * 8 + F.wave; s < pend[e]; s += 64) {
          if (F.lane == 0) F.slotw()[s] = 0.f;
#pragma unroll
          for (int j = 0; j < 4; ++j) *(u32x4*)(F.amoe() + (size_t)s * 2048 + j * 512 + F.lane * 8) = (u32x4){0u, 0u, 0u, 0u}; } }
}

__global__ void __launch_bounds__(NTHR, 2) fwd_kernel(Params p) {
    extern __shared__ __attribute__((aligned(16))) unsigned char lds_raw[];
    Frame F;
    F.L = (LAS unsigned char*)lds_raw; F.lb = (unsigned)(uintptr_t)F.L;
    F.tid = threadIdx.x; F.lane = F.tid & 63; F.wave = __builtin_amdgcn_readfirstlane(F.tid >> 6); F.bid = blockIdx.x; F.G = gridDim.x;
    unsigned char* ws = p.ws; F.ws = ws;

    volatile LAS unsigned* xbw = (volatile LAS unsigned*)(F.L + LDS_MISC);
    if (F.tid == 0) { xbw[0] = 0u; xbw[1] = 0u; }
    __syncthreads();
    const int lo = p.ph_lo, hi = p.ph_hi;
    const bool multi = (hi - lo) > 1;
    XcdBarrier bar; bar.bar = (unsigned*)(ws + WS_BAR); bar.x = 0; bar.st = xbw;
    if (multi) bar = xcd_barrier_post((unsigned*)(ws + WS_BAR), xbw);
#ifndef PH_MASK
#define PH_MASK 0xFFF
#endif
#ifndef TM
#define TM 31
#endif
#define IN(k) (lo <= (k) && (k) < hi)
#define ON(j) (((PH_MASK) >> (j)) & 1)
#define SEAM(k) do { if (IN(k) && IN((k) + 1)) xcd_barrier(bar); } while (0)

    if (ON(0) && IN(0)) { phase_prologue(p, F.fresh()); } SEAM(0);
    for (int l = 0; l < 2; ++l) {
        const int pb = 1 + 11 * l;
        if (ON(1) && IN(pb + 0)) { if (l == 0) phase_rows<0>(p, F.fresh()); else phase_rows<1>(p, F.fresh()); } SEAM(pb + 0);
        if (ON(2) && IN(pb + 1)) {
            pg8::Gemm g{F.h(), F.win() + (size_t)l * NPAD * 2048, NT, NPAD, 2048}; pg8::StaticOrder S; S.init(NT, NPAD, F.G, F.bid);
            pg8::EpiProj E{F.proj(), F.gates()};
            pg8::gemm_phase<pg8::EpiProj, pg8::StaticOrder>(F.L, g, S, E, nullptr);
        } SEAM(pb + 1);
        if (ON(3) && IN(pb + 2)) { phase_prep(p, F.fresh(), l); } SEAM(pb + 2);
        if (ON(4) && IN(pb + 3)) {
            const Frame Fq = F.fresh(); const int ntask = l == 0 ? 1040 : 1024;
            if (TM & 1) for (int t = F.bid; t < ntask; t += F.G) na_task(p, Fq, l, t);
            if (TM & 2) for (int t = F.bid; t < NCH * 4; t += F.G) ml_state_task(p, Fq, t >> 2, t & 3);
            if (TM & 4) for (int t = F.bid; t < NCH * 2; t += F.G) ss_state_task(p, Fq, l, t >> 1, t & 1);
        } SEAM(pb + 3);
        if (ON(5) && IN(pb + 4)) { phase_scan(F.fresh()); } SEAM(pb + 4);
        if (ON(6) && IN(pb + 5)) {
            const Frame Fq = F.fresh(); const int nc = l == 0 ? NCH : 256;
            if (TM & 8) for (int t = F.bid; t < nc * 4; t += F.G) ml_out_task(p, Fq, l, t >> 2, t & 3);
            if (TM & 16) for (int t = F.bid; t < nc * 2; t += F.G) ss_out_task(p, Fq, l, t >> 1, t & 1);
        } SEAM(pb + 5);
        if (ON(7) && IN(pb + 6)) {
            const int M = l == 0 ? NT : T;
            pg8::Gemm g{F.mix(), F.wout() + (size_t)l * 2048 * 2048, M, 2048, 2048}; pg8::StaticOrder S; S.init(M, 2048, F.G, F.bid);
            const float* gl = F.mod() + ((size_t)l * 2 + 0) * 12288 + 2 * 2048; const float* gc = F.mod() + ((size_t)l * 2 + 1) * 12288 + 2 * 2048;
            pg8::EpiRes E{l == 0 ? p.x : F.xbuf(), l == 0 ? p.ctx : F.xbuf() + (size_t)T * 2048, F.xbuf(), gl, gc};
            pg8::gemm_phase<pg8::EpiRes, pg8::StaticOrder>(F.L, g, S, E, nullptr);
        } SEAM(pb + 6);
        if (ON(8) && IN(pb + 7)) { phase_route(p, F.fresh(), l); } SEAM(pb + 7);
        if (ON(9) && IN(pb + 8)) { phase_slot(p, F.fresh(), l); } SEAM(pb + 8);
        if (ON(10) && IN(pb + 9)) {
            pg8::Gemm g{F.amoe(), F.w13() + (size_t)l * NEXP * 2048 * 2048, NSLOT, 2048, 2048};
            pg8::MoeOrder S{F.mte(), F.mte()[MAXMT] * 8, F.G, F.bid};
            pg8::EpiGateUp E{F.hid()};
            pg8::gemm_phase<pg8::EpiGateUp, pg8::MoeOrder>(F.L, g, S, E, nullptr);
        } SEAM(pb + 9);
        if (ON(11) && IN(pb + 10)) {
            pg8::Gemm g{F.hid(), F.w2() + (size_t)l * NEXP * 2048 * 1024, NSLOT, 2048, 1024};
            pg8::MoeOrder S{F.mte(), F.mte()[MAXMT] * 8, F.G, F.bid};
            pg8::EpiDown E{F.ymoe(), F.slotw()};
            pg8::gemm_phase<pg8::EpiDown, pg8::MoeOrder>(F.L, g, S, E, nullptr);
        } SEAM(pb + 10);
    }
    if (ON(1) && IN(23)) { phase_rows<2>(p, F.fresh()); }
#undef IN
#undef SEAM
}

constexpr int NPHASE = 24;
#ifndef N_LAUNCH_MODE
#define N_LAUNCH_MODE 0
#endif

extern "C" void kernel_launch(void* const* d_in, const int* in_sizes, int n_in, void* d_out, int out_size, void* d_ws, size_t ws_size, hipStream_t stream) {
    static int grid = 0;
    if (grid == 0) {
        if (n_in != 27 || ws_size < WS_END) { fprintf(stderr, "kernel_launch: unexpected inputs (n_in %d) or workspace %zu < %zu\n", n_in, ws_size, (size_t)WS_END); grid = -1; return; }
        int dev = 0, cus = 0, per_cu = 0;
        hipGetDevice(&dev); hipDeviceGetAttribute(&cus, hipDeviceAttributeMultiprocessorCount, dev);
        if (hipFuncSetAttribute((const void*)fwd_kernel, hipFuncAttributeMaxDynamicSharedMemorySize, LDS_BYTES) != hipSuccess) { fprintf(stderr, "kernel_launch: hipFuncSetAttribute failed\n"); grid = -1; return; }
        hipOccupancyMaxActiveBlocksPerMultiprocessor(&per_cu, (const void*)fwd_kernel, NTHR, LDS_BYTES);
        (void)hipGetLastError();
        if (cus < 256 || per_cu < 1) { fprintf(stderr, "kernel_launch: needs 256 CUs with one resident workgroup each (cus %d, per_cu %d)\n", cus, per_cu); grid = -1; return; }
        grid = 256;
    }
    if (grid < 0) return;
    hipMemsetAsync((char*)d_ws + WS_BAR, 0, 65536, stream);
    Params p{};
    const float** pp = (const float**)&p;
    for (int i = 0; i < 27; ++i) pp[i] = (const float*)d_in[i];
    p.out = (float*)d_out; p.ws = (unsigned char*)d_ws;
#if N_LAUNCH_MODE == 1
    p.ph_lo = 0; p.ph_hi = NPHASE;
    hipLaunchKernelGGL(fwd_kernel, dim3(grid), dim3(NTHR), LDS_BYTES, stream, p);
#else
    for (int ph = 0; ph < NPHASE; ++ph) { p.ph_lo = ph; p.ph_hi = ph + 1; hipLaunchKernelGGL(fwd_kernel, dim3(grid), dim3(NTHR), LDS_BYTES, stream, p); }
#endif
}
```

```cpp
#include <hip/hip_runtime.h>
#include <stdint.h>
#include <stdio.h>

#ifdef PROBE_LIST
#define DBG(x) (p.pad & (x))
#else
#define DBG(x) 0
#endif
#define LAS __attribute__((address_space(3)))
#define DI __device__ __forceinline__
typedef unsigned short bf16_t;
typedef short bf16x8 __attribute__((ext_vector_type(8)));
typedef short bf16x4 __attribute__((ext_vector_type(4)));
typedef float f32x4 __attribute__((ext_vector_type(4)));
typedef float f32x2 __attribute__((ext_vector_type(2)));
typedef unsigned u32x4 __attribute__((ext_vector_type(4)));
typedef unsigned u32x2 __attribute__((ext_vector_type(2)));
typedef __bf16 bfv2 __attribute__((ext_vector_type(2)));

constexpr int D = 2048, T = 16384, CTXL = 256, NT = T + CTXL;
constexpr int INC = 6688, NPROJ = 6656, NPAD = 6912;
constexpr int QO = 0, KO = 1024, VO = 2048, MQO = 3072, MKO = 3584, MVO = 4096, MOO = 4608, ZO = 5120, XBO = 5632;
constexpr int NCH = 260;
constexpr int NEXP = 32, FF = 1024;
constexpr int MAXMT = 162, NSLOT = MAXMT * 256;
constexpr int NTHR = 512;
constexpr int LDS_BYTES = 155648;
constexpr int LDS_MISC = LDS_BYTES - 256;

constexpr size_t al256(size_t x) { return (x + 255) & ~(size_t)255; }
constexpr size_t WS_BAR   = 0;
constexpr size_t WS_MODP  = 65536;
constexpr size_t WS_MOD   = WS_MODP  + al256((size_t)2 * 8 * 2 * 12288 * 4);
constexpr size_t WS_ROPE  = WS_MOD   + al256((size_t)2 * 2 * 12288 * 4);
constexpr size_t WS_TOKE  = WS_ROPE  + al256((size_t)(256 + 64) * 32 * 2 * 4);
constexpr size_t WS_TOKW  = WS_TOKE  + al256((size_t)NT * 2 * 4);
constexpr size_t WS_TOKR  = WS_TOKW  + al256((size_t)NT * 2 * 4);
constexpr size_t WS_TOKS  = WS_TOKR  + al256((size_t)NT * 2 * 4);
constexpr size_t WS_CNT   = WS_TOKS  + al256((size_t)NT * 2 * 4);
constexpr size_t WS_MTE   = WS_CNT   + al256((size_t)256 * 32 * 4);
constexpr size_t WS_SLOTW = WS_MTE   + al256((size_t)(MAXMT + 2) * 4);
constexpr size_t WS_GATES = WS_SLOTW + al256((size_t)NSLOT * 4);
constexpr size_t WS_MLG   = WS_GATES + al256((size_t)NT * 32 * 4);
constexpr size_t WS_DT    = WS_MLG   + al256((size_t)NT * 16 * 4);
constexpr size_t WS_DECML = WS_DT    + al256((size_t)NT * 16 * 4);
constexpr size_t WS_DECSS = WS_DECML + al256((size_t)8 * NCH * 4);
constexpr size_t WS_RWT   = WS_DECSS + al256((size_t)16 * NCH * 4);
constexpr size_t WS_WIN   = WS_RWT   + al256((size_t)2 * 36 * 2048 * 2);
constexpr size_t WS_WOUT  = WS_WIN   + (size_t)2 * NPAD * D * 2;
constexpr size_t WS_W13   = WS_WOUT  + (size_t)2 * D * D * 2;
constexpr size_t WS_W2    = WS_W13   + (size_t)2 * NEXP * 2048 * D * 2;
constexpr size_t WS_H     = WS_W2    + (size_t)2 * NEXP * D * FF * 2;
constexpr size_t WS_XBUF  = WS_H     + (size_t)NT * D * 2;
constexpr size_t WS_PROJ  = WS_XBUF  + (size_t)NT * D * 4;
constexpr size_t WS_XBCC  = WS_PROJ  + (size_t)NT * NPROJ * 2;
constexpr size_t WS_MIX   = WS_XBCC  + (size_t)NT * 1024 * 2;
constexpr size_t WS_STML  = WS_MIX   + (size_t)NT * D * 2;
constexpr size_t WS_STSS  = WS_STML  + (size_t)8 * NCH * 16512 * 4;
constexpr size_t WS_END   = WS_STSS  + (size_t)16 * NCH * 8192 * 4;
constexpr size_t WS_AMOE  = WS_PROJ;
constexpr size_t WS_HID   = WS_AMOE + (size_t)NSLOT * D * 2;
constexpr size_t WS_YMOE  = WS_MIX;
static_assert(WS_HID + (size_t)NSLOT * FF * 2 <= WS_MIX, "moe alias 1");
static_assert(WS_YMOE + (size_t)NSLOT * D * 2 <= WS_STSS, "moe alias 2");

struct Params {
    const float *x, *c, *ctx, *c_ctx, *w_mod, *b_mod, *norm1_w, *norm2_w, *w_in, *w_out, *na_rpb, *ml_gate_b, *ml_norm_w,
                *conv_w, *conv_b, *dt_bias, *a_log, *ssm_d, *ssm_norm_w, *rg_w, *rg_b, *re_w, *re_b, *w1, *w3, *w2, *final_w;
    float* out; unsigned char* ws; int ph_lo, ph_hi, tmask, pad;
};

DI unsigned pk2(float lo, float hi) { f32x2 v = {lo, hi}; bfv2 b = __builtin_convertvector(v, bfv2); return __builtin_bit_cast(unsigned, b); }
DI float bflo(unsigned u) { return __uint_as_float(u << 16); }
DI float bfhi(unsigned u) { return __uint_as_float(u & 0xffff0000u); }
DI float bf2f(bf16_t b) { return __uint_as_float(((unsigned)b) << 16); }
DI bf16_t f2bf(float f) { return (bf16_t)(pk2(f, 0.f) & 0xffffu); }
DI float wsum(float v) { v += __shfl_xor(v, 32); v += __shfl_xor(v, 16); v += __shfl_xor(v, 8); v += __shfl_xor(v, 4); v += __shfl_xor(v, 2); v += __shfl_xor(v, 1); return v; }
DI float gsum4(float v) { v += __shfl_xor(v, 16); v += __shfl_xor(v, 32); return v; }
DI f32x4 mfma16(bf16x8 a, bf16x8 b, f32x4 c) { return __builtin_amdgcn_mfma_f32_16x16x32_bf16(a, b, c, 0, 0, 0); }
DI float siluf(float v) { return v / (1.0f + __expf(-v)); }
DI float sigmf(float v) { return 1.0f / (1.0f + __expf(-v)); }
DI bf16x8 pack8(const float (&v)[8]) { u32x4 p; p.x = pk2(v[0], v[1]); p.y = pk2(v[2], v[3]); p.z = pk2(v[4], v[5]); p.w = pk2(v[6], v[7]); return __builtin_bit_cast(bf16x8, p); }
DI void unpack8(u32x4 u, float (&v)[8]) { v[0] = bflo(u.x); v[1] = bfhi(u.x); v[2] = bflo(u.y); v[3] = bfhi(u.y); v[4] = bflo(u.z); v[5] = bfhi(u.z); v[6] = bflo(u.w); v[7] = bfhi(u.w); }
DI bf16x8 frag_row(LAS unsigned char* L, unsigned tb, unsigned pb, int r0, int k0, int lane) {
    return *(LAS bf16x8*)(L + tb + (unsigned)(r0 + (lane & 15)) * pb + (unsigned)(k0 + 8 * (lane >> 4)) * 2u);
}
DI bf16x8 frag_tr(unsigned lbase, unsigned tb, unsigned pb, int rA, int rB, int c0, int lane) {
    const int q = (lane & 15) >> 2, pq = lane & 3;
    const unsigned a0 = lbase + tb + (unsigned)(rA + q) * pb + (unsigned)(c0 + 4 * pq) * 2u;
    const unsigned a1 = lbase + tb + (unsigned)(rB + q) * pb + (unsigned)(c0 + 4 * pq) * 2u;
    bf16x4 lo, hi;
    asm volatile("ds_read_b64_tr_b16 %0, %2\n\tds_read_b64_tr_b16 %1, %3\n\ts_waitcnt lgkmcnt(0)" : "=&v"(lo), "=&v"(hi) : "v"(a0), "v"(a1) : "memory");
    bf16x8 r; r[0] = lo[0]; r[1] = lo[1]; r[2] = lo[2]; r[3] = lo[3]; r[4] = hi[0]; r[5] = hi[1]; r[6] = hi[2]; r[7] = hi[3]; return r;
}
DI float wscan(float v, int rev, int lane) {
#pragma unroll
    for (int off = 1; off < 64; off <<= 1) {
        const float t = rev ? __shfl_down(v, off) : __shfl_up(v, off);
        const bool ok = rev ? (lane + off < 64) : (lane >= off);
        v += ok ? t : 0.f;
    }
    return v;
}
DI void frag_tr_x4(bf16x8 (&f)[4], unsigned lbase, unsigned tb, unsigned pb, int rA, int rB, int c0, int lane) {
    const int q = (lane & 15) >> 2, pq = lane & 3;
    const unsigned a0 = lbase + tb + (unsigned)(rA + q) * pb + (unsigned)(c0 + 4 * pq) * 2u;
    const unsigned a1 = lbase + tb + (unsigned)(rB + q) * pb + (unsigned)(c0 + 4 * pq) * 2u;
    bf16x4 l0, l1, l2, l3, h0, h1, h2, h3;
    asm volatile("ds_read_b64_tr_b16 %0, %8\n\tds_read_b64_tr_b16 %1, %8 offset:32\n\tds_read_b64_tr_b16 %2, %8 offset:64\n\tds_read_b64_tr_b16 %3, %8 offset:96\n\t"
                 "ds_read_b64_tr_b16 %4, %9\n\tds_read_b64_tr_b16 %5, %9 offset:32\n\tds_read_b64_tr_b16 %6, %9 offset:64\n\tds_read_b64_tr_b16 %7, %9 offset:96\n\ts_waitcnt lgkmcnt(0)"
                 : "=&v"(l0), "=&v"(l1), "=&v"(l2), "=&v"(l3), "=&v"(h0), "=&v"(h1), "=&v"(h2), "=&v"(h3) : "v"(a0), "v"(a1) : "memory");
    f[0] = __builtin_shufflevector(l0, h0, 0, 1, 2, 3, 4, 5, 6, 7); f[1] = __builtin_shufflevector(l1, h1, 0, 1, 2, 3, 4, 5, 6, 7);
    f[2] = __builtin_shufflevector(l2, h2, 0, 1, 2, 3, 4, 5, 6, 7); f[3] = __builtin_shufflevector(l3, h3, 0, 1, 2, 3, 4, 5, 6, 7);
}
DI unsigned pk4_fp8(float a, float b, float c, float d) { int w = 0; w = __builtin_amdgcn_cvt_pk_fp8_f32(a, b, w, false); w = __builtin_amdgcn_cvt_pk_fp8_f32(c, d, w, true); return (unsigned)w; }
constexpr float FS_W13 = 64.f, FS_W2 = 32.f, FS_X = 4.f, FS_Y = 16.f;
constexpr int SC_W13 = 127 - 4, SC_W2 = 127 - 4, SC_X = 127 - 4, SC_X2 = 127 - 3;
DI f32x4 unpk4_fp8(unsigned w) { const f32x2 lo = __builtin_amdgcn_cvt_pk_f32_fp8((int)w, false), hi = __builtin_amdgcn_cvt_pk_f32_fp8((int)w, true); return (f32x4){lo[0], lo[1], hi[0], hi[1]}; }

namespace pg8 {
#define PG8_LAS __attribute__((address_space(3)))
typedef unsigned short bf16_t;
typedef short bf16x8 __attribute__((ext_vector_type(8)));
typedef float f32x4 __attribute__((ext_vector_type(4)));
typedef unsigned u32x4 __attribute__((ext_vector_type(4)));
constexpr int BM = 256, BK = 64, HALF = 128, HTB = HALF * BK * 2, STAGE_BYTES = 8 * HTB, NXCD = 8, WGM = 8;
__host__ __device__ __forceinline__ int lds_byte(int r, int c) { const int st = (r >> 4) * 2 + (c >> 5), rr = r & 15, cc = c & 31, ob = rr * 64 + cc * 2; return st * 1024 + (ob ^ (((ob >> 9) & 1) << 5)); }
__host__ __device__ __forceinline__ void stage_rc(int b, int& R, int& C) { const int st = b / 1024, sb = b % 1024, swz = sb ^ (((sb >> 9) & 1) << 5); R = (st >> 1) * 16 + swz / 64; C = (st & 1) * 32 + (swz % 64) / 2; }
__host__ __device__ __forceinline__ int perm32(int rho) { const int n = rho >> 4, i = rho & 15; return 8 * (i >> 2) + 4 * n + (i & 3); }
struct Unit { int pm, pn; };
struct Gemm { const bf16_t* A; const bf16_t* Bt; int M, N, K; };
struct StaticOrder {
    int nM, nN, nwg, G, c;
    __host__ __device__ void init(int M, int N, int G_, int c_) { nM = M / BM; nN = N / BM; nwg = nM * nN; G = G_; c = c_; }
    __host__ __device__ bool next(int i, Unit& u) const {
        const long L = (long)i * G + c; if (L >= nwg) return false;
        int wgid = (int)L; { const int q = nwg / NXCD, r = nwg % NXCD, xcd = wgid % NXCD, off = wgid / NXCD; wgid = (xcd < r ? xcd * (q + 1) : r * (q + 1) + (xcd - r) * q) + off; }
        const int nig = WGM * nN, gid = wgid / nig, fm = gid * WGM, gsz = (nM - fm) < WGM ? (nM - fm) : WGM;
        u.pm = fm + ((wgid % nig) % gsz); u.pn = (wgid % nig) / gsz; return true;
    }
    __device__ __forceinline__ void a_ready(const Unit&) const {}
    __device__ __forceinline__ void done(const Unit&) const {}
};
struct MoeOrder {
    const int* mte; int nunits, G, c;
    __device__ bool next(int i, Unit& u) const { const int L = i * G + c; if (L >= nunits) return false; const int mt = L >> 3; u.pm = mt; u.pn = mte[mt] * 8 + (L & 7); return true; }
    __device__ __forceinline__ void a_ready(const Unit&) const {}
    __device__ __forceinline__ void done(const Unit&) const {}
};
DI unsigned pk2(float lo, float hi) { return ::pk2(lo, hi); }
DI unsigned pk4_fp8(float a, float b, float c, float d) { return ::pk4_fp8(a, b, c, d); }
using ::FS_X; using ::FS_Y;

struct EpiProj {
    static constexpr bool PERM = true, AFTER_DRAIN = false;
    bf16_t* O; float* gates;
    __device__ __forceinline__ void operator()(const f32x4 (&acc)[2][2][4][2], const Unit& u, int wr, int wc, int fr, int fq) const {
        const int row0 = u.pm * BM + wr * 64 + fr;
        if (u.pn < 26) {
            const int col0 = u.pn * BM + wc * 32 + 8 * fq;
#pragma unroll
            for (int ai = 0; ai < 2; ++ai)
#pragma unroll
                for (int m = 0; m < 4; ++m) { bf16_t* rowp = O + (size_t)(row0 + ai * HALF + m * 16) * 6656 + col0;
#pragma unroll
                    for (int bj = 0; bj < 2; ++bj) { const f32x4 v0 = acc[ai][bj][m][0], v1 = acc[ai][bj][m][1];
                        u32x4 w; w.x = pk2(v0[0], v0[1]); w.y = pk2(v0[2], v0[3]); w.z = pk2(v1[0], v1[1]); w.w = pk2(v1[2], v1[3]);
                        *(u32x4*)(rowp + bj * HALF) = w; } }
        } else if (wc == 0) {
#pragma unroll
            for (int ai = 0; ai < 2; ++ai)
#pragma unroll
                for (int m = 0; m < 4; ++m) { float* rowp = gates + (size_t)(row0 + ai * HALF + m * 16) * 32 + 8 * fq;
                    *(f32x4*)(rowp) = acc[ai][0][m][0]; *(f32x4*)(rowp + 4) = acc[ai][0][m][1]; }
        }
    }
};
template <bool BF32> struct EpiRes {
    static constexpr bool PERM = true, AFTER_DRAIN = false;
    const float* base_lat; const float* base_ctx; bf16_t* out; const float* g_lat; const float* g_ctx;
    __device__ __forceinline__ void operator()(const f32x4 (&acc)[2][2][4][2], const Unit& u, int wr, int wc, int fr, int fq) const {
        const bool isctx = u.pm >= 64;
        const float* base = isctx ? base_ctx - (size_t)16384 * 2048 : base_lat; const float* gv = isctx ? g_ctx : g_lat;
        const int row0 = u.pm * BM + wr * 64 + fr, col0 = u.pn * BM + wc * 32 + 8 * fq;
        f32x4 gg[2][2];
#pragma unroll
        for (int bj = 0; bj < 2; ++bj)
#pragma unroll
            for (int n = 0; n < 2; ++n) gg[bj][n] = *(const f32x4*)(gv + col0 + bj * HALF + n * 4);
#pragma unroll
        for (int ai = 0; ai < 2; ++ai)
#pragma unroll
            for (int m = 0; m < 4; ++m) { const size_t off = (size_t)(row0 + ai * HALF + m * 16) * 2048 + col0;
#pragma unroll
                for (int bj = 0; bj < 2; ++bj) { f32x4 b0, b1;
                    if constexpr (BF32) { b0 = *(const f32x4*)(base + off + bj * HALF); b1 = *(const f32x4*)(base + off + bj * HALF + 4); }
                    else { const u32x4 q = *(const u32x4*)(out + off + bj * HALF); b0 = (f32x4){__uint_as_float(q.x << 16), __uint_as_float(q.x & 0xffff0000u), __uint_as_float(q.y << 16), __uint_as_float(q.y & 0xffff0000u)};
                           b1 = (f32x4){__uint_as_float(q.z << 16), __uint_as_float(q.z & 0xffff0000u), __uint_as_float(q.w << 16), __uint_as_float(q.w & 0xffff0000u)}; }
                    const f32x4 v0 = b0 + gg[bj][0] * acc[ai][bj][m][0], v1 = b1 + gg[bj][1] * acc[ai][bj][m][1];
                    u32x4 w; w.x = pk2(v0[0], v0[1]); w.y = pk2(v0[2], v0[3]); w.z = pk2(v1[0], v1[1]); w.w = pk2(v1[2], v1[3]);
                    *(u32x4*)(out + off + bj * HALF) = w; } }
    }
};
struct EpiGateUp {
    static constexpr bool PERM = true, AFTER_DRAIN = false;
    unsigned char* O;
    __device__ __forceinline__ void operator()(const f32x4 (&acc)[2][2][4][2], const Unit& u, int wr, int wc, int fr, int fq) const {
        const int row0 = u.pm * BM + wr * 64 + fr, col0 = (u.pn & 7) * 128 + wc * 32 + 8 * fq;
#pragma unroll
        for (int ai = 0; ai < 2; ++ai)
#pragma unroll
            for (int m = 0; m < 4; ++m) { float h[8];
#pragma unroll
                for (int n = 0; n < 2; ++n)
#pragma unroll
                    for (int j = 0; j < 4; ++j) { const float gt = acc[ai][0][m][n][j], up = acc[ai][1][m][n][j]; h[n * 4 + j] = gt / (1.0f + __expf(-gt)) * up * FS_X; }
                u32x2 w; w.x = pk4_fp8(h[0], h[1], h[2], h[3]); w.y = pk4_fp8(h[4], h[5], h[6], h[7]);
                *(u32x2*)(O + (size_t)(row0 + ai * HALF + m * 16) * 1024 + col0) = w; }
    }
};
struct EpiDown {
    static constexpr bool PERM = true, AFTER_DRAIN = false;
    unsigned char* O; const float* sw;
    __device__ __forceinline__ void operator()(const f32x4 (&acc)[2][2][4][2], const Unit& u, int wr, int wc, int fr, int fq) const {
        const int row0 = u.pm * BM + wr * 64 + fr, col0 = (u.pn & 7) * BM + wc * 32 + 8 * fq;
#pragma unroll
        for (int ai = 0; ai < 2; ++ai)
#pragma unroll
            for (int m = 0; m < 4; ++m) { const int row = row0 + ai * HALF + m * 16; const float s = sw[row] * FS_Y; unsigned char* rowp = O + (size_t)row * 2048 + col0;
#pragma unroll
                for (int bj = 0; bj < 2; ++bj) { const f32x4 v0 = acc[ai][bj][m][0] * s, v1 = acc[ai][bj][m][1] * s;
                    u32x2 w; w.x = pk4_fp8(v0[0], v0[1], v0[2], v0[3]); w.y = pk4_fp8(v1[0], v1[1], v1[2], v1[3]);
                    *(u32x2*)(rowp + bj * HALF) = w; } }
    }
};

template <class Epi, class Sched, bool STAMP = false, int ES = 2, int SCW = 127, int SCX = 127>
__device__ __forceinline__ void gemm_phase(PG8_LAS unsigned char* lds, const Gemm g, const Sched& S, const Epi& E, unsigned long long* stamps) {
    int tid_ = threadIdx.x; asm volatile("" : "+v"(tid_)); const int tid = tid_, wid = __builtin_amdgcn_readfirstlane(tid >> 6), lane = tid & 63, wr = wid >> 2, wc = wid & 3, fr = lane & 15, fq = lane >> 4;
    const int K = g.K * ES / 2  , nt = K / BK;
    int ts_lo = 0, ts_hi = 0, nts = 0; const unsigned long long rt_entry = STAMP ? (unsigned long long)wall_clock64() : 0ull;
#define PG8_STAMP() do { if (STAMP && wid == 0 && nts < 64) { const unsigned long long _c = (unsigned long long)clock64(); \
        ts_lo = (lane == nts) ? (int)(unsigned)_c : ts_lo; ts_hi = (lane == nts) ? (int)(unsigned)(_c >> 32) : ts_hi; ++nts; } } while (0)
    PG8_STAMP();
    unsigned voffA[2], voffB[2];
#pragma unroll
    for (int i = 0; i < 2; ++i) { int R, C; stage_rc(tid * 16 + i * 8192, R, C); const int Rb = Epi::PERM ? ((R & ~31) + perm32(R & 31)) : R;
        voffA[i] = (unsigned)(R * K + C) * 2u; voffB[i] = (unsigned)(Rb * K + C) * 2u; }
    const size_t kstep = (size_t)(BK * 2);
    const size_t hstep = (size_t)HALF * K * 2;
    const size_t tstep = 2 * hstep;
    const unsigned ldsw = (unsigned)wid * 1024u;
    const int aoff = lds_byte(wr * 64 + fr, fq * 8), boff = lds_byte(wc * 32 + fr, fq * 8);
#define PG8_SA(b, h) (((b) * 2 + (h)) * HTB)
#define PG8_SB(b, h) ((4 + (b) * 2 + (h)) * HTB)
#define PG8_STAGE(bufoff, gbase, voff) do { _Pragma("unroll") for (int _i = 0; _i < 2; ++_i) \
        __builtin_amdgcn_global_load_lds((const unsigned*)((const char*)(gbase) + (voff)[_i]), (PG8_LAS unsigned*)(lds + (bufoff) + ldsw + _i * 8192), 16, 0, 0); } while (0)
#define PG8_LDA(dst, b, h) do { _Pragma("unroll") for (int m = 0; m < 4; ++m) { \
        if constexpr (ES == 2) { _Pragma("unroll") for (int k = 0; k < 2; ++k) dst[m][k] = *(const PG8_LAS bf16x8*)(lds + PG8_SA(b, h) + aoff + m * 2048 + k * 1024); } \
        else { const v4i_ lo_ = *(const PG8_LAS v4i_*)(lds + PG8_SA(b, h) + aoff + m * 2048), hi_ = *(const PG8_LAS v4i_*)(lds + PG8_SA(b, h) + aoff + m * 2048 + 1024); dst##8[m] = __builtin_shufflevector(lo_, hi_, 0, 1, 2, 3, 4, 5, 6, 7); } } } while (0)
#define PG8_LDB(dst, b, h) do { _Pragma("unroll") for (int n = 0; n < 2; ++n) { \
        if constexpr (ES == 2) { _Pragma("unroll") for (int k = 0; k < 2; ++k) dst[n][k] = *(const PG8_LAS bf16x8*)(lds + PG8_SB(b, h) + boff + n * 2048 + k * 1024); } \
        else { const v4i_ lo_ = *(const PG8_LAS v4i_*)(lds + PG8_SB(b, h) + boff + n * 2048), hi_ = *(const PG8_LAS v4i_*)(lds + PG8_SB(b, h) + boff + n * 2048 + 1024); dst##8[n] = __builtin_shufflevector(lo_, hi_, 0, 1, 2, 3, 4, 5, 6, 7); } } } while (0)
#define PG8_MMA(ai, bj, At, Bt) do { __builtin_amdgcn_s_setprio(1); _Pragma("unroll") for (int m = 0; m < 4; ++m) _Pragma("unroll") for (int n = 0; n < 2; ++n) { \
        if constexpr (ES == 2) { _Pragma("unroll") for (int k = 0; k < 2; ++k) acc[ai][bj][m][n] = __builtin_amdgcn_mfma_f32_16x16x32_bf16(Bt[n][k], At[m][k], acc[ai][bj][m][n], 0, 0, 0); } \
        else asm volatile("v_mfma_scale_f32_16x16x128_f8f6f4 %0, %1, %2, %0, %3, %4 op_sel_hi:[0,0,0]" : "+v"(acc[ai][bj][m][n]) : "v"(Bt##8[n]), "v"(At##8[m]), "v"(scw_), "v"(scx_)); } \
        __builtin_amdgcn_s_setprio(0); } while (0)
#define PG8_WAIT_V(n) asm volatile("s_waitcnt vmcnt(" #n ")" ::: "memory")
#define PG8_WAIT_L(n) asm volatile("s_waitcnt lgkmcnt(" #n ")" ::: "memory")
#define PG8_BAR __builtin_amdgcn_s_barrier()
#define PG8_SCHED __builtin_amdgcn_sched_barrier(0)
    Unit cur, nxt; int ui = 0;
    if (!S.next(0, cur)) return;
    f32x4 acc[2][2][4][2];
#pragma unroll
    for (int a = 0; a < 2; ++a)
#pragma unroll
        for (int b = 0; b < 2; ++b)
#pragma unroll
            for (int m = 0; m < 4; ++m)
#pragma unroll
                for (int n = 0; n < 2; ++n) acc[a][b][m][n] = (f32x4){0.f, 0.f, 0.f, 0.f};
    typedef int v4i_ __attribute__((ext_vector_type(4))); typedef int v8i_ __attribute__((ext_vector_type(8)));
    bf16x8 At[4][2], B0[2][2], B1[2][2]; v8i_ At8[4], B08[2], B18[2]; const int scw_ = SCW * 0x01010101, scx_ = SCX * 0x01010101;
    const char* cA = (const char*)g.A + (size_t)cur.pm * tstep; const char* cB = (const char*)g.Bt + (size_t)cur.pn * tstep;
    S.a_ready(cur);
    PG8_STAGE(PG8_SB(0, 0), cB, voffB); PG8_STAGE(PG8_SA(0, 0), cA, voffA); PG8_STAGE(PG8_SB(0, 1), cB + hstep, voffB); PG8_STAGE(PG8_SA(0, 1), cA + hstep, voffA);
    if (wr == 1) PG8_BAR;
    PG8_WAIT_V(4); PG8_BAR;
    PG8_STAGE(PG8_SB(1, 0), cB + kstep, voffB); PG8_STAGE(PG8_SA(1, 0), cA + kstep, voffA); PG8_STAGE(PG8_SB(1, 1), cB + hstep + kstep, voffB);
    PG8_WAIT_V(6); PG8_BAR;
    PG8_STAMP();
    for (;;) {
        const bool has_next = S.next(ui + 1, nxt);
        const char* nA = has_next ? (const char*)g.A + (size_t)nxt.pm * tstep : cA; const char* nB = has_next ? (const char*)g.Bt + (size_t)nxt.pn * tstep : cB;
        for (int t = 0; t < nt; t += 2) {
            const bool last = (t == nt - 2);
            const char* a1 = cA + (size_t)(t + 1) * kstep;
            const char* a2 = last ? nA : cA + (size_t)(t + 2) * kstep; const char* b2 = last ? nB : cB + (size_t)(t + 2) * kstep;
            const char* a3 = a2 + kstep; const char* b3 = b2 + kstep;
            if (last && has_next) S.a_ready(nxt);
            PG8_LDB(B0, 0, 0); PG8_SCHED; PG8_LDA(At, 0, 0); PG8_STAGE(PG8_SA(1, 1), a1 + hstep, voffA);
            PG8_WAIT_L(8); PG8_BAR; PG8_WAIT_L(0); PG8_MMA(0, 0, At, B0); PG8_BAR; PG8_SCHED;
            PG8_LDB(B1, 0, 1); PG8_STAGE(PG8_SB(0, 0), b2, voffB);
            PG8_BAR; PG8_WAIT_L(0); PG8_MMA(0, 1, At, B1); PG8_BAR;
            PG8_LDA(At, 0, 1); PG8_STAGE(PG8_SA(0, 0), a2, voffA);
            PG8_BAR; PG8_WAIT_L(0); PG8_MMA(1, 0, At, B0); PG8_BAR; PG8_SCHED;
            PG8_STAGE(PG8_SB(0, 1), b2 + hstep, voffB);
            PG8_WAIT_V(6); PG8_BAR; PG8_MMA(1, 1, At, B1); PG8_BAR;
            PG8_LDB(B0, 1, 0); PG8_SCHED; PG8_LDA(At, 1, 0); PG8_STAGE(PG8_SA(0, 1), a2 + hstep, voffA);
            PG8_WAIT_L(8); PG8_BAR; PG8_WAIT_L(0); PG8_MMA(0, 0, At, B0); PG8_BAR; PG8_SCHED;
            PG8_LDB(B1, 1, 1); PG8_STAGE(PG8_SB(1, 0), b3, voffB);
            PG8_BAR; PG8_WAIT_L(0); PG8_MMA(0, 1, At, B1); PG8_BAR;
            PG8_LDA(At, 1, 1); PG8_STAGE(PG8_SA(1, 0), a3, voffA);
            PG8_BAR; PG8_WAIT_L(0); PG8_MMA(1, 0, At, B0); PG8_BAR; PG8_SCHED;
            PG8_STAGE(PG8_SB(1, 1), b3 + hstep, voffB);
            PG8_WAIT_V(6); PG8_BAR; PG8_MMA(1, 1, At, B1); PG8_BAR;
        }
        PG8_STAMP();
        if constexpr (ES == 1) { asm volatile("s_nop 15\n\ts_nop 15\n\ts_nop 15" ::: "memory"); __builtin_amdgcn_sched_barrier(0); }
        if constexpr (!Epi::AFTER_DRAIN) { E(acc, cur, wr, wc, fr, fq); S.done(cur); }
        PG8_STAMP();
        if (!has_next) break;
#pragma unroll
        for (int a = 0; a < 2; ++a)
#pragma unroll
            for (int b = 0; b < 2; ++b)
#pragma unroll
                for (int m = 0; m < 4; ++m)
#pragma unroll
                    for (int n = 0; n < 2; ++n) acc[a][b][m][n] = (f32x4){0.f, 0.f, 0.f, 0.f};
        cur = nxt; cA = nA; cB = nB; ++ui;
    }
    PG8_WAIT_V(0);
    if (wr == 0) PG8_BAR;
    PG8_BAR;
    if constexpr (Epi::AFTER_DRAIN) { E.fused(acc, cur, wr, wc, fr, fq, lds, wid, lane); S.done(cur); }
    PG8_STAMP();
    if (STAMP && wid == 0) { stamps[lane] = lane < nts ? (((unsigned long long)(unsigned)ts_hi << 32) | (unsigned)ts_lo) : 0ull;
        if (lane == 62) stamps[62] = rt_entry; if (lane == 63) stamps[63] = (unsigned long long)wall_clock64(); }
#undef PG8_STAMP
#undef PG8_SA
#undef PG8_SB
#undef PG8_STAGE
#undef PG8_LDA
#undef PG8_LDB
#undef PG8_MMA
#undef PG8_WAIT_V
#undef PG8_WAIT_L
#undef PG8_BAR
#undef PG8_SCHED
}
}

#define XB_TMO      128
#define XB_XCNT(j)  (256  + 64 * (j))
#define XB_XSUB(j)  (1280 + 64 * (j))
#define XB_XGEN(j)  (2304 + 64 * (j))
#define XB_TOP      3328
#define XB_TOPGEN   3392
#define XCD_BAR_WORDS 3456
#define XB_SPIN_CAP (1u << 18)
__device__ __forceinline__ unsigned xb_ld(unsigned* p)              { return __hip_atomic_load(p, __ATOMIC_RELAXED, __HIP_MEMORY_SCOPE_AGENT); }
__device__ __forceinline__ unsigned xb_add(unsigned* p, unsigned v) { return __hip_atomic_fetch_add(p, v, __ATOMIC_RELAXED, __HIP_MEMORY_SCOPE_AGENT); }
__device__ __forceinline__ unsigned xb_xcc_id() { return (unsigned)__builtin_amdgcn_s_getreg((3 << 11) | 20) & 0xFu; }
#define XB_SPIN(cond, bar) do { unsigned _sp = 0; while (cond) { __builtin_amdgcn_s_sleep(1); \
    if ((++_sp & 255u) == 0u) { if (xb_ld(&(bar)[XB_TMO])) break; if (_sp > XB_SPIN_CAP) { atomicAdd(&(bar)[XB_TMO], 1u); break; } } } } while (0)
struct XcdBarrier { unsigned* bar; unsigned x; volatile LAS unsigned* st; };
__device__ __forceinline__ XcdBarrier xcd_barrier_post(unsigned* bar, volatile LAS unsigned* st) {
    XcdBarrier b; b.bar = bar; b.x = xb_xcc_id(); b.st = st;
    if (threadIdx.x == 0) (void)xb_add(&bar[XB_XCNT(b.x)], 1u);
    return b;
}
__device__ __forceinline__ void xcd_barrier_complete(unsigned* bar, unsigned x, unsigned& nloc, unsigned& nx) {
    const unsigned G = gridDim.x * gridDim.y * gridDim.z;
    unsigned sum, cnt, mine, sp = 0u;
    for (;;) {
        sum = 0u; cnt = 0u; mine = 0u;
#pragma unroll
        for (unsigned j = 0; j < 16; ++j) { const unsigned c = xb_ld(&bar[XB_XCNT(j)]); sum += c; cnt += (c > 0u) ? 1u : 0u; mine = (j == x) ? c : mine; }
        if (sum == G) break;
        __builtin_amdgcn_s_sleep(1);
        if ((++sp & 255u) == 0u) { if (xb_ld(&bar[XB_TMO])) break; if (sp > XB_SPIN_CAP) { atomicAdd(&bar[XB_TMO], 1u); break; } }
    }
    nloc = mine > 0u ? mine : 1u; nx = cnt > 0u ? cnt : 1u;
}
__device__ __forceinline__ void xcd_barrier(const XcdBarrier& b) {
    asm volatile("s_waitcnt vmcnt(0)" ::: "memory");
    __syncthreads();
    if (threadIdx.x == 0) {
        unsigned* bar = b.bar;
        __builtin_amdgcn_s_waitcnt(0);
        unsigned nloc = b.st[0], nx = b.st[1];
        if (nloc == 0u) { xcd_barrier_complete(bar, b.x, nloc, nx); b.st[0] = nloc; b.st[1] = nx; }
        const unsigned old = xb_add(&bar[XB_XSUB(b.x)], 1u);
        const unsigned gen = old / nloc;
        if (old + 1u == (gen + 1u) * nloc) {
            __builtin_amdgcn_fence(__ATOMIC_RELEASE, "agent");
            asm volatile("s_waitcnt vmcnt(0)" ::: "memory");
            const unsigned og = xb_add(&bar[XB_TOP], 1u);
            const unsigned tg = og / nx;
            if (og + 1u == (tg + 1u) * nx) xb_add(&bar[XB_TOPGEN], 1u);
            else XB_SPIN(xb_ld(&bar[XB_TOPGEN]) == tg, bar);
            __builtin_amdgcn_fence(__ATOMIC_ACQUIRE, "agent");
            xb_add(&bar[XB_XGEN(b.x)], 1u);
            asm volatile("s_waitcnt vmcnt(0)" ::: "memory");
        } else {
            XB_SPIN(xb_ld(&bar[XB_XGEN(b.x)]) == gen, bar);
            __builtin_amdgcn_fence(__ATOMIC_ACQUIRE, "agent");
            asm volatile("s_waitcnt vmcnt(0)" ::: "memory");
        }
    }
    __syncthreads();
}

struct Frame {
    LAS unsigned char* L; unsigned lb; int tid, lane, wave, bid, G; unsigned char* ws;
    DI Frame fresh() const { Frame f = *this; asm volatile("" : "+v"(f.tid), "+s"(f.wave), "+s"(f.bid), "+s"(f.lb), "+s"(f.G)); f.lane = f.tid & 63; f.L = (LAS unsigned char*)(uintptr_t)f.lb; return f; }
    DI float* modp() const { return (float*)(ws + WS_MODP); }
    DI float* mod() const { return (float*)(ws + WS_MOD); }
    DI float* rope() const { return (float*)(ws + WS_ROPE); }
    DI float* tokw() const { return (float*)(ws + WS_TOKW); }
    DI float* slotw() const { return (float*)(ws + WS_SLOTW); }
    DI float* gates() const { return (float*)(ws + WS_GATES); }
    DI float* mlg() const { return (float*)(ws + WS_MLG); }
    DI float* dt() const { return (float*)(ws + WS_DT); }
    DI float* decml() const { return (float*)(ws + WS_DECML); }
    DI float* decss() const { return (float*)(ws + WS_DECSS); }
    DI bf16_t* xbuf() const { return (bf16_t*)(ws + WS_XBUF); }
    DI bf16_t* stml() const { return (bf16_t*)(ws + WS_STML); }
    DI bf16_t* stss() const { return (bf16_t*)(ws + WS_STSS); }
    DI int* toke() const { return (int*)(ws + WS_TOKE); }
    DI int* tokr() const { return (int*)(ws + WS_TOKR); }
    DI int* toks() const { return (int*)(ws + WS_TOKS); }
    DI int* cnt() const { return (int*)(ws + WS_CNT); }
    DI int* mte() const { return (int*)(ws + WS_MTE); }
    DI bf16_t* rwt() const { return (bf16_t*)(ws + WS_RWT); }
    DI bf16_t* win() const { return (bf16_t*)(ws + WS_WIN); }
    DI bf16_t* wout() const { return (bf16_t*)(ws + WS_WOUT); }
    DI bf16_t* w13() const { return (bf16_t*)(ws + WS_W13); }
    DI bf16_t* w2() const { return (bf16_t*)(ws + WS_W2); }
    DI bf16_t* h() const { return (bf16_t*)(ws + WS_H); }
    DI bf16_t* proj() const { return (bf16_t*)(ws + WS_PROJ); }
    DI bf16_t* xbcc() const { return (bf16_t*)(ws + WS_XBCC); }
    DI bf16_t* mix() const { return (bf16_t*)(ws + WS_MIX); }
    DI bf16_t* amoe() const { return (bf16_t*)(ws + WS_AMOE); }
    DI bf16_t* hid() const { return (bf16_t*)(ws + WS_HID); }
    DI bf16_t* ymoe() const { return (bf16_t*)(ws + WS_YMOE); }
};

constexpr int NJ_ADA = 768, NJ_WIN = 2 * 27 * 32, NJ_WOUT = 2 * 8 * 32, NJ_W13 = 64 * 8 * 16, NJ_W2 = 64 * 8 * 8;
constexpr int NJ_TOTAL = NJ_ADA + 1 + NJ_WIN + NJ_WOUT + NJ_W13 + NJ_W2;
DI int win_col(int n) { return n < 5120 ? n : (n < 6656 ? n + 16 : (n < 6672 ? n - 1536 : (n < 6688 ? n : -1))); }

DI void phase_prologue(const Params& p, const Frame& F) {
    LAS float* TL = (LAS float*)F.L;
    for (int job = F.bid; job < (DBG(64) ? 0 : NJ_ADA); job += F.G) {
        __syncthreads();
        {
            const int l = job / 384, kq = (job / 48) & 7, cb = job % 48;
            LAS float* sl = TL; LAS float* sc = TL + 512; LAS float* red = TL + 1024;
            if (F.tid < 256) { const int k = kq * 256 + F.tid; const float a = p.c[k], b = p.c_ctx[k]; sl[F.tid] = siluf(a); sc[F.tid] = siluf(b); }
            __syncthreads();
            const int cg = F.tid & 63, ks = F.tid >> 6;
            f32x4 a0 = {0.f, 0.f, 0.f, 0.f}, a1 = {0.f, 0.f, 0.f, 0.f};
            const float* wp = p.w_mod + ((size_t)l * 2048 + kq * 256 + ks * 32) * 12288 + cb * 256 + cg * 4;
#pragma unroll 16
            for (int k = 0; k < 32; ++k) { const f32x4 w = *(const f32x4*)(wp + (size_t)k * 12288); a0 += sl[ks * 32 + k] * w; a1 += sc[ks * 32 + k] * w; }
            *(LAS f32x4*)(red + (ks * 2 + 0) * 256 + cg * 4) = a0; *(LAS f32x4*)(red + (ks * 2 + 1) * 256 + cg * 4) = a1;
            __syncthreads();
            { const int which = F.tid >> 8, col = F.tid & 255; float s = 0.f;
#pragma unroll
              for (int k8 = 0; k8 < 8; ++k8) s += red[(k8 * 2 + which) * 256 + col];
              F.modp()[((size_t)(l * 8 + kq) * 2 + which) * 12288 + cb * 256 + col] = s; }
        }
    }
    for (int i = F.bid * NTHR + F.tid; i < 320 * 32; i += F.G * NTHR) { const int pos = i >> 5, f = i & 31; const int pp = pos < 256 ? pos : pos - 256;
        const float inv = expf(-logf(10000.0f) * (float)f / 32.0f); float sn, cs; sincosf((float)pp * inv, &sn, &cs);
        F.rope()[(size_t)pos * 64 + f] = cs; F.rope()[(size_t)pos * 64 + 32 + f] = sn; }
    for (int i = F.bid * NTHR + F.tid; i < 2 * 36 * 2048; i += F.G * NTHR) { const int l = i / (36 * 2048), o = (i / 2048) % 36, k = i & 2047;
        F.rwt()[i] = f2bf(o < 4 ? p.rg_w[((size_t)l * 2048 + k) * 4 + o] : p.re_w[((size_t)l * 2048 + k) * 32 + (o - 4)]); }
    __syncthreads();
    const int lane = F.lane, w = F.wave, n4 = lane & 7, kr = lane >> 3;
    LAS unsigned char* WT = F.L + w * 4608;
    const int c4 = w * 32 + n4 * 4;
#pragma unroll 1
    for (int job = F.bid; job < (DBG(128) ? 0 : NJ_WIN + NJ_WOUT); job += F.G) {
        int j = job; int kind, K, ldS; const float* s0; bf16_t* dst; int n0, k0;
        if (j < NJ_WIN) { kind = 0; const int l = j / (27 * 32), r = j % (27 * 32); n0 = (r / 32) * 256; k0 = (r % 32) * 64; K = 2048; ldS = INC; s0 = p.w_in + (size_t)l * 2048 * INC; dst = F.win() + (size_t)l * NPAD * 2048; }
        else { j -= NJ_WIN; kind = 1; const int l = j / 256, r = j % 256; n0 = (r / 32) * 256; k0 = (r % 32) * 64; K = 2048; ldS = 2048; s0 = p.w_out + (size_t)l * 2048 * 2048 + n0; dst = F.wout() + (size_t)l * 2048 * 2048; }
        const float* sp;
        if (kind == 0) { const int sc = win_col(n0 + c4); sp = sc >= 0 ? s0 + (size_t)(k0 + 2 * kr) * ldS + sc : nullptr; }
        else sp = s0 + (size_t)(k0 + 2 * kr) * ldS + c4;
        f32x4 va[4], vb[4];
#pragma unroll
        for (int i = 0; i < 4; ++i) { va[i] = sp ? *(const f32x4*)(sp + (size_t)(16 * i) * ldS) : (f32x4){0.f, 0.f, 0.f, 0.f}; vb[i] = sp ? *(const f32x4*)(sp + (size_t)(16 * i + 1) * ldS) : (f32x4){0.f, 0.f, 0.f, 0.f}; }
#pragma unroll
        for (int i = 0; i < 4; ++i)
#pragma unroll
            for (int c = 0; c < 4; ++c) *(LAS unsigned*)(WT + (n4 * 4 + c) * 144 + (16 * i + 2 * kr) * 2) = pk2(va[i][c], vb[i][c]);
        __builtin_amdgcn_wave_barrier();
#pragma unroll
        for (int i = 0; i < 4; ++i) { const int ci = lane + 64 * i, n = ci >> 3, k8 = ci & 7;
            const u32x4 o = *(LAS u32x4*)(WT + n * 144 + k8 * 16);
            *(u32x4*)(dst + (size_t)(n0 + w * 32 + n) * K + k0 + k8 * 8) = o; }
        __builtin_amdgcn_wave_barrier();
    }
#pragma unroll 1
    for (int job = F.bid; job < NJ_W13 + NJ_W2; job += F.G) {
        int j = job; int K, ldS; const float* sp; unsigned char* dst; int n0, k0; float fs;
        if (j < NJ_W13) { const int le = j / 128, r = j % 128; const int jt = r / 16; n0 = jt * 256; k0 = (r % 16) * 128; K = 2048; ldS = 1024; fs = FS_W13;
            sp = (c4 < 128 ? p.w1 + (size_t)le * 2048 * 1024 + jt * 128 + c4 : p.w3 + (size_t)le * 2048 * 1024 + jt * 128 + (c4 - 128)) + (size_t)(k0 + 4 * kr) * ldS; dst = (unsigned char*)F.w13() + (size_t)le * 2048 * 2048; }
        else { j -= NJ_W13; const int le = j / 64, r = j % 64; n0 = (r / 8) * 256; k0 = (r % 8) * 128; K = 1024; ldS = 2048; fs = FS_W2;
            sp = p.w2 + (size_t)le * 1024 * 2048 + n0 + c4 + (size_t)(k0 + 4 * kr) * ldS; dst = (unsigned char*)F.w2() + (size_t)le * 2048 * 1024; }
        f32x4 v[4][4];
#pragma unroll
        for (int i = 0; i < 4; ++i)
#pragma unroll
            for (int r = 0; r < 4; ++r) v[i][r] = DBG(32) ? (f32x4){1.f, 2.f, 3.f, 4.f} : *(const f32x4*)(sp + (size_t)(32 * i + r) * ldS);
#pragma unroll
        for (int i = 0; i < 4; ++i)
#pragma unroll
            for (int c = 0; c < 4; ++c) *(LAS unsigned*)(WT + (n4 * 4 + c) * 144 + 32 * i + 4 * kr) = pk4_fp8(v[i][0][c] * fs, v[i][1][c] * fs, v[i][2][c] * fs, v[i][3][c] * fs);
        __builtin_amdgcn_wave_barrier();
#pragma unroll
        for (int i = 0; i < 4; ++i) { const int ci = lane + 64 * i, n = ci >> 3, k16 = ci & 7;
            const u32x4 o = *(LAS u32x4*)(WT + n * 144 + k16 * 16);
            if (!DBG(16)) *(u32x4*)(dst + (size_t)(n0 + w * 32 + n) * K + k0 + k16 * 16) = o; }
        __builtin_amdgcn_wave_barrier();
    }
}

DI float mod_from_partials(const Params& p, const Frame& F, int l, int which, int idx) {
    float s = p.b_mod[(size_t)l * 12288 + idx];
#pragma unroll
    for (int kq = 0; kq < 8; ++kq) s += F.modp()[((size_t)(l * 8 + kq) * 2 + which) * 12288 + idx];
    return s;
}

template <int MODE> DI void phase_rows(const Params& p, const Frame& F) {
    constexpr int l = MODE == 0 ? 0 : 1;
    LAS float* nw = (LAS float*)F.L; LAS float* scl = nw + 2048; LAS float* shf = scl + 4096; LAS float* g2v = shf + 4096;
    __syncthreads();
    for (int i = F.tid; i < 2048; i += NTHR) {
        nw[i] = MODE == 2 ? p.final_w[i] : p.norm1_w[l * 2048 + i];
        if (MODE != 2) { for (int w = 0; w < 2; ++w) { scl[w * 2048 + i] = 1.0f + mod_from_partials(p, F, l, w, 2048 + i); shf[w * 2048 + i] = mod_from_partials(p, F, l, w, i); } }
        if (MODE != 0) { for (int w = 0; w < 2; ++w) g2v[w * 2048 + i] = F.mod()[((size_t)(MODE - 1) * 2 + w) * 12288 + 5 * 2048 + i]; }
    }
    if (MODE != 2) {
        for (int i = F.bid * NTHR + F.tid; i < 2 * 12288; i += F.G * NTHR) F.mod()[(size_t)l * 2 * 12288 + i] = mod_from_partials(p, F, l, i / 12288, i % 12288);
    }
    __syncthreads();
    const int nrows = MODE == 2 ? T : NT;
    for (int row = F.bid * 8 + F.wave; row < nrows; row += F.G * 8) {
        const int w = row >= T ? 1 : 0;
        f32x4 v[8];
        if (MODE == 0) { const float* src = w ? p.ctx + (size_t)(row - T) * 2048 : p.x + (size_t)row * 2048;
#pragma unroll
            for (int j = 0; j < 8; ++j) v[j] = *(const f32x4*)(src + j * 256 + F.lane * 4); }
        else {
#pragma unroll
            for (int j = 0; j < 8; ++j) { const u32x2 q = *(const u32x2*)(F.xbuf() + (size_t)row * 2048 + j * 256 + F.lane * 4); v[j] = (f32x4){bflo(q.x), bfhi(q.x), bflo(q.y), bfhi(q.y)}; } }
        if (MODE != 0) {
            const int s0 = F.toks()[row * 2], s1 = F.toks()[row * 2 + 1];
            const unsigned char* y0 = (const unsigned char*)F.ymoe() + (size_t)s0 * 2048; const unsigned char* y1 = (const unsigned char*)F.ymoe() + (size_t)s1 * 2048;
#pragma unroll
            for (int j = 0; j < 8; ++j) { const int c = j * 256 + F.lane * 4; const f32x4 a = unpk4_fp8(*(const unsigned*)(y0 + c)), b = unpk4_fp8(*(const unsigned*)(y1 + c));
                const f32x4 g = *(LAS f32x4*)(g2v + w * 2048 + c) * (1.0f / FS_Y);
                v[j] += g * (a + b); }
            if (MODE == 1) {
#pragma unroll
                for (int j = 0; j < 8; ++j) { u32x2 q; q.x = pk2(v[j][0], v[j][1]); q.y = pk2(v[j][2], v[j][3]); *(u32x2*)(F.xbuf() + (size_t)row * 2048 + j * 256 + F.lane * 4) = q; }
            }
        }
        float ss = 0.f;
#pragma unroll
        for (int j = 0; j < 8; ++j) ss += v[j][0] * v[j][0] + v[j][1] * v[j][1] + v[j][2] * v[j][2] + v[j][3] * v[j][3];
        ss = wsum(ss);
        const float rstd = rsqrtf(ss * (1.0f / 2048.0f) + 1e-6f);
#pragma unroll
        for (int j = 0; j < 8; ++j) { const int c = j * 256 + F.lane * 4; const f32x4 nwv = *(LAS f32x4*)(nw + c);
            f32x4 o = v[j] * rstd * nwv;
            if (MODE == 2) *(f32x4*)(p.out + (size_t)row * 2048 + c) = o;
            else { o = o * *(LAS f32x4*)(scl + w * 2048 + c) + *(LAS f32x4*)(shf + w * 2048 + c);
                u32x2 pk; pk.x = pk2(o[0], o[1]); pk.y = pk2(o[2], o[3]); *(u32x2*)(F.h() + (size_t)row * 2048 + c) = pk; } }
    }
}

DI void phase_prep(const Params& p, const Frame& F, int l) {
    const int lane = F.lane;
#pragma unroll 2
    for (int row = F.bid * 8 + F.wave; row < NT; row += F.G * 8) {
        const bool lat = row < T;
        bf16_t* pr = F.proj() + (size_t)row * NPROJ;
        if (!DBG(8192))
#pragma unroll
        for (int j = 0; j < 2; ++j) {
            const int head = lane >> 4, half = (lane >> 3) & 1, i4 = (lane & 7) * 4;
            bf16_t* base = pr + (j ? MKO : MQO) + head * 128 + half * 64 + i4;
            const u32x2 a = *(const u32x2*)base, b = *(const u32x2*)(base + 32);
            float x1[4] = {bflo(a.x), bfhi(a.x), bflo(a.y), bfhi(a.y)}, x2[4] = {bflo(b.x), bfhi(b.x), bflo(b.y), bfhi(b.y)}, o1[4], o2[4];
            if (lat) { const int pos = half ? 256 + (row & 63) : (row >> 6); const f32x4 cs = *(const f32x4*)(F.rope() + (size_t)pos * 64 + i4), sn = *(const f32x4*)(F.rope() + (size_t)pos * 64 + 32 + i4);
#pragma unroll
                for (int e = 0; e < 4; ++e) { o1[e] = x1[e] * cs[e] - x2[e] * sn[e]; o2[e] = x1[e] * sn[e] + x2[e] * cs[e]; } }
            else {
#pragma unroll
                for (int e = 0; e < 4; ++e) { o1[e] = x1[e]; o2[e] = x2[e]; } }
            if (j) {
#pragma unroll
                for (int e = 0; e < 4; ++e) { o1[e] *= 0.08838834764831845f; o2[e] *= 0.08838834764831845f; } }
            u32x2 wa, wb; wa.x = pk2(o1[0], o1[1]); wa.y = pk2(o1[2], o1[3]); wb.x = pk2(o2[0], o2[1]); wb.y = pk2(o2[2], o2[3]);
            *(u32x2*)base = wa; *(u32x2*)(base + 32) = wb;
        }
        if (lane < 16) { float v = F.gates()[(size_t)row * 32 + lane] + p.ml_gate_b[l * 16 + lane];
            if ((lane >> 2) & 1) v = fminf(v, 0.f) - __logf(1.0f + __expf(-fabsf(v)));
            F.mlg()[(size_t)row * 16 + lane] = v; }
        else if (lane < 32) { const int idx = lane - 16; const float v = F.gates()[(size_t)row * 32 + lane] + p.dt_bias[l * 16 + idx];
            F.dt()[(size_t)row * 16 + idx] = fmaxf(v, 0.f) + __logf(1.0f + __expf(-fabsf(v))); }
    }
    if (!DBG(16384))
    for (int item = F.bid * 8 + F.wave; item < (T / 8) * 2 + CTXL * 2; item += F.G * 8) {
        const bool lat = item < (T / 8) * 2; const int ci = item - (T / 8) * 2;
        const int ch = ((item & 1) * 64 + lane) * 8, nr = lat ? 8 : 1;
        const int t0 = lat ? (item >> 1) * 8 : T + (ci >> 1); const int tl0 = lat ? t0 : t0 - T, nseq = lat ? T : CTXL, rb = lat ? 0 : T;
        float wgt[4][8], bia[8];
        { const f32x4 b0 = *(const f32x4*)(p.conv_b + l * 1024 + ch), b1 = *(const f32x4*)(p.conv_b + l * 1024 + ch + 4);
          bia[0] = b0[0]; bia[1] = b0[1]; bia[2] = b0[2]; bia[3] = b0[3]; bia[4] = b1[0]; bia[5] = b1[1]; bia[6] = b1[2]; bia[7] = b1[3]; }
#pragma unroll
        for (int tap = 0; tap < 4; ++tap) { const f32x4 w0 = *(const f32x4*)(p.conv_w + ((size_t)l * 4 + tap) * 1024 + ch), w1 = *(const f32x4*)(p.conv_w + ((size_t)l * 4 + tap) * 1024 + ch + 4);
            wgt[tap][0] = w0[0]; wgt[tap][1] = w0[1]; wgt[tap][2] = w0[2]; wgt[tap][3] = w0[3]; wgt[tap][4] = w1[0]; wgt[tap][5] = w1[1]; wgt[tap][6] = w1[2]; wgt[tap][7] = w1[3]; }
        u32x4 xr[11];
#pragma unroll
        for (int r = 0; r < 11; ++r) { const int tt = tl0 + r - 2; xr[r] = (tt >= 0 && tt < nseq && r < nr + 3) ? *(const u32x4*)(F.proj() + (size_t)(rb + tt) * NPROJ + XBO + ch) : (u32x4){0u, 0u, 0u, 0u}; }
#pragma unroll
        for (int r = 0; r < 8; ++r) { float acc[8];
#pragma unroll
            for (int e = 0; e < 8; ++e) acc[e] = bia[e];
#pragma unroll
            for (int tap = 0; tap < 4; ++tap) { float xv[8]; unpack8(xr[r + tap], xv);
#pragma unroll
                for (int e = 0; e < 8; ++e) acc[e] += wgt[tap][e] * xv[e]; }
#pragma unroll
            for (int e = 0; e < 8; ++e) acc[e] = siluf(acc[e]);
            if (r < nr) *(u32x4*)(F.xbcc() + (size_t)(t0 + r) * 1024 + ch) = __builtin_bit_cast(u32x4, pack8(acc)); }
    }
}

DI void na_block64(const Params& p, LAS unsigned char* L, unsigned lb, unsigned ktA, unsigned vtA, int kbA, bool actA, const LAS float* rpA,
                   unsigned ktB, unsigned vtB, int kbB, bool actB, const LAS float* rpB, bool masked, int qc, int cs, int lane,
                   const bf16x8 (&qf)[4], f32x4 (&o)[8], float& m_run, float& l_run) {
    constexpr unsigned PB = 272, PVB = 288; const int g = lane >> 4;
    f32x4 s0 = {0.f, 0.f, 0.f, 0.f}, s1 = s0, s2 = s0, s3 = s0;
    if (actA && !DBG(8)) {
#pragma unroll
        for (int ks = 0; ks < 4; ++ks) { s0 = mfma16(frag_row(L, ktA, PB, kbA, ks * 32, lane), qf[ks], s0); s1 = mfma16(frag_row(L, ktA, PB, kbA + 16, ks * 32, lane), qf[ks], s1); } }
    if (actB && !DBG(8)) {
#pragma unroll
        for (int ks = 0; ks < 4; ++ks) { s2 = mfma16(frag_row(L, ktB, PB, kbB, ks * 32, lane), qf[ks], s2); s3 = mfma16(frag_row(L, ktB, PB, kbB + 16, ks * 32, lane), qf[ks], s3); } }
    float sv[16];
#pragma unroll
    for (int e = 0; e < 4; ++e) { sv[e] = s0[e] * 0.08838834764831845f; sv[4 + e] = s1[e] * 0.08838834764831845f; sv[8 + e] = s2[e] * 0.08838834764831845f; sv[12 + e] = s3[e] * 0.08838834764831845f; }
    if (masked) {
#pragma unroll
        for (int e = 0; e < 8; ++e) { const int kc = kbA + (e < 4 ? 4 * g + e : 16 + 4 * g + (e - 4)); const bool valid = (unsigned)(kc - cs) < 16u; const int bi = valid ? kc - qc + 15 : 0;
            const float ba = actA ? rpA[bi] : 0.f, bb = actB ? rpB[bi] : 0.f;
            sv[e] = (valid && actA) ? sv[e] + ba : -INFINITY; sv[8 + e] = (valid && actB) ? sv[8 + e] + bb : -INFINITY; } }
    float mx = sv[0];
#pragma unroll
    for (int e = 1; e < 16; ++e) mx = fmaxf(mx, sv[e]);
    mx = fmaxf(mx, __shfl_xor(mx, 16)); mx = fmaxf(mx, __shfl_xor(mx, 32));
    const float m_new = fmaxf(m_run, mx), alpha = __expf(m_run - m_new);
    float pa[8], pb[8], ps = 0.f;
#pragma unroll
    for (int e = 0; e < 8; ++e) { pa[e] = __expf(sv[e] - m_new); pb[e] = __expf(sv[8 + e] - m_new); ps += pa[e] + pb[e]; }
    l_run = l_run * alpha + ps; m_run = m_new;
    const bf16x8 pfa = pack8(pa), pfb = pack8(pb);
#pragma unroll
    for (int i = 0; i < 8; ++i) o[i] *= alpha;
    if (actA && !DBG(4)) {
#pragma unroll
        for (int hf = 0; hf < 2; ++hf) { bf16x8 vf[4]; frag_tr_x4(vf, lb, vtA, PVB, kbA + 4 * g, kbA + 16 + 4 * g, hf * 64, lane);
#pragma unroll
            for (int i = 0; i < 4; ++i) o[hf * 4 + i] = mfma16(vf[i], pfa, o[hf * 4 + i]); } }
    if (actB && !DBG(4)) {
#pragma unroll
        for (int hf = 0; hf < 2; ++hf) { bf16x8 vf[4]; frag_tr_x4(vf, lb, vtB, PVB, kbB + 4 * g, kbB + 16 + 4 * g, hf * 64, lane);
#pragma unroll
            for (int i = 0; i < 4; ++i) o[hf * 4 + i] = mfma16(vf[i], pfb, o[hf * 4 + i]); } }
}
DI void na_task(const Params& p, const Frame& F, int l, int task) {
    constexpr unsigned BUF = 71680, TIL = 35840, RPB = 143360, PB = 272, PVB = 288;
    LAS unsigned char* L = F.L; const int lane = F.lane, g = lane >> 4, n = lane & 15;
    const bool isctx = task >= 1024;
    const int r0 = isctx ? 0 : (task >> 3) * 2, head = task & 7;
    const int rsel = F.wave >> 2, qt = F.wave & 3, rw = r0 + rsel;
    const int rsA = r0 - 4 < 0 ? 0 : (r0 - 4 > 248 ? 248 : r0 - 4), rsB = r0 - 3 < 0 ? 0 : (r0 - 3 > 248 ? 248 : r0 - 3);
    const int rsw = rsel ? rsB : rsA;
    const int nwin = isctx ? 0 : rsB + 8 - rsA, nwp = (nwin + 1) >> 1;
    const int qrow = isctx ? T + ((task - 1024) >> 3) * 128 + rsel * 64 : rw * 64;
    const bf16_t* proj = F.proj();
    bf16x8 qa[4];
#pragma unroll
    for (int ks = 0; ks < 4; ++ks) qa[ks] = *(const bf16x8*)(proj + (size_t)(qrow + qt * 16 + n) * NPROJ + QO + head * 128 + ks * 32 + g * 8);
    f32x4 oa[8];
#pragma unroll
    for (int i = 0; i < 8; ++i) oa[i] = (f32x4){0.f, 0.f, 0.f, 0.f};
    float ma = -INFINITY, la = 0.f;
    const int cb = qt == 0 ? 0 : (qt == 1 ? 8 : (qt == 2 ? 24 : 32));
    const int qc = qt * 16 + n, cs = qc - 8 < 0 ? 0 : (qc - 8 > 48 ? 48 : qc - 8);
    const int nsteps = nwp + 2;
    u32x4 pre[8];
    const bf16_t* gp = proj + (size_t)(F.tid >> 4) * NPROJ + KO + head * 128 + (F.tid & 15) * 8;
    const unsigned lp = (unsigned)(F.tid >> 4) * PB + (unsigned)(F.tid & 15) * 16u, lpv = 17408u + (unsigned)(F.tid >> 4) * PVB + (unsigned)(F.tid & 15) * 16u;
#define NA_TOK(step, t) ((step) < nwp ? (rsA + ((2 * (step) + (t)) < nwin ? 2 * (step) + (t) : 2 * (step))) * 64 : T + (2 * ((step) - nwp) + (t)) * 64)
#define NA_LOAD(step) do { const bf16_t* g0_ = gp + (size_t)NA_TOK(step, 0) * NPROJ; const bf16_t* g1_ = gp + (size_t)NA_TOK(step, 1) * NPROJ; _Pragma("unroll") for (int i = 0; i < 8; ++i) \
        pre[i] = *(const u32x4*)(((i >> 2) ? g1_ : g0_) + (size_t)((i & 1) * 32) * NPROJ + ((i >> 1) & 1) * 1024); } while (0)
#define NA_STORE(bufo) do { _Pragma("unroll") for (int i = 0; i < 8; ++i) *(LAS u32x4*)(L + (bufo) + (i >> 2) * TIL + (((i >> 1) & 1) ? lpv + (i & 1) * 32 * PVB : lp + (i & 1) * 32 * PB)) = pre[i]; } while (0)
    NA_LOAD(0);
    __syncthreads();
    if (!isctx) { LAS float* rp = (LAS float*)(L + RPB); for (int i = F.tid; i < 465; i += NTHR) rp[i] = p.na_rpb[((size_t)(l * 8 + head)) * 465 + i]; }
#pragma unroll 1
    for (int step = 0; step < nsteps; ++step) {
        const unsigned bufo = (step & 1) * BUF;
        NA_STORE(bufo);
        if (step + 1 < nsteps && !DBG(1)) NA_LOAD(step + 1);
        __syncthreads();
        if (DBG(2)) continue;
        unsigned t0 = bufo, t1 = bufo + TIL;
        asm volatile("" : "+v"(t0), "+v"(t1));
        if (step < nwp) { const int kr0 = rsA + 2 * step, kr1 = kr0 + 1;
            const bool a0 = kr0 >= rsw && kr0 < rsw + 8, a1 = (2 * step + 1 < nwin) && kr1 >= rsw && kr1 < rsw + 8;
            const LAS float* rpw = (const LAS float*)(L + RPB);
            if (a0 || a1) na_block64(p, L, F.lb, t0, t0 + 17408, cb, a0, rpw + (a0 ? kr0 - rw + 7 : 0) * 31, t1, t1 + 17408, cb, a1, rpw + (a1 ? kr1 - rw + 7 : 0) * 31, true, qc, cs, lane, qa, oa, ma, la);
        } else {
#pragma unroll 1
            for (int tt = 0; tt < 2; ++tt) { unsigned tb = tt ? t1 : t0; asm volatile("" : "+v"(tb));
                na_block64(p, L, F.lb, tb, tb + 17408, 0, true, nullptr, tb, tb + 17408, 32, true, nullptr, false, qc, cs, lane, qa, oa, ma, la); }
        }
    }
#undef NA_TOK
#undef NA_LOAD
#undef NA_STORE
    const float inva = 1.0f / gsum4(la);
#pragma unroll
    for (int dvt = 0; dvt < 8; ++dvt) { u32x2 w; w.x = pk2(oa[dvt][0] * inva, oa[dvt][1] * inva); w.y = pk2(oa[dvt][2] * inva, oa[dvt][3] * inva);
        *(u32x2*)(F.mix() + (size_t)(qrow + qt * 16 + n) * 2048 + head * 128 + dvt * 16 + 4 * g) = w; }
}

DI void ml_state_task(const Params& p, const Frame& F, int tc, int h) {
    constexpr unsigned KT = 0, VF = 17408, VB = 34816, WF = 52224, PB = 272;
    LAS unsigned char* L = F.L; const int lane = F.lane, g = lane >> 4, n = lane & 15;
    LAS float* Wt = (LAS float*)(L + WF);
    __syncthreads();
    if (F.wave < 2) { const int d = F.wave, tok = tc * 64 + lane;
        const float ig = F.mlg()[(size_t)tok * 16 + d * 8 + h], lf = F.mlg()[(size_t)tok * 16 + d * 8 + 4 + h];
        const float b = wscan(lf, d, lane); const float G = __shfl(b, d ? 0 : 63);
        Wt[d * 64 + lane] = __expf(G - b + ig);
        if (lane == 0) F.decml()[(d * 4 + h) * NCH + tc] = __expf(G); }
    __syncthreads();
#pragma unroll
    for (int i = 0; i < 2; ++i) { const int ci = F.tid + NTHR * i, row = ci >> 4, c16 = ci & 15; const size_t tok = (size_t)tc * 64 + row;
        const u32x4 kv = *(const u32x4*)(F.proj() + tok * NPROJ + MKO + h * 128 + c16 * 8);
        *(LAS u32x4*)(L + KT + row * PB + c16 * 16) = kv;
        float v[8], a[8], b[8]; unpack8(*(const u32x4*)(F.proj() + tok * NPROJ + MVO + h * 128 + c16 * 8), v);
        const float wf = Wt[row], wb = Wt[64 + row];
#pragma unroll
        for (int e = 0; e < 8; ++e) { a[e] = v[e] * wf; b[e] = v[e] * wb; }
        *(LAS bf16x8*)(L + VF + row * PB + c16 * 16) = pack8(a); *(LAS bf16x8*)(L + VB + row * PB + c16 * 16) = pack8(b); }
    __syncthreads();
    const int w = F.wave;
    const bf16x8 k0 = frag_tr(F.lb, KT, PB, 8 * g, 8 * g + 4, 16 * w, lane), k1 = frag_tr(F.lb, KT, PB, 32 + 8 * g, 32 + 8 * g + 4, 16 * w, lane);
#pragma unroll
    for (int d = 0; d < 2; ++d) { const unsigned vt = d ? VB : VF;
        bf16_t* dst = F.stml() + ((size_t)(d * 4 + h) * NCH + tc) * 16512;
#pragma unroll 1
        for (int jh = 0; jh < 2; ++jh) { bf16x8 y0[4], y1[4];
            frag_tr_x4(y0, F.lb, vt, PB, 8 * g, 8 * g + 4, 64 * jh, lane); frag_tr_x4(y1, F.lb, vt, PB, 32 + 8 * g, 32 + 8 * g + 4, 64 * jh, lane);
#pragma unroll
            for (int q = 0; q < 4; ++q) { f32x4 acc = {0.f, 0.f, 0.f, 0.f}; acc = mfma16(k0, y0[q], acc); acc = mfma16(k1, y1[q], acc);
                u32x2 pk; pk.x = pk2(acc[0], acc[1]); pk.y = pk2(acc[2], acc[3]);
                *(u32x2*)(dst + (size_t)(64 * jh + 16 * q + n) * 128 + 16 * w + 4 * g) = pk; } } }
    if (F.tid < 256) { const int d = F.tid >> 7, dk = F.tid & 127; float sacc = 0.f;
        for (int t = 0; t < 64; ++t) sacc += Wt[d * 64 + t] * bf2f(*(LAS bf16_t*)(L + KT + t * PB + dk * 2));
        F.stml()[((size_t)(d * 4 + h) * NCH + tc) * 16512 + 16384 + dk] = f2bf(sacc); }
}

DI void ml_out_task(const Params& p, const Frame& F, int l, int tc, int h) {
    constexpr unsigned QT = 0, KT = 17408, VT = 34816, CF = 54272, CB = 93440, GA = 132608, PB = 272, PV = 304;
    LAS unsigned char* L = F.L; const int lane = F.lane, g = lane >> 4, n = lane & 15;
    LAS float* Bg = (LAS float*)(L + GA);
    LAS float* Ig = Bg + 128;
    __syncthreads();
    if (F.wave < 2) { const int d = F.wave, tok = tc * 64 + lane;
        const float ig = F.mlg()[(size_t)tok * 16 + d * 8 + h], lf = F.mlg()[(size_t)tok * 16 + d * 8 + 4 + h];
        Bg[d * 64 + lane] = wscan(lf, d, lane); Ig[d * 64 + lane] = ig; }
    if (!DBG(256)) {
#pragma unroll
    for (int i = 0; i < 2; ++i) { const int ci = F.tid + NTHR * i, row = ci >> 4, c16 = ci & 15; const size_t tok = (size_t)tc * 64 + row;
        *(LAS u32x4*)(L + QT + row * PB + c16 * 16) = *(const u32x4*)(F.proj() + tok * NPROJ + MQO + h * 128 + c16 * 8);
        *(LAS u32x4*)(L + KT + row * PB + c16 * 16) = *(const u32x4*)(F.proj() + tok * NPROJ + MKO + h * 128 + c16 * 8);
        *(LAS u32x4*)(L + VT + row * PV + c16 * 16) = *(const u32x4*)(F.proj() + tok * NPROJ + MVO + h * 128 + c16 * 8); }
    if (F.tid < 128) { const int row = F.tid >> 1, hf = F.tid & 1; u32x4 v = {0u, 0u, 0u, 0u}; if (!hf) v.x = 0x3f80u; *(LAS u32x4*)(L + VT + row * PV + 256 + hf * 16) = v; }
#pragma unroll
    for (int d = 0; d < 2; ++d) { const bf16_t* src = F.stml() + ((size_t)(d * 4 + h) * NCH + tc) * 16512; const unsigned ct = d ? CB : CF;
        { u32x4 cv[5];
#pragma unroll
          for (int i = 0; i < 4; ++i) cv[i] = *(const u32x4*)(src + (size_t)(F.tid + NTHR * i) * 8);
          cv[4] = F.tid < 16 ? *(const u32x4*)(src + (size_t)(2048 + F.tid) * 8) : (u32x4){0u, 0u, 0u, 0u};
#pragma unroll
          for (int i = 0; i < 4; ++i) { const int ci = F.tid + NTHR * i; *(LAS u32x4*)(L + ct + (ci >> 4) * PB + (ci & 15) * 16) = cv[i]; }
          if (F.tid < 16) *(LAS u32x4*)(L + ct + 128 * PB + F.tid * 16) = cv[4]; }
        for (int i = F.tid; i < 15 * 17; i += NTHR) { const int row = 129 + i / 17, c = i % 17; *(LAS u32x4*)(L + ct + row * PB + c * 16) = (u32x4){0u, 0u, 0u, 0u}; } }
    }
    __syncthreads();
    if (DBG(512)) return;
    const int d = F.wave >> 2, qt = F.wave & 3;
    bf16x8 qf[4];
#pragma unroll
    for (int ks = 0; ks < 4; ++ks) qf[ks] = frag_row(L, QT, PB, 16 * qt, 32 * ks, lane);
    const int t = 16 * qt + n; const float bt = Bg[d * 64 + t];
    float wv[4][4];
    { f32x4 sa[4];
#pragma unroll
      for (int st = 0; st < 4; ++st) sa[st] = (f32x4){0.f, 0.f, 0.f, 0.f};
#pragma unroll
      for (int ks = 0; ks < 4; ++ks)
#pragma unroll
        for (int st = 0; st < 4; ++st) sa[st] = mfma16(frag_row(L, KT, PB, 16 * st, 32 * ks, lane), qf[ks], sa[st]);
#pragma unroll
      for (int st = 0; st < 4; ++st) { const f32x4 bs = *(LAS f32x4*)(Bg + d * 64 + 16 * st + 4 * g), is = *(LAS f32x4*)(Ig + d * 64 + 16 * st + 4 * g);
#pragma unroll
        for (int e = 0; e < 4; ++e) { const int s = 16 * st + 4 * g + e; const bool valid = d ? (s >= t) : (s <= t);
            wv[st][e] = valid ? sa[st][e] * __expf(bt - bs[e] + is[e]) : 0.f; } } }
    f32x4 num[9];
#pragma unroll
    for (int it = 0; it < 9; ++it) num[it] = (f32x4){0.f, 0.f, 0.f, 0.f};
#pragma unroll
    for (int kk = 0; kk < 2; ++kk) {
        const bool need = d ? (2 * kk + 1 >= qt) : (2 * kk <= qt);
        if (need) { float pv[8];
#pragma unroll
            for (int e = 0; e < 4; ++e) { pv[e] = wv[2 * kk][e]; pv[4 + e] = wv[2 * kk + 1][e]; }
            const bf16x8 pf = pack8(pv);
#pragma unroll
            for (int hf = 0; hf < 2; ++hf) { bf16x8 vf[4]; frag_tr_x4(vf, F.lb, VT, PV, 32 * kk + 4 * g, 32 * kk + 16 + 4 * g, 64 * hf, lane);
#pragma unroll
                for (int q = 0; q < 4; ++q) num[hf * 4 + q] = mfma16(vf[q], pf, num[hf * 4 + q]); }
            num[8] = mfma16(frag_tr(F.lb, VT, PV, 32 * kk + 4 * g, 32 * kk + 16 + 4 * g, 128, lane), pf, num[8]); }
    }
    const unsigned ct = d ? CB : CF; const float eb = __expf(bt);
    { f32x4 ia[9];
#pragma unroll
      for (int it = 0; it < 9; ++it) ia[it] = (f32x4){0.f, 0.f, 0.f, 0.f};
#pragma unroll
      for (int ks = 0; ks < 4; ++ks)
#pragma unroll
        for (int it = 0; it < 9; ++it) ia[it] = mfma16(frag_row(L, ct, PB, 16 * it, 32 * ks, lane), qf[ks], ia[it]);
#pragma unroll
      for (int it = 0; it < 9; ++it) num[it] += eb * ia[it]; }
    const float den = __shfl(num[8][0], n);
    const float dn = 1.0f / fmaxf(fabsf(den), 1.0f);
#pragma unroll
    for (int it = 0; it < 8; ++it) num[it] *= dn;
    __syncthreads();
    LAS float* HX = (LAS float*)(L + CF);
    if (d == 1) {
#pragma unroll
        for (int it = 0; it < 8; ++it) *(LAS f32x4*)(HX + t * 132 + 16 * it + 4 * g) = num[it]; }
    __syncthreads();
    if (d == 0 && (l == 0 || tc < 256)) {
        float sm = 0.f;
#pragma unroll
        for (int it = 0; it < 8; ++it) { num[it] += *(LAS f32x4*)(HX + t * 132 + 16 * it + 4 * g); sm += num[it][0] + num[it][1] + num[it][2] + num[it][3]; }
        const float mean = gsum4(sm) * (1.0f / 128.0f); float vs = 0.f;
#pragma unroll
        for (int it = 0; it < 8; ++it) { num[it] -= mean; vs += num[it][0] * num[it][0] + num[it][1] * num[it][1] + num[it][2] * num[it][2] + num[it][3] * num[it][3]; }
        const float rstd = rsqrtf(gsum4(vs) * (1.0f / 128.0f) + 1e-6f);
        const size_t tok = (size_t)tc * 64 + t;
#pragma unroll
        for (int it = 0; it < 8; ++it) { const int c = h * 128 + 16 * it + 4 * g;
            const u32x2 mo = *(const u32x2*)(F.proj() + tok * NPROJ + MOO + c); const f32x4 nwv = *(const f32x4*)(p.ml_norm_w + l * 512 + c);
            const float o0 = num[it][0] * rstd * nwv[0] * sigmf(bflo(mo.x)), o1 = num[it][1] * rstd * nwv[1] * sigmf(bfhi(mo.x));
            const float o2 = num[it][2] * rstd * nwv[2] * sigmf(bflo(mo.y)), o3 = num[it][3] * rstd * nwv[3] * sigmf(bfhi(mo.y));
            u32x2 w; w.x = pk2(o0, o1); w.y = pk2(o2, o3); *(u32x2*)(F.mix() + tok * 2048 + 1024 + c) = w; }
    }
}

constexpr int NC2 = 130;
DI void wscan128(float& lo, float& hi, int rev, int lane) {
    lo = wscan(lo, rev, lane); hi = wscan(hi, rev, lane);
    if (!rev) hi += __shfl(lo, 63); else lo += __shfl(hi, 0);
}
DI void ml_state128_task(const Params& p, const Frame& F, int tc2, int h) {
    constexpr unsigned KT = 0, VF = 34816, VB = 69632, WF = 104448, PB = 272;
    LAS unsigned char* L = F.L; const int lane = F.lane, g = lane >> 4, n = lane & 15;
    LAS float* Wt = (LAS float*)(L + WF);
    __syncthreads();
    if (F.wave < 2) { const int d = F.wave; const size_t t0 = (size_t)tc2 * 128 + lane, t1 = t0 + 64;
        const float ig0 = F.mlg()[t0 * 16 + d * 8 + h], ig1 = F.mlg()[t1 * 16 + d * 8 + h];
        float b0 = F.mlg()[t0 * 16 + d * 8 + 4 + h], b1 = F.mlg()[t1 * 16 + d * 8 + 4 + h];
        wscan128(b0, b1, d, lane); const float G = d ? __shfl(b0, 0) : __shfl(b1, 63);
        Wt[d * 128 + lane] = __expf(G - b0 + ig0); Wt[d * 128 + 64 + lane] = __expf(G - b1 + ig1);
        if (lane == 0) F.decml()[(d * 4 + h) * NC2 + tc2] = __expf(G); }
    __syncthreads();
#pragma unroll
    for (int i = 0; i < 4; ++i) { const int ci = F.tid + NTHR * i, row = ci >> 4, c16 = ci & 15; const size_t tok = (size_t)tc2 * 128 + row;
        const u32x4 kv = *(const u32x4*)(F.proj() + tok * NPROJ + MKO + h * 128 + c16 * 8);
        *(LAS u32x4*)(L + KT + row * PB + c16 * 16) = kv;
        float v[8], a[8], b[8]; unpack8(*(const u32x4*)(F.proj() + tok * NPROJ + MVO + h * 128 + c16 * 8), v);
        const float wf = Wt[row], wb = Wt[128 + row];
#pragma unroll
        for (int e = 0; e < 8; ++e) { a[e] = v[e] * wf; b[e] = v[e] * wb; }
        *(LAS bf16x8*)(L + VF + row * PB + c16 * 16) = pack8(a); *(LAS bf16x8*)(L + VB + row * PB + c16 * 16) = pack8(b); }
    __syncthreads();
    const int w = F.wave;
    bf16x8 kf[4];
#pragma unroll
    for (int ks = 0; ks < 4; ++ks) kf[ks] = frag_tr(F.lb, KT, PB, 32 * ks + 8 * g, 32 * ks + 8 * g + 4, 16 * w, lane);
#pragma unroll
    for (int d = 0; d < 2; ++d) { const unsigned vt = d ? VB : VF;
        bf16_t* dst = F.stml() + ((size_t)(d * 4 + h) * NC2 + tc2) * 16512;
#pragma unroll 1
        for (int jh = 0; jh < 2; ++jh) { f32x4 acc[4];
#pragma unroll
            for (int q = 0; q < 4; ++q) acc[q] = (f32x4){0.f, 0.f, 0.f, 0.f};
#pragma unroll
            for (int ks = 0; ks < 4; ++ks) { bf16x8 y[4]; frag_tr_x4(y, F.lb, vt, PB, 32 * ks + 8 * g, 32 * ks + 8 * g + 4, 64 * jh, lane);
#pragma unroll
                for (int q = 0; q < 4; ++q) acc[q] = mfma16(kf[ks], y[q], acc[q]); }
#pragma unroll
            for (int q = 0; q < 4; ++q) { u32x2 pk; pk.x = pk2(acc[q][0], acc[q][1]); pk.y = pk2(acc[q][2], acc[q][3]);
                *(u32x2*)(dst + (size_t)(64 * jh + 16 * q + n) * 128 + 16 * w + 4 * g) = pk; } } }
    if (F.tid < 256) { const int d = F.tid >> 7, dk = F.tid & 127; float sacc = 0.f;
        for (int t = 0; t < 128; ++t) sacc += Wt[d * 128 + t] * bf2f(*(LAS bf16_t*)(L + KT + t * PB + dk * 2));
        F.stml()[((size_t)(d * 4 + h) * NC2 + tc2) * 16512 + 16384 + dk] = f2bf(sacc); }
}
DI void ml_stage_c(const Frame& F, LAS unsigned char* L, unsigned ct, const bf16_t* src) {
    constexpr unsigned PB = 272; u32x4 cv[5];
#pragma unroll
    for (int i = 0; i < 4; ++i) cv[i] = *(const u32x4*)(src + (size_t)(F.tid + NTHR * i) * 8);
    cv[4] = F.tid < 16 ? *(const u32x4*)(src + (size_t)(2048 + F.tid) * 8) : (u32x4){0u, 0u, 0u, 0u};
#pragma unroll
    for (int i = 0; i < 4; ++i) { const int ci = F.tid + NTHR * i; *(LAS u32x4*)(L + ct + (ci >> 4) * PB + (ci & 15) * 16) = cv[i]; }
    if (F.tid < 16) *(LAS u32x4*)(L + ct + 128 * PB + F.tid * 16) = cv[4];
    for (int i = F.tid; i < 15 * 17; i += NTHR) { const int row = 129 + i / 17, c = i % 17; *(LAS u32x4*)(L + ct + row * PB + c * 16) = (u32x4){0u, 0u, 0u, 0u}; }
}
DI void ml_out128_task(const Params& p, const Frame& F0, int l, int tc2, int h) {
    constexpr unsigned QT = 0, KT = 34816, VT = 69632, CT = 108544, GA = 147712, PB = 272, PV = 304;
    Frame F = F0; asm volatile("" : "+v"(F.tid)); F.lane = F.tid & 63;
    LAS unsigned char* L = F.L; const int lane = F.lane, g = lane >> 4, n = lane & 15, w = F.wave;
    LAS float* Bg = (LAS float*)(L + GA);
    LAS float* Ig = Bg + 256;
    __syncthreads();
    if (F.wave < 2) { const int d = F.wave; const size_t t0 = (size_t)tc2 * 128 + lane, t1 = t0 + 64;
        const float ig0 = F.mlg()[t0 * 16 + d * 8 + h], ig1 = F.mlg()[t1 * 16 + d * 8 + h];
        float b0 = F.mlg()[t0 * 16 + d * 8 + 4 + h], b1 = F.mlg()[t1 * 16 + d * 8 + 4 + h];
        wscan128(b0, b1, d, lane);
        Bg[d * 128 + lane] = b0; Bg[d * 128 + 64 + lane] = b1; Ig[d * 128 + lane] = ig0; Ig[d * 128 + 64 + lane] = ig1; }
#pragma unroll 2
    for (int i = 0; i < 4; ++i) { const int ci = F.tid + NTHR * i, row = ci >> 4, c16 = ci & 15; const size_t tok = (size_t)tc2 * 128 + row;
        *(LAS u32x4*)(L + QT + row * PB + c16 * 16) = *(const u32x4*)(F.proj() + tok * NPROJ + MQO + h * 128 + c16 * 8);
        *(LAS u32x4*)(L + KT + row * PB + c16 * 16) = *(const u32x4*)(F.proj() + tok * NPROJ + MKO + h * 128 + c16 * 8);
        *(LAS u32x4*)(L + VT + row * PV + c16 * 16) = *(const u32x4*)(F.proj() + tok * NPROJ + MVO + h * 128 + c16 * 8); }
    if (F.tid < 256) { const int row = F.tid >> 1, hf = F.tid & 1; u32x4 v = {0u, 0u, 0u, 0u}; if (!hf) v.x = 0x3f80u; *(LAS u32x4*)(L + VT + row * PV + 256 + hf * 16) = v; }
    ml_stage_c(F, L, CT, F.stml() + ((size_t)(0 * 4 + h) * NC2 + tc2) * 16512);
    __syncthreads();
    bf16x8 qf[4];
#pragma unroll
    for (int ks = 0; ks < 4; ++ks) qf[ks] = frag_row(L, QT, PB, 16 * w, 32 * ks, lane);
    const int t = 16 * w + n;
    f32x4 hsum[8];
#pragma unroll
    for (int it = 0; it < 8; ++it) hsum[it] = (f32x4){0.f, 0.f, 0.f, 0.f};
#pragma unroll 1
    for (int d = 0; d < 2; ++d) {
        if (d == 1) { __syncthreads(); ml_stage_c(F, L, CT, F.stml() + ((size_t)(1 * 4 + h) * NC2 + tc2) * 16512); __syncthreads(); }
        const float bt = Bg[d * 128 + t];
        unsigned kt_ = KT, ct_ = CT, vt_ = VT; asm volatile("" : "+v"(kt_), "+v"(ct_), "+v"(vt_));
        bf16x8 pf[4];
#pragma unroll
        for (int hk = 0; hk < 2; ++hk) {
            f32x4 sa[4];
#pragma unroll
            for (int q = 0; q < 4; ++q) sa[q] = (f32x4){0.f, 0.f, 0.f, 0.f};
#pragma unroll
            for (int ks = 0; ks < 4; ++ks)
#pragma unroll
                for (int q = 0; q < 4; ++q) { const int st = 4 * hk + q; if (d ? (st >= w) : (st <= w)) sa[q] = mfma16(frag_row(L, kt_, PB, 16 * st, 32 * ks, lane), qf[ks], sa[q]); }
#pragma unroll
            for (int k2 = 0; k2 < 2; ++k2) { float pv[8];
#pragma unroll
                for (int hh = 0; hh < 2; ++hh) { const int st = 4 * hk + 2 * k2 + hh; const f32x4 bs = *(LAS f32x4*)(Bg + d * 128 + 16 * st + 4 * g), is = *(LAS f32x4*)(Ig + d * 128 + 16 * st + 4 * g);
#pragma unroll
                    for (int e = 0; e < 4; ++e) { const int s = 16 * st + 4 * g + e; const bool valid = d ? (s >= t) : (s <= t);
                        pv[hh * 4 + e] = valid ? sa[2 * k2 + hh][e] * __expf(bt - bs[e] + is[e]) : 0.f; } }
                pf[2 * hk + k2] = pack8(pv); } }
        const float eb = __expf(bt);
#define ML_QS(ks) ({ float qv_[8]; unpack8(__builtin_bit_cast(u32x4, qf[ks]), qv_); _Pragma("unroll") for (int e_ = 0; e_ < 8; ++e_) qv_[e_] *= eb; pack8(qv_); })
        float dn;
        { f32x4 na[5];
#pragma unroll
          for (int it = 0; it < 5; ++it) na[it] = (f32x4){0.f, 0.f, 0.f, 0.f};
#pragma unroll
          for (int kk = 0; kk < 4; ++kk) {
            if (d ? (2 * kk + 1 >= w) : (2 * kk <= w)) { bf16x8 vf[4]; frag_tr_x4(vf, F.lb, vt_, PV, 32 * kk + 4 * g, 32 * kk + 16 + 4 * g, 0, lane);
#pragma unroll
                for (int q = 0; q < 4; ++q) na[q] = mfma16(vf[q], pf[kk], na[q]);
                na[4] = mfma16(frag_tr(F.lb, vt_, PV, 32 * kk + 4 * g, 32 * kk + 16 + 4 * g, 128, lane), pf[kk], na[4]); } }
#pragma unroll
          for (int ks = 0; ks < 4; ++ks) { const bf16x8 qsk = ML_QS(ks);
#pragma unroll
            for (int q = 0; q < 4; ++q) na[q] = mfma16(frag_row(L, ct_, PB, 16 * q, 32 * ks, lane), qsk, na[q]);
            na[4] = mfma16(frag_row(L, ct_, PB, 128, 32 * ks, lane), qsk, na[4]); }
          const float den = __shfl(na[4][0], n);
          dn = 1.0f / fmaxf(fabsf(den), 1.0f);
#pragma unroll
          for (int q = 0; q < 4; ++q) hsum[q] += na[q] * dn; }
        { f32x4 nb[4];
#pragma unroll
          for (int q = 0; q < 4; ++q) nb[q] = (f32x4){0.f, 0.f, 0.f, 0.f};
#pragma unroll
          for (int kk = 0; kk < 4; ++kk) {
            if (d ? (2 * kk + 1 >= w) : (2 * kk <= w)) { bf16x8 vf[4]; frag_tr_x4(vf, F.lb, vt_, PV, 32 * kk + 4 * g, 32 * kk + 16 + 4 * g, 64, lane);
#pragma unroll
                for (int q = 0; q < 4; ++q) nb[q] = mfma16(vf[q], pf[kk], nb[q]); } }
#pragma unroll
          for (int ks = 0; ks < 4; ++ks) { const bf16x8 qsk = ML_QS(ks);
#pragma unroll
            for (int q = 0; q < 4; ++q) nb[q] = mfma16(frag_row(L, ct_, PB, 64 + 16 * q, 32 * ks, lane), qsk, nb[q]); }
#pragma unroll
          for (int q = 0; q < 4; ++q) hsum[4 + q] += nb[q] * dn; }
#undef ML_QS
    }
    if (l == 0 || tc2 < 128) {
        float sm = 0.f;
#pragma unroll
        for (int it = 0; it < 8; ++it) sm += hsum[it][0] + hsum[it][1] + hsum[it][2] + hsum[it][3];
        const float mean = gsum4(sm) * (1.0f / 128.0f); float vs = 0.f;
#pragma unroll
        for (int it = 0; it < 8; ++it) { hsum[it] -= mean; vs += hsum[it][0] * hsum[it][0] + hsum[it][1] * hsum[it][1] + hsum[it][2] * hsum[it][2] + hsum[it][3] * hsum[it][3]; }
        const float rstd = rsqrtf(gsum4(vs) * (1.0f / 128.0f) + 1e-6f);
        const size_t tok = (size_t)tc2 * 128 + t;
#pragma unroll
        for (int it = 0; it < 8; ++it) { const int c = h * 128 + 16 * it + 4 * g;
            const u32x2 mo = *(const u32x2*)(F.proj() + tok * NPROJ + MOO + c); const f32x4 nwv = *(const f32x4*)(p.ml_norm_w + l * 512 + c);
            const float o0 = hsum[it][0] * rstd * nwv[0] * sigmf(bflo(mo.x)), o1 = hsum[it][1] * rstd * nwv[1] * sigmf(bfhi(mo.x));
            const float o2 = hsum[it][2] * rstd * nwv[2] * sigmf(bflo(mo.y)), o3 = hsum[it][3] * rstd * nwv[3] * sigmf(bfhi(mo.y));
            u32x2 wq; wq.x = pk2(o0, o1); wq.y = pk2(o2, o3); *(u32x2*)(F.mix() + tok * 2048 + 1024 + c) = wq; }
    }
}

DI void ss_state_task(const Params& p, const Frame& F, int l, int tc, int gi) {
    constexpr unsigned BT = 0, XS = 17408, WA = 91136, PB = 272, PX = 144;
    LAS unsigned char* L = F.L; const int lane = F.lane, g = lane >> 4, n = lane & 15, w = F.wave;
    LAS float* Wt = (LAS float*)(L + WA);
    const int hl = w & 3, d = w >> 2, hh = gi * 4 + hl;
    __syncthreads();
    { const int tok = tc * 64 + lane; const float dt = F.dt()[(size_t)tok * 16 + d * 8 + hh], a = -__expf(p.a_log[(l * 2 + d) * 8 + hh]);
      const float la = wscan(dt * a, d, lane); const float G = __shfl(la, d ? 0 : 63);
      Wt[w * 64 + lane] = __expf(G - la) * dt;
      if (lane == 0) F.decss()[(d * 8 + hh) * NCH + tc] = __expf(G); }
    __syncthreads();
#pragma unroll
    for (int i = 0; i < 2; ++i) { const int ci = F.tid + NTHR * i, row = ci >> 4, c16 = ci & 15;
        *(LAS u32x4*)(L + BT + row * PB + c16 * 16) = *(const u32x4*)(F.xbcc() + ((size_t)tc * 64 + row) * 1024 + 512 + gi * 128 + c16 * 8); }
#pragma unroll
    for (int i = 0; i < 8; ++i) { const int ci = F.tid + NTHR * i, ww = ci >> 9, row = (ci >> 3) & 63, c8 = ci & 7; float v[8];
        unpack8(*(const u32x4*)(F.xbcc() + ((size_t)tc * 64 + row) * 1024 + (gi * 4 + (ww & 3)) * 64 + c8 * 8), v);
        const float ws = Wt[ww * 64 + row];
#pragma unroll
        for (int e = 0; e < 8; ++e) v[e] *= ws;
        *(LAS bf16x8*)(L + XS + ww * 9216 + row * PX + c8 * 16) = pack8(v); }
    __syncthreads();
    bf16_t* dst = F.stss() + ((size_t)(d * 8 + hh) * NCH + tc) * 8192;
    const unsigned xt = XS + w * 9216;
    bf16x8 x0[4], x1[4];
    frag_tr_x4(x0, F.lb, xt, PX, 8 * g, 8 * g + 4, 0, lane); frag_tr_x4(x1, F.lb, xt, PX, 32 + 8 * g, 32 + 8 * g + 4, 0, lane);
#pragma unroll 1
    for (int ih = 0; ih < 2; ++ih) { bf16x8 b0[4], b1[4];
        frag_tr_x4(b0, F.lb, BT, PB, 8 * g, 8 * g + 4, 64 * ih, lane); frag_tr_x4(b1, F.lb, BT, PB, 32 + 8 * g, 32 + 8 * g + 4, 64 * ih, lane);
#pragma unroll
        for (int q = 0; q < 4; ++q)
#pragma unroll
            for (int jt = 0; jt < 4; ++jt) { f32x4 acc = {0.f, 0.f, 0.f, 0.f}; acc = mfma16(b0[q], x0[jt], acc); acc = mfma16(b1[q], x1[jt], acc);
                u32x2 pk; pk.x = pk2(acc[0], acc[1]); pk.y = pk2(acc[2], acc[3]);
                *(u32x2*)(dst + (size_t)(16 * jt + n) * 128 + 64 * ih + 16 * q + 4 * g) = pk; } }
}

DI void ss_out_task(const Params& p, const Frame& F, int l, int tc, int gi) {
    constexpr unsigned CT = 0, BT = 17408, XT = 34816, SS = 68608, LA = 138240, DS = 140288, SQ = 142336, PB = 272, PX = 528;
    LAS unsigned char* L = F.L; const int lane = F.lane, g = lane >> 4, n = lane & 15, w = F.wave;
    LAS float* La = (LAS float*)(L + LA); LAS float* Dt = (LAS float*)(L + DS); LAS float* Sq = (LAS float*)(L + SQ);
    __syncthreads();
    { const int hl = w & 3, d = w >> 2, hh = gi * 4 + hl; const int tok = tc * 64 + lane;
      const float dt = F.dt()[(size_t)tok * 16 + d * 8 + hh], a = -__expf(p.a_log[(l * 2 + d) * 8 + hh]);
      La[w * 64 + lane] = wscan(dt * a, d, lane); Dt[w * 64 + lane] = dt; }
#pragma unroll
    for (int i = 0; i < 2; ++i) { const int ci = F.tid + NTHR * i, row = ci >> 4, c16 = ci & 15; const size_t tok = (size_t)tc * 64 + row;
        *(LAS u32x4*)(L + CT + row * PB + c16 * 16) = *(const u32x4*)(F.xbcc() + tok * 1024 + 768 + gi * 128 + c16 * 8);
        *(LAS u32x4*)(L + BT + row * PB + c16 * 16) = *(const u32x4*)(F.xbcc() + tok * 1024 + 512 + gi * 128 + c16 * 8); }
#pragma unroll
    for (int i = 0; i < 4; ++i) { const int ci = F.tid + NTHR * i, row = ci >> 5, c32 = ci & 31;
        *(LAS u32x4*)(L + XT + row * PX + c32 * 16) = *(const u32x4*)(F.xbcc() + ((size_t)tc * 64 + row) * 1024 + gi * 256 + c32 * 8); }
    __syncthreads();
    const int qt = w & 3, hp2 = w >> 2, t = 16 * qt + n;
    bf16x8 cf[4];
#pragma unroll
    for (int ks = 0; ks < 4; ++ks) cf[ks] = frag_row(L, CT, PB, 16 * qt, 32 * ks, lane);
    f32x4 ga[4];
#pragma unroll
    for (int st = 0; st < 4; ++st) ga[st] = (f32x4){0.f, 0.f, 0.f, 0.f};
#pragma unroll
    for (int ks = 0; ks < 4; ++ks)
#pragma unroll
        for (int st = 0; st < 4; ++st) ga[st] = mfma16(frag_row(L, BT, PB, 16 * st, 32 * ks, lane), cf[ks], ga[st]);
    f32x4 y[2][4];
#pragma unroll
    for (int a = 0; a < 2; ++a)
#pragma unroll
        for (int it = 0; it < 4; ++it) y[a][it] = (f32x4){0.f, 0.f, 0.f, 0.f};
#pragma unroll 1
    for (int d = 0; d < 2; ++d) {
        __syncthreads();
        { u32x4 sv[8];
#pragma unroll
          for (int i = 0; i < 8; ++i) { const int ci = F.tid + NTHR * i, hl = ci >> 10, r = ci & 1023; sv[i] = *(const u32x4*)(F.stss() + ((size_t)(d * 8 + gi * 4 + hl) * NCH + tc) * 8192 + (size_t)r * 8); }
#pragma unroll
          for (int i = 0; i < 8; ++i) { const int ci = F.tid + NTHR * i, hl = ci >> 10, r = ci & 1023; *(LAS u32x4*)(L + SS + hl * 17408 + (r >> 4) * PB + (r & 15) * 16) = sv[i]; } }
        __syncthreads();
#pragma unroll
        for (int a = 0; a < 2; ++a) { const int hl = 2 * hp2 + a, wi = d * 4 + hl; const float lat = La[wi * 64 + t];
            float wv[4][4];
#pragma unroll
            for (int st = 0; st < 4; ++st) { const f32x4 ls = *(LAS f32x4*)(La + wi * 64 + 16 * st + 4 * g), ds = *(LAS f32x4*)(Dt + wi * 64 + 16 * st + 4 * g);
#pragma unroll
                for (int e = 0; e < 4; ++e) { const int s = 16 * st + 4 * g + e; const bool valid = d ? (s >= t) : (s <= t);
                    wv[st][e] = valid ? ga[st][e] * __expf(lat - ls[e]) * ds[e] : 0.f; } }
            const float el = __expf(lat);
            { f32x4 ia[4];
#pragma unroll
              for (int it = 0; it < 4; ++it) ia[it] = (f32x4){0.f, 0.f, 0.f, 0.f};
#pragma unroll
              for (int ks = 0; ks < 4; ++ks)
#pragma unroll
                for (int it = 0; it < 4; ++it) ia[it] = mfma16(frag_row(L, SS + hl * 17408, PB, 16 * it, 32 * ks, lane), cf[ks], ia[it]);
#pragma unroll
              for (int it = 0; it < 4; ++it) y[a][it] += el * ia[it]; }
#pragma unroll
            for (int kk = 0; kk < 2; ++kk) { float pv[8];
#pragma unroll
                for (int e = 0; e < 4; ++e) { pv[e] = wv[2 * kk][e]; pv[4 + e] = wv[2 * kk + 1][e]; }
                const bf16x8 pf = pack8(pv);
                bf16x8 xf[4]; frag_tr_x4(xf, F.lb, XT, PX, 32 * kk + 4 * g, 32 * kk + 16 + 4 * g, hl * 64, lane);
#pragma unroll
                for (int it = 0; it < 4; ++it) y[a][it] = mfma16(xf[it], pf, y[a][it]); }
        }
    }
    const size_t tok = (size_t)tc * 64 + t; float ssq = 0.f;
#pragma unroll
    for (int a = 0; a < 2; ++a) { const int hl = 2 * hp2 + a, hh = gi * 4 + hl; const float dsk = p.ssm_d[l * 8 + hh];
#pragma unroll
        for (int it = 0; it < 4; ++it) { const int pi = 16 * it + 4 * g;
            const u32x2 xv = *(LAS u32x2*)(L + XT + t * PX + (hl * 64 + pi) * 2); const u32x2 zv = *(const u32x2*)(F.proj() + tok * NPROJ + ZO + hh * 64 + pi);
            f32x4 v = y[a][it];
            v[0] = (v[0] + dsk * bflo(xv.x)) * siluf(bflo(zv.x)); v[1] = (v[1] + dsk * bfhi(xv.x)) * siluf(bfhi(zv.x));
            v[2] = (v[2] + dsk * bflo(xv.y)) * siluf(bflo(zv.y)); v[3] = (v[3] + dsk * bfhi(xv.y)) * siluf(bfhi(zv.y));
            y[a][it] = v; ssq += v[0] * v[0] + v[1] * v[1] + v[2] * v[2] + v[3] * v[3]; } }
    ssq = gsum4(ssq);
    if (g == 0) Sq[hp2 * 64 + t] = ssq;
    __syncthreads();
    if (l == 0 || tc < 256) {
        const float rstd = rsqrtf((Sq[t] + Sq[64 + t]) * (1.0f / 256.0f) + 1e-6f);
#pragma unroll
        for (int a = 0; a < 2; ++a) { const int hh = gi * 4 + 2 * hp2 + a;
#pragma unroll
            for (int it = 0; it < 4; ++it) { const int c = hh * 64 + 16 * it + 4 * g; const f32x4 nwv = *(const f32x4*)(p.ssm_norm_w + l * 512 + c); const f32x4 v = y[a][it] * rstd * nwv;
                u32x2 wq; wq.x = pk2(v[0], v[1]); wq.y = pk2(v[2], v[3]); *(u32x2*)(F.mix() + tok * 2048 + 1536 + c) = wq; } }
    }
}

DI void phase_scan(const Frame& F) {
    int item;
    if (F.tid < 128) item = F.bid * 128 + F.tid; else if (F.tid == 128 && F.bid < 128) item = 32768 + F.bid; else return;
    const bool isml = item < 16512;
    bf16_t* base; const float* dec; int d; size_t stride; int nch, nctx;
    if (isml) { const int ch = item / 2064, e = item % 2064; base = F.stml() + (size_t)ch * NC2 * 16512 + e * 8; dec = F.decml() + ch * NC2; d = ch >> 2; stride = 16512; nch = NC2; nctx = 2; }
    else { const int it2 = item - 16512, ch = it2 >> 10, e = it2 & 1023; base = F.stss() + (size_t)ch * NCH * 8192 + e * 8; dec = F.decss() + ch * NCH; d = ch >> 3; stride = 8192; nch = NCH; nctx = 4; }
    float s[8];
#pragma unroll
    for (int e = 0; e < 8; ++e) s[e] = 0.f;
#pragma unroll 1
    for (int p0 = 0; p0 < nch; p0 += 13) {
        u32x4 tmp[13]; float dc[13]; int tcs[13];
#pragma unroll
        for (int j = 0; j < 13; ++j) { const int pp = p0 + j; const int tc = d ? nch - 1 - pp : (pp < nctx ? nch - nctx + pp : pp - nctx); tcs[j] = tc;
            tmp[j] = *(const u32x4*)(base + (size_t)tc * stride); dc[j] = dec[tc]; }
#pragma unroll
        for (int j = 0; j < 13; ++j) { *(u32x4*)(base + (size_t)tcs[j] * stride) = __builtin_bit_cast(u32x4, pack8(s)); float t[8]; unpack8(tmp[j], t);
#pragma unroll
            for (int e = 0; e < 8; ++e) s[e] = dc[j] * s[e] + t[e]; }
    }
}

DI void phase_route(const Params& p, const Frame& F, int l) {
    constexpr unsigned RP = 4112;
    LAS unsigned char* L = F.L; const int lane = F.lane, g = lane >> 4, n = lane & 15;
    LAS int* lcnt = (LAS int*)(L + 36 * RP);
    __syncthreads();
    if (!DBG(1024)) { const bf16_t* rw = F.rwt() + (size_t)l * 36 * 2048;
      for (int ci = F.tid; ci < 36 * 256; ci += NTHR) { const int row = ci >> 8, c16 = ci & 255; *(LAS u32x4*)(L + row * RP + c16 * 16) = *(const u32x4*)(rw + row * 2048 + c16 * 8); } }
    if (F.tid < 32) lcnt[F.tid] = 0;
    __syncthreads();
    const int nrows = l == 0 ? NT : T;
    const float* modl = F.mod() + (size_t)l * 2 * 12288;
    const int ntile = nrows / 16, ntb = (ntile - F.bid + F.G - 1) / F.G;
    if (!DBG(2048))
#pragma unroll 2
    for (int j = F.wave; j < ntb * 16; j += 8) { const int row = ((j >> 4) * F.G + F.bid) * 16 + (j & 15);
        const float* md = modl + (size_t)(row >= T ? 1 : 0) * 12288;
        f32x4 v[8]; float ss = 0.f;
#pragma unroll
        for (int jj = 0; jj < 8; ++jj) { const u32x2 q = *(const u32x2*)(F.xbuf() + (size_t)row * 2048 + jj * 256 + lane * 4); v[jj] = (f32x4){bflo(q.x), bfhi(q.x), bflo(q.y), bfhi(q.y)}; ss += v[jj][0] * v[jj][0] + v[jj][1] * v[jj][1] + v[jj][2] * v[jj][2] + v[jj][3] * v[jj][3]; }
        ss = wsum(ss); const float rstd = rsqrtf(ss * (1.0f / 2048.0f) + 1e-6f);
#pragma unroll
        for (int jj = 0; jj < 8; ++jj) { const int c = jj * 256 + lane * 4;
            const f32x4 nwv = *(const f32x4*)(p.norm2_w + l * 2048 + c), sc = *(const f32x4*)(md + 4 * 2048 + c), sh = *(const f32x4*)(md + 3 * 2048 + c);
            const f32x4 o = v[jj] * rstd * nwv * (1.0f + sc) + sh;
            u32x2 pk; pk.x = pk2(o[0], o[1]); pk.y = pk2(o[2], o[3]); *(u32x2*)(F.h() + (size_t)row * 2048 + c) = pk; } }
    asm volatile("s_waitcnt vmcnt(0)" ::: "memory");
    __syncthreads();
    __builtin_amdgcn_fence(__ATOMIC_ACQUIRE, "agent");
    asm volatile("s_waitcnt vmcnt(0)" ::: "memory");
    const int r0 = (F.wave * F.G + F.bid) * 16;
    if (r0 < nrows) {
        if (!DBG(4096)) {
        f32x4 acc[3];
#pragma unroll
        for (int nt = 0; nt < 3; ++nt) acc[nt] = (f32x4){0.f, 0.f, 0.f, 0.f};
        const bf16_t* ap = F.h() + (size_t)(r0 + n) * 2048 + 8 * g;
        const unsigned bo0 = (unsigned)n * RP + 16u * g, bo1 = (unsigned)(16 + n) * RP + 16u * g, bo2 = (unsigned)(32 + n > 35 ? 35 : 32 + n) * RP + 16u * g;
#pragma unroll 16
        for (int ks = 0; ks < 64; ++ks) { const bf16x8 a = *(const bf16x8*)(ap + ks * 32);
            acc[0] = mfma16(*(LAS bf16x8*)(L + bo0 + ks * 64), a, acc[0]); acc[1] = mfma16(*(LAS bf16x8*)(L + bo1 + ks * 64), a, acc[1]); acc[2] = mfma16(*(LAS bf16x8*)(L + bo2 + ks * 64), a, acc[2]); }
        float gl[4];
#pragma unroll
        for (int r = 0; r < 4; ++r) gl[r] = __shfl(acc[0][r], n) + p.rg_b[l * 4 + r];
        int gs = 0; float gm = gl[0];
#pragma unroll
        for (int o = 1; o < 4; ++o) { if (gl[o] > gm) { gm = gl[o]; gs = o; } }
        float gden = 0.f;
#pragma unroll
        for (int o = 0; o < 4; ++o) gden += __expf(gl[o] - gm);
        const float gw = 1.0f / gden;
        float le[8];
#pragma unroll
        for (int i = 0; i < 8; ++i) { const int o = 4 + 8 * gs + i, nt = o >> 4, src = n + 16 * ((o >> 2) & 3);
            const float t0 = __shfl(acc[0][i & 3], src), t1 = __shfl(acc[1][i & 3], src), t2 = __shfl(acc[2][i & 3], src);
            le[i] = (nt == 0 ? t0 : (nt == 1 ? t1 : t2)) + p.re_b[l * 32 + gs * 8 + i]; }
        int i1 = 0; float v1 = le[0];
#pragma unroll
        for (int i = 1; i < 8; ++i) if (le[i] > v1) { v1 = le[i]; i1 = i; }
        int i2 = -1; float v2 = -INFINITY;
#pragma unroll
        for (int i = 0; i < 8; ++i) if (i != i1 && le[i] > v2) { v2 = le[i]; i2 = i; }
        const float w1 = 1.0f / (1.0f + __expf(v2 - v1)), w2 = 1.0f - w1;
        if (g == 0) { const int row = r0 + n, e1 = gs * 8 + i1, e2 = gs * 8 + i2;
            const int r1 = atomicAdd((int*)(lcnt + e1), 1), r2 = atomicAdd((int*)(lcnt + e2), 1);
            F.toke()[row * 2] = e1; F.toke()[row * 2 + 1] = e2; F.tokw()[row * 2] = w1 * gw; F.tokw()[row * 2 + 1] = w2 * gw; F.tokr()[row * 2] = r1; F.tokr()[row * 2 + 1] = r2; }
        }
    }
    __syncthreads();
    if (F.tid < 32) F.cnt()[F.bid * 32 + F.tid] = lcnt[F.tid];
}

DI void phase_slot(const Params& p, const Frame& F, int l) {
    LAS int* tot = (LAS int*)F.L; LAS int* pre = tot + 32; LAS int* pst = tot + 64; LAS int* pend = tot + 96; LAS int* part = tot + 128;
    __syncthreads();
    { const int e = F.tid & 31, pt = F.tid >> 5; int t = 0, pr = 0;
#pragma unroll 4
      for (int b = pt * 16; b < pt * 16 + 16; ++b) { const int c = F.cnt()[b * 32 + e]; t += c; pr += (b < F.bid) ? c : 0; }
      part[(pt * 2) * 32 + e] = t; part[(pt * 2 + 1) * 32 + e] = pr; }
    __syncthreads();
    if (F.tid < 32) { int t = 0, pr = 0; for (int pt = 0; pt < 16; ++pt) { t += part[(pt * 2) * 32 + F.tid]; pr += part[(pt * 2 + 1) * 32 + F.tid]; } tot[F.tid] = t; pre[F.tid] = pr; }
    __syncthreads();
    if (F.tid == 0) { int acc = 0; for (int e = 0; e < 32; ++e) { pst[e] = acc; acc += (tot[e] + 255) & ~255; pend[e] = acc; } }
    __syncthreads();
    if (F.bid == 0 && F.tid == 0) { int idx = 0; for (int e = 0; e < 32; ++e) { const int nt = (pend[e] - pst[e]) >> 8; for (int k = 0; k < nt; ++k) F.mte()[idx++] = e; } F.mte()[MAXMT] = idx; }
    const int nrows = l == 0 ? NT : T;
    const int r0 = (F.wave * F.G + F.bid) * 16;
    if (r0 < nrows) {
#pragma unroll 4
        for (int rr = 0; rr < 16; ++rr) { const int row = r0 + rr;
            const int e1 = F.toke()[row * 2], e2 = F.toke()[row * 2 + 1];
            const int s1 = pst[e1] + pre[e1] + F.tokr()[row * 2], s2 = pst[e2] + pre[e2] + F.tokr()[row * 2 + 1];
            if (F.lane == 0) { F.toks()[row * 2] = s1; F.toks()[row * 2 + 1] = s2; F.slotw()[s1] = F.tokw()[row * 2]; F.slotw()[s2] = F.tokw()[row * 2 + 1]; }
#pragma unroll
            for (int j = 0; j < 2; ++j) { float a[8], b[8]; unpack8(*(const u32x4*)(F.h() + (size_t)row * 2048 + j * 1024 + F.lane * 16), a); unpack8(*(const u32x4*)(F.h() + (size_t)row * 2048 + j * 1024 + F.lane * 16 + 8), b);
                u32x4 v; v.x = pk4_fp8(a[0] * FS_X, a[1] * FS_X, a[2] * FS_X, a[3] * FS_X); v.y = pk4_fp8(a[4] * FS_X, a[5] * FS_X, a[6] * FS_X, a[7] * FS_X);
                v.z = pk4_fp8(b[0] * FS_X, b[1] * FS_X, b[2] * FS_X, b[3] * FS_X); v.w = pk4_fp8(b[4] * FS_X, b[5] * FS_X, b[6] * FS_X, b[7] * FS_X);
                unsigned char* am = (unsigned char*)F.amoe();
                *(u32x4*)(am + (size_t)s1 * 2048 + j * 1024 + F.lane * 16) = v; *(u32x4*)(am + (size_t)s2 * 2048 + j * 1024 + F.lane * 16) = v; } }
    }
    { const int e = F.bid >> 3, part8 = F.bid & 7;
      unsigned zz = 0u; asm volatile("" : "+v"(zz)); const u32x4 zv = {zz, zz, zz, zz};
      if (e < 32) for (int s = pst[e] + tot[e] + part8 * 8 + F.wave; s < pend[e]; s += 64) {
          if (F.lane == 0) F.slotw()[s] = 0.f;
#pragma unroll
          for (int j = 0; j < 2; ++j) *(u32x4*)((unsigned char*)F.amoe() + (size_t)s * 2048 + j * 1024 + F.lane * 16) = zv; } }
}

__global__ void __launch_bounds__(NTHR, 2) fwd_kernel(Params p) {
    extern __shared__ __attribute__((aligned(16))) unsigned char lds_raw[];
    Frame F;
    F.L = (LAS unsigned char*)lds_raw; F.lb = (unsigned)(uintptr_t)F.L;
    F.tid = threadIdx.x; F.lane = F.tid & 63; F.wave = __builtin_amdgcn_readfirstlane(F.tid >> 6); F.bid = blockIdx.x; F.G = gridDim.x;
    unsigned char* ws = p.ws; F.ws = ws;

    volatile LAS unsigned* xbw = (volatile LAS unsigned*)(F.L + LDS_MISC);
    if (F.tid == 0) { xbw[0] = 0u; xbw[1] = 0u; }
    __syncthreads();
    const int lo = p.ph_lo, hi = p.ph_hi;
    const bool multi = (hi - lo) > 1;
    XcdBarrier bar; bar.bar = (unsigned*)(ws + WS_BAR); bar.x = 0; bar.st = xbw;
    if (multi) bar = xcd_barrier_post((unsigned*)(ws + WS_BAR), xbw);
#ifndef PH_MASK
#define PH_MASK 0xFFF
#endif
#ifndef TM
#define TM (p.tmask)
#endif
#define IN(k) (lo <= (k) && (k) < hi)
#define ON(j) (((PH_MASK) >> (j)) & 1)
#define SEAM(k) do { if (IN(k) && IN((k) + 1)) xcd_barrier(bar); } while (0)

    if (ON(0) && IN(0)) { phase_prologue(p, F.fresh()); } SEAM(0);
#ifdef EXTRA_BARRIERS
    if (hi - lo > 1) for (int eb = 0; eb < EXTRA_BARRIERS; ++eb) xcd_barrier(bar);
#endif
    for (int l = 0; l < 2; ++l) {
        const int pb = 1 + 11 * l;
        if (ON(1) && IN(pb + 0)) { if (l == 0) phase_rows<0>(p, F.fresh()); else phase_rows<1>(p, F.fresh()); } SEAM(pb + 0);
        if (ON(2) && IN(pb + 1)) {
            pg8::Gemm g{F.h(), F.win() + (size_t)l * NPAD * 2048, NT, NPAD, 2048}; pg8::StaticOrder S; S.init(NT, NPAD, F.G, F.bid);
            pg8::EpiProj E{F.proj(), F.gates()};
            pg8::gemm_phase<pg8::EpiProj, pg8::StaticOrder>(F.L, g, S, E, nullptr);
        } SEAM(pb + 1);
        if (ON(3) && IN(pb + 2)) { phase_prep(p, F.fresh(), l); } SEAM(pb + 2);
        if (ON(4) && IN(pb + 3)) {
            const Frame Fq = F.fresh(); const int ntask = l == 0 ? 1040 : 1024;
            if (TM & 1) for (int t = F.bid; t < ntask; t += F.G) na_task(p, Fq, l, t);
            if (TM & 2) for (int t = F.bid; t < NC2 * 4; t += F.G) ml_state128_task(p, Fq, t >> 2, t & 3);
            if (TM & 4) for (int t = F.bid; t < NCH * 2; t += F.G) ss_state_task(p, Fq, l, t >> 1, t & 1);
        } SEAM(pb + 3);
        if (ON(5) && IN(pb + 4)) { phase_scan(F.fresh()); } SEAM(pb + 4);
        if (ON(6) && IN(pb + 5)) {
            const Frame Fq = F.fresh(); const int nc = l == 0 ? NCH : 256;
            if (TM & 8) for (int t = F.bid; t < (nc >> 1) * 4; t += F.G) ml_out128_task(p, Fq, l, t >> 2, t & 3);
            if (TM & 16) for (int t = F.bid; t < nc * 2; t += F.G) ss_out_task(p, Fq, l, t >> 1, t & 1);
        } SEAM(pb + 5);
        if (ON(7) && IN(pb + 6)) {
            const int M = l == 0 ? NT : T;
            pg8::Gemm g{F.mix(), F.wout() + (size_t)l * 2048 * 2048, M, 2048, 2048}; pg8::StaticOrder S; S.init(M, 2048, F.G, F.bid);
            const float* gl = F.mod() + ((size_t)l * 2 + 0) * 12288 + 2 * 2048; const float* gc = F.mod() + ((size_t)l * 2 + 1) * 12288 + 2 * 2048;
            if (l == 0) { pg8::EpiRes<true> E{p.x, p.ctx, F.xbuf(), gl, gc}; pg8::gemm_phase<pg8::EpiRes<true>, pg8::StaticOrder>(F.L, g, S, E, nullptr); }
            else { pg8::EpiRes<false> E{nullptr, nullptr, F.xbuf(), gl, gc}; pg8::gemm_phase<pg8::EpiRes<false>, pg8::StaticOrder>(F.L, g, S, E, nullptr); }
        } SEAM(pb + 6);
        if (ON(8) && IN(pb + 7)) { phase_route(p, F.fresh(), l); } SEAM(pb + 7);
        if (ON(9) && IN(pb + 8)) { phase_slot(p, F.fresh(), l); } SEAM(pb + 8);
        if (ON(10) && IN(pb + 9)) {
            pg8::Gemm g{F.amoe(), (const bf16_t*)((const unsigned char*)F.w13() + (size_t)l * NEXP * 2048 * 2048), NSLOT, 2048, 2048};
            pg8::MoeOrder S{F.mte(), F.mte()[MAXMT] * 8, F.G, F.bid};
            pg8::EpiGateUp E{(unsigned char*)F.hid()};
            pg8::gemm_phase<pg8::EpiGateUp, pg8::MoeOrder, false, 1, SC_W13, SC_X>(F.L, g, S, E, nullptr);
        } SEAM(pb + 9);
        if (ON(11) && IN(pb + 10)) {
            pg8::Gemm g{F.hid(), (const bf16_t*)((const unsigned char*)F.w2() + (size_t)l * NEXP * 2048 * 1024), NSLOT, 2048, 1024};
            pg8::MoeOrder S{F.mte(), F.mte()[MAXMT] * 8, F.G, F.bid};
            pg8::EpiDown E{(unsigned char*)F.ymoe(), F.slotw()};
            pg8::gemm_phase<pg8::EpiDown, pg8::MoeOrder, false, 1, SC_W2, SC_X2>(F.L, g, S, E, nullptr);
        } SEAM(pb + 10);
    }
    if (ON(1) && IN(23)) { phase_rows<2>(p, F.fresh()); }
#undef IN
#undef SEAM
}

constexpr int NPHASE = 24;
#ifndef N_LAUNCH_MODE
#define N_LAUNCH_MODE 1
#endif

extern "C" void kernel_launch(void* const* d_in, const int* in_sizes, int n_in, void* d_out, int out_size, void* d_ws, size_t ws_size, hipStream_t stream) {
    static int grid = 0;
    if (grid == 0) {
        if (n_in != 27 || ws_size < WS_END) { fprintf(stderr, "kernel_launch: unexpected inputs (n_in %d) or workspace %zu < %zu\n", n_in, ws_size, (size_t)WS_END); grid = -1; return; }
        int dev = 0, cus = 0, per_cu = 0;
        hipGetDevice(&dev); hipDeviceGetAttribute(&cus, hipDeviceAttributeMultiprocessorCount, dev);
        if (hipFuncSetAttribute((const void*)fwd_kernel, hipFuncAttributeMaxDynamicSharedMemorySize, LDS_BYTES) != hipSuccess) { fprintf(stderr, "kernel_launch: hipFuncSetAttribute failed\n"); grid = -1; return; }
        hipOccupancyMaxActiveBlocksPerMultiprocessor(&per_cu, (const void*)fwd_kernel, NTHR, LDS_BYTES);
        (void)hipGetLastError();
        if (cus < 256 || per_cu < 1) { fprintf(stderr, "kernel_launch: needs 256 CUs with one resident workgroup each (cus %d, per_cu %d)\n", cus, per_cu); grid = -1; return; }
        grid = 256;
    }
    if (grid < 0) return;
    hipMemsetAsync((char*)d_ws + WS_BAR, 0, 65536, stream);
    Params p{};
    const float** pp = (const float**)&p;
    for (int i = 0; i < 27; ++i) pp[i] = (const float*)d_in[i];
    p.out = (float*)d_out; p.ws = (unsigned char*)d_ws;
#if N_LAUNCH_MODE == 1
    p.ph_lo = 0; p.ph_hi = NPHASE; p.tmask = 31; p.pad = 0;
    hipLaunchKernelGGL(fwd_kernel, dim3(grid), dim3(NTHR), LDS_BYTES, stream, p);
#ifdef PROBE_LIST
    { const int pl[] = PROBE_LIST; for (int pv : pl) { const int ph = pv & 255; p.tmask = ((pv >> 8) & 255) ? ((pv >> 8) & 255) : 31; p.pad = pv >> 16; p.ph_lo = ph; p.ph_hi = ph + 1; hipLaunchKernelGGL(fwd_kernel, dim3(grid), dim3(NTHR), LDS_BYTES, stream, p); } }
#endif
#else
    p.tmask = 31; p.pad = 0; for (int ph = 0; ph < NPHASE; ++ph) { p.ph_lo = ph; p.ph_hi = ph + 1; hipLaunchKernelGGL(fwd_kernel, dim3(grid), dim3(NTHR), LDS_BYTES, stream, p); }
#endif
}
```

```cpp
#include <hip/hip_runtime.h>
#include <stdint.h>
#include <stdio.h>

#ifdef PROBE_LIST
#define DBG(x) (p.pad & (x))
#else
#define DBG(x) 0
#endif
#define LAS __attribute__((address_space(3)))
#define DI __device__ __forceinline__
typedef unsigned short bf16_t;
typedef short bf16x8 __attribute__((ext_vector_type(8)));
typedef short bf16x4 __attribute__((ext_vector_type(4)));
typedef float f32x4 __attribute__((ext_vector_type(4)));
typedef float f32x2 __attribute__((ext_vector_type(2)));
typedef unsigned u32x4 __attribute__((ext_vector_type(4)));
typedef unsigned u32x2 __attribute__((ext_vector_type(2)));
typedef __bf16 bfv2 __attribute__((ext_vector_type(2)));

constexpr int D = 2048, T = 16384, CTXL = 256, NT = T + CTXL;
constexpr int INC = 6688, NPROJ = 6656, NPAD = 6912;
constexpr int QO = 0, KO = 1024, VO = 2048, MQO = 3072, MKO = 3584, MVO = 4096, MOO = 4608, ZO = 5120, XBO = 5632;
constexpr int NCH = 260;
constexpr int NEXP = 32, FF = 1024;
constexpr int MAXMT = 162, NSLOT = MAXMT * 256;
constexpr int NTHR = 512;
constexpr int LDS_BYTES = 155648;
constexpr int LDS_MISC = LDS_BYTES - 256;

constexpr size_t al256(size_t x) { return (x + 255) & ~(size_t)255; }
constexpr size_t WS_BAR   = 0;
constexpr size_t WS_MODP  = 65536;
constexpr size_t WS_MOD   = WS_MODP  + al256((size_t)2 * 8 * 2 * 12288 * 4);
constexpr size_t WS_ROPE  = WS_MOD   + al256((size_t)2 * 2 * 12288 * 4);
constexpr size_t WS_TOKE  = WS_ROPE  + al256((size_t)(256 + 64) * 32 * 2 * 4);
constexpr size_t WS_TOKW  = WS_TOKE  + al256((size_t)NT * 2 * 4);
constexpr size_t WS_TOKR  = WS_TOKW  + al256((size_t)NT * 2 * 4);
constexpr size_t WS_TOKS  = WS_TOKR  + al256((size_t)NT * 2 * 4);
constexpr size_t WS_CNT   = WS_TOKS  + al256((size_t)NT * 2 * 4);
constexpr size_t WS_MTE   = WS_CNT   + al256((size_t)256 * 32 * 4);
constexpr size_t WS_SLOTW = WS_MTE   + al256((size_t)(MAXMT + 2) * 4);
constexpr size_t WS_GATES = WS_SLOTW + al256((size_t)NSLOT * 4);
constexpr size_t WS_MLG   = WS_GATES + al256((size_t)NT * 32 * 4);
constexpr size_t WS_DT    = WS_MLG   + al256((size_t)NT * 16 * 4);
constexpr size_t WS_DECML = WS_DT    + al256((size_t)NT * 16 * 4);
constexpr size_t WS_DECSS = WS_DECML + al256((size_t)8 * NCH * 4);
constexpr size_t WS_RWT   = WS_DECSS + al256((size_t)16 * NCH * 4);
constexpr size_t WS_WIN   = WS_RWT   + al256((size_t)2 * 36 * 2048 * 2);
constexpr size_t WS_WOUT  = WS_WIN   + (size_t)2 * NPAD * D * 2;
constexpr size_t WS_W13   = WS_WOUT  + (size_t)2 * D * D * 2;
constexpr size_t WS_W2    = WS_W13   + (size_t)2 * NEXP * 2048 * D * 2;
constexpr size_t WS_H     = WS_W2    + (size_t)2 * NEXP * D * FF * 2;
constexpr size_t WS_XBUF  = WS_H     + (size_t)NT * D * 2;
constexpr size_t WS_PROJ  = WS_XBUF  + (size_t)NT * D * 4;
constexpr size_t WS_XBCC  = WS_PROJ  + (size_t)NT * NPROJ * 2;
constexpr size_t WS_MIX   = WS_XBCC  + (size_t)NT * 1024 * 2;
constexpr size_t WS_STML  = WS_MIX   + (size_t)NT * D * 2;
constexpr size_t WS_STSS  = WS_STML  + (size_t)8 * NCH * 16512 * 4;
constexpr size_t WS_END   = WS_STSS  + (size_t)16 * NCH * 8192 * 4;
constexpr size_t WS_AMOE  = WS_PROJ;
constexpr size_t WS_HID   = WS_AMOE + (size_t)NSLOT * D * 2;
constexpr size_t WS_YMOE  = WS_MIX;
static_assert(WS_HID + (size_t)NSLOT * FF * 2 <= WS_MIX, "moe alias 1");
static_assert(WS_YMOE + (size_t)NSLOT * D * 2 <= WS_STSS, "moe alias 2");

struct Params {
    const float *x, *c, *ctx, *c_ctx, *w_mod, *b_mod, *norm1_w, *norm2_w, *w_in, *w_out, *na_rpb, *ml_gate_b, *ml_norm_w,
                *conv_w, *conv_b, *dt_bias, *a_log, *ssm_d, *ssm_norm_w, *rg_w, *rg_b, *re_w, *re_b, *w1, *w3, *w2, *final_w;
    float* out; unsigned char* ws; int ph_lo, ph_hi, tmask, pad;
};

DI unsigned pk2(float lo, float hi) { f32x2 v = {lo, hi}; bfv2 b = __builtin_convertvector(v, bfv2); return __builtin_bit_cast(unsigned, b); }
DI float bflo(unsigned u) { return __uint_as_float(u << 16); }
DI float bfhi(unsigned u) { return __uint_as_float(u & 0xffff0000u); }
DI float bf2f(bf16_t b) { return __uint_as_float(((unsigned)b) << 16); }
DI bf16_t f2bf(float f) { return (bf16_t)(pk2(f, 0.f) & 0xffffu); }
DI float wsum(float v) { v += __shfl_xor(v, 32); v += __shfl_xor(v, 16); v += __shfl_xor(v, 8); v += __shfl_xor(v, 4); v += __shfl_xor(v, 2); v += __shfl_xor(v, 1); return v; }
DI float gsum4(float v) { v += __shfl_xor(v, 16); v += __shfl_xor(v, 32); return v; }
DI f32x4 mfma16(bf16x8 a, bf16x8 b, f32x4 c) { return __builtin_amdgcn_mfma_f32_16x16x32_bf16(a, b, c, 0, 0, 0); }
DI float siluf(float v) { return v / (1.0f + __expf(-v)); }
DI float sigmf(float v) { return 1.0f / (1.0f + __expf(-v)); }
DI bf16x8 pack8(const float (&v)[8]) { u32x4 p; p.x = pk2(v[0], v[1]); p.y = pk2(v[2], v[3]); p.z = pk2(v[4], v[5]); p.w = pk2(v[6], v[7]); return __builtin_bit_cast(bf16x8, p); }
DI void unpack8(u32x4 u, float (&v)[8]) { v[0] = bflo(u.x); v[1] = bfhi(u.x); v[2] = bflo(u.y); v[3] = bfhi(u.y); v[4] = bflo(u.z); v[5] = bfhi(u.z); v[6] = bflo(u.w); v[7] = bfhi(u.w); }
DI bf16x8 frag_row(LAS unsigned char* L, unsigned tb, unsigned pb, int r0, int k0, int lane) {
    return *(LAS bf16x8*)(L + tb + (unsigned)(r0 + (lane & 15)) * pb + (unsigned)(k0 + 8 * (lane >> 4)) * 2u);
}
DI bf16x8 frag_tr(unsigned lbase, unsigned tb, unsigned pb, int rA, int rB, int c0, int lane) {
    const int q = (lane & 15) >> 2, pq = lane & 3;
    const unsigned a0 = lbase + tb + (unsigned)(rA + q) * pb + (unsigned)(c0 + 4 * pq) * 2u;
    const unsigned a1 = lbase + tb + (unsigned)(rB + q) * pb + (unsigned)(c0 + 4 * pq) * 2u;
    bf16x4 lo, hi;
    asm volatile("ds_read_b64_tr_b16 %0, %2\n\tds_read_b64_tr_b16 %1, %3\n\ts_waitcnt lgkmcnt(0)" : "=&v"(lo), "=&v"(hi) : "v"(a0), "v"(a1) : "memory");
    bf16x8 r; r[0] = lo[0]; r[1] = lo[1]; r[2] = lo[2]; r[3] = lo[3]; r[4] = hi[0]; r[5] = hi[1]; r[6] = hi[2]; r[7] = hi[3]; return r;
}
DI float wscan(float v, int rev, int lane) {
#pragma unroll
    for (int off = 1; off < 64; off <<= 1) {
        const float t = rev ? __shfl_down(v, off) : __shfl_up(v, off);
        const bool ok = rev ? (lane + off < 64) : (lane >= off);
        v += ok ? t : 0.f;
    }
    return v;
}
DI void frag_tr_x4(bf16x8 (&f)[4], unsigned lbase, unsigned tb, unsigned pb, int rA, int rB, int c0, int lane) {
    const int q = (lane & 15) >> 2, pq = lane & 3;
    const unsigned a0 = lbase + tb + (unsigned)(rA + q) * pb + (unsigned)(c0 + 4 * pq) * 2u;
    const unsigned a1 = lbase + tb + (unsigned)(rB + q) * pb + (unsigned)(c0 + 4 * pq) * 2u;
    bf16x4 l0, l1, l2, l3, h0, h1, h2, h3;
    asm volatile("ds_read_b64_tr_b16 %0, %8\n\tds_read_b64_tr_b16 %1, %8 offset:32\n\tds_read_b64_tr_b16 %2, %8 offset:64\n\tds_read_b64_tr_b16 %3, %8 offset:96\n\t"
                 "ds_read_b64_tr_b16 %4, %9\n\tds_read_b64_tr_b16 %5, %9 offset:32\n\tds_read_b64_tr_b16 %6, %9 offset:64\n\tds_read_b64_tr_b16 %7, %9 offset:96\n\ts_waitcnt lgkmcnt(0)"
                 : "=&v"(l0), "=&v"(l1), "=&v"(l2), "=&v"(l3), "=&v"(h0), "=&v"(h1), "=&v"(h2), "=&v"(h3) : "v"(a0), "v"(a1) : "memory");
    f[0] = __builtin_shufflevector(l0, h0, 0, 1, 2, 3, 4, 5, 6, 7); f[1] = __builtin_shufflevector(l1, h1, 0, 1, 2, 3, 4, 5, 6, 7);
    f[2] = __builtin_shufflevector(l2, h2, 0, 1, 2, 3, 4, 5, 6, 7); f[3] = __builtin_shufflevector(l3, h3, 0, 1, 2, 3, 4, 5, 6, 7);
}
DI unsigned pk4_fp8(float a, float b, float c, float d) { int w = 0; w = __builtin_amdgcn_cvt_pk_fp8_f32(a, b, w, false); w = __builtin_amdgcn_cvt_pk_fp8_f32(c, d, w, true); return (unsigned)w; }
constexpr float FS_W13 = 64.f, FS_W2 = 32.f, FS_X = 4.f, FS_Y = 16.f;
constexpr int SC_W13 = 127 - 4, SC_W2 = 127 - 4, SC_X = 127 - 4, SC_X2 = 127 - 3;
DI f32x4 unpk4_fp8(unsigned w) { const f32x2 lo = __builtin_amdgcn_cvt_pk_f32_fp8((int)w, false), hi = __builtin_amdgcn_cvt_pk_f32_fp8((int)w, true); return (f32x4){lo[0], lo[1], hi[0], hi[1]}; }

namespace pg8 {
#define PG8_LAS __attribute__((address_space(3)))
typedef unsigned short bf16_t;
typedef short bf16x8 __attribute__((ext_vector_type(8)));
typedef float f32x4 __attribute__((ext_vector_type(4)));
typedef unsigned u32x4 __attribute__((ext_vector_type(4)));
constexpr int BM = 256, BK = 64, HALF = 128, HTB = HALF * BK * 2, STAGE_BYTES = 8 * HTB, NXCD = 8, WGM = 8;
__host__ __device__ __forceinline__ int lds_byte(int r, int c) { const int st = (r >> 4) * 2 + (c >> 5), rr = r & 15, cc = c & 31, ob = rr * 64 + cc * 2; return st * 1024 + (ob ^ (((ob >> 9) & 1) << 5)); }
__host__ __device__ __forceinline__ void stage_rc(int b, int& R, int& C) { const int st = b / 1024, sb = b % 1024, swz = sb ^ (((sb >> 9) & 1) << 5); R = (st >> 1) * 16 + swz / 64; C = (st & 1) * 32 + (swz % 64) / 2; }
__host__ __device__ __forceinline__ int perm32(int rho) { const int n = rho >> 4, i = rho & 15; return 8 * (i >> 2) + 4 * n + (i & 3); }
struct Unit { int pm, pn; };
struct Gemm { const bf16_t* A; const bf16_t* Bt; int M, N, K; };
struct StaticOrder {
    int nM, nN, nwg, G, c;
    __host__ __device__ void init(int M, int N, int G_, int c_) { nM = M / BM; nN = N / BM; nwg = nM * nN; G = G_; c = c_; }
    __host__ __device__ bool next(int i, Unit& u) const {
        const long L = (long)i * G + c; if (L >= nwg) return false;
        int wgid = (int)L; { const int q = nwg / NXCD, r = nwg % NXCD, xcd = wgid % NXCD, off = wgid / NXCD; wgid = (xcd < r ? xcd * (q + 1) : r * (q + 1) + (xcd - r) * q) + off; }
        const int nig = WGM * nN, gid = wgid / nig, fm = gid * WGM, gsz = (nM - fm) < WGM ? (nM - fm) : WGM;
        u.pm = fm + ((wgid % nig) % gsz); u.pn = (wgid % nig) / gsz; return true;
    }
    __device__ __forceinline__ void a_ready(const Unit&) const {}
    __device__ __forceinline__ void done(const Unit&) const {}
};
struct MoeOrder {
    const int* mte; int nunits, G, c;
    __device__ bool next(int i, Unit& u) const { const int L = i * G + c; if (L >= nunits) return false; const int mt = L >> 3; u.pm = mt; u.pn = mte[mt] * 8 + (L & 7); return true; }
    __device__ __forceinline__ void a_ready(const Unit&) const {}
    __device__ __forceinline__ void done(const Unit&) const {}
};
DI unsigned pk2(float lo, float hi) { return ::pk2(lo, hi); }
DI unsigned pk4_fp8(float a, float b, float c, float d) { return ::pk4_fp8(a, b, c, d); }
using ::FS_X; using ::FS_Y;

struct EpiProj {
    static constexpr bool PERM = true, AFTER_DRAIN = false;
    bf16_t* O; float* gates;
    __device__ __forceinline__ void operator()(const f32x4 (&acc)[2][2][4][2], const Unit& u, int wr, int wc, int fr, int fq) const {
        const int row0 = u.pm * BM + wr * 64 + fr;
        if (u.pn < 26) {
            const int col0 = u.pn * BM + wc * 32 + 8 * fq;
#pragma unroll
            for (int ai = 0; ai < 2; ++ai)
#pragma unroll
                for (int m = 0; m < 4; ++m) { bf16_t* rowp = O + (size_t)(row0 + ai * HALF + m * 16) * 6656 + col0;
#pragma unroll
                    for (int bj = 0; bj < 2; ++bj) { const f32x4 v0 = acc[ai][bj][m][0], v1 = acc[ai][bj][m][1];
                        u32x4 w; w.x = pk2(v0[0], v0[1]); w.y = pk2(v0[2], v0[3]); w.z = pk2(v1[0], v1[1]); w.w = pk2(v1[2], v1[3]);
                        *(u32x4*)(rowp + bj * HALF) = w; } }
        } else if (wc == 0) {
#pragma unroll
            for (int ai = 0; ai < 2; ++ai)
#pragma unroll
                for (int m = 0; m < 4; ++m) { float* rowp = gates + (size_t)(row0 + ai * HALF + m * 16) * 32 + 8 * fq;
                    *(f32x4*)(rowp) = acc[ai][0][m][0]; *(f32x4*)(rowp + 4) = acc[ai][0][m][1]; }
        }
    }
};
template <bool BF32> struct EpiRes {
    static constexpr bool PERM = true, AFTER_DRAIN = false;
    const float* base_lat; const float* base_ctx; bf16_t* out; const float* g_lat; const float* g_ctx;
    __device__ __forceinline__ void operator()(const f32x4 (&acc)[2][2][4][2], const Unit& u, int wr, int wc, int fr, int fq) const {
        const bool isctx = u.pm >= 64;
        const float* base = isctx ? base_ctx - (size_t)16384 * 2048 : base_lat; const float* gv = isctx ? g_ctx : g_lat;
        const int row0 = u.pm * BM + wr * 64 + fr, col0 = u.pn * BM + wc * 32 + 8 * fq;
        f32x4 gg[2][2];
#pragma unroll
        for (int bj = 0; bj < 2; ++bj)
#pragma unroll
            for (int n = 0; n < 2; ++n) gg[bj][n] = *(const f32x4*)(gv + col0 + bj * HALF + n * 4);
#pragma unroll
        for (int ai = 0; ai < 2; ++ai)
#pragma unroll
            for (int m = 0; m < 4; ++m) { const size_t off = (size_t)(row0 + ai * HALF + m * 16) * 2048 + col0;
#pragma unroll
                for (int bj = 0; bj < 2; ++bj) { f32x4 b0, b1;
                    if constexpr (BF32) { b0 = *(const f32x4*)(base + off + bj * HALF); b1 = *(const f32x4*)(base + off + bj * HALF + 4); }
                    else { const u32x4 q = *(const u32x4*)(out + off + bj * HALF); b0 = (f32x4){__uint_as_float(q.x << 16), __uint_as_float(q.x & 0xffff0000u), __uint_as_float(q.y << 16), __uint_as_float(q.y & 0xffff0000u)};
                           b1 = (f32x4){__uint_as_float(q.z << 16), __uint_as_float(q.z & 0xffff0000u), __uint_as_float(q.w << 16), __uint_as_float(q.w & 0xffff0000u)}; }
                    const f32x4 v0 = b0 + gg[bj][0] * acc[ai][bj][m][0], v1 = b1 + gg[bj][1] * acc[ai][bj][m][1];
                    u32x4 w; w.x = pk2(v0[0], v0[1]); w.y = pk2(v0[2], v0[3]); w.z = pk2(v1[0], v1[1]); w.w = pk2(v1[2], v1[3]);
                    *(u32x4*)(out + off + bj * HALF) = w; } }
    }
};
struct EpiGateUp {
    static constexpr bool PERM = true, AFTER_DRAIN = false;
    unsigned char* O;
    __device__ __forceinline__ void operator()(const f32x4 (&acc)[2][2][4][2], const Unit& u, int wr, int wc, int fr, int fq) const {
        const int row0 = u.pm * BM + wr * 64 + fr, col0 = (u.pn & 7) * 128 + wc * 32 + 8 * fq;
#pragma unroll
        for (int ai = 0; ai < 2; ++ai)
#pragma unroll
            for (int m = 0; m < 4; ++m) { float h[8];
#pragma unroll
                for (int n = 0; n < 2; ++n)
#pragma unroll
                    for (int j = 0; j < 4; ++j) { const float gt = acc[ai][0][m][n][j], up = acc[ai][1][m][n][j]; h[n * 4 + j] = gt / (1.0f + __expf(-gt)) * up * FS_X; }
                u32x2 w; w.x = pk4_fp8(h[0], h[1], h[2], h[3]); w.y = pk4_fp8(h[4], h[5], h[6], h[7]);
                *(u32x2*)(O + (size_t)(row0 + ai * HALF + m * 16) * 1024 + col0) = w; }
    }
};
struct EpiDown {
    static constexpr bool PERM = true, AFTER_DRAIN = false;
    unsigned char* O; const float* sw;
    __device__ __forceinline__ void operator()(const f32x4 (&acc)[2][2][4][2], const Unit& u, int wr, int wc, int fr, int fq) const {
        const int row0 = u.pm * BM + wr * 64 + fr, col0 = (u.pn & 7) * BM + wc * 32 + 8 * fq;
#pragma unroll
        for (int ai = 0; ai < 2; ++ai)
#pragma unroll
            for (int m = 0; m < 4; ++m) { const int row = row0 + ai * HALF + m * 16; const float s = sw[row] * FS_Y; unsigned char* rowp = O + (size_t)row * 2048 + col0;
#pragma unroll
                for (int bj = 0; bj < 2; ++bj) { const f32x4 v0 = acc[ai][bj][m][0] * s, v1 = acc[ai][bj][m][1] * s;
                    u32x2 w; w.x = pk4_fp8(v0[0], v0[1], v0[2], v0[3]); w.y = pk4_fp8(v1[0], v1[1], v1[2], v1[3]);
                    *(u32x2*)(rowp + bj * HALF) = w; } }
    }
};

template <class Epi, class Sched, bool STAMP = false, int ES = 2, int SCW = 127, int SCX = 127>
__device__ __forceinline__ void gemm_phase(PG8_LAS unsigned char* lds, const Gemm g, const Sched& S, const Epi& E, unsigned long long* stamps) {
    int tid_ = threadIdx.x; asm volatile("" : "+v"(tid_)); const int tid = tid_, wid = __builtin_amdgcn_readfirstlane(tid >> 6), lane = tid & 63, wr = wid >> 2, wc = wid & 3, fr = lane & 15, fq = lane >> 4;
    const int K = g.K * ES / 2  , nt = K / BK;
    int ts_lo = 0, ts_hi = 0, nts = 0; const unsigned long long rt_entry = STAMP ? (unsigned long long)wall_clock64() : 0ull;
#define PG8_STAMP() do { if (STAMP && wid == 0 && nts < 64) { const unsigned long long _c = (unsigned long long)clock64(); \
        ts_lo = (lane == nts) ? (int)(unsigned)_c : ts_lo; ts_hi = (lane == nts) ? (int)(unsigned)(_c >> 32) : ts_hi; ++nts; } } while (0)
    PG8_STAMP();
    unsigned voffA[2], voffB[2];
#pragma unroll
    for (int i = 0; i < 2; ++i) { int R, C; stage_rc(tid * 16 + i * 8192, R, C); const int Rb = Epi::PERM ? ((R & ~31) + perm32(R & 31)) : R;
        voffA[i] = (unsigned)(R * K + C) * 2u; voffB[i] = (unsigned)(Rb * K + C) * 2u; }
    const size_t kstep = (size_t)(BK * 2);
    const size_t hstep = (size_t)HALF * K * 2;
    const size_t tstep = 2 * hstep;
    const unsigned ldsw = (unsigned)wid * 1024u;
    const int aoff = lds_byte(wr * 64 + fr, fq * 8), boff = lds_byte(wc * 32 + fr, fq * 8);
#define PG8_SA(b, h) (((b) * 2 + (h)) * HTB)
#define PG8_SB(b, h) ((4 + (b) * 2 + (h)) * HTB)
#define PG8_STAGE(bufoff, gbase, voff) do { _Pragma("unroll") for (int _i = 0; _i < 2; ++_i) \
        __builtin_amdgcn_global_load_lds((const unsigned*)((const char*)(gbase) + (voff)[_i]), (PG8_LAS unsigned*)(lds + (bufoff) + ldsw + _i * 8192), 16, 0, 0); } while (0)
#define PG8_LDA(dst, b, h) do { _Pragma("unroll") for (int m = 0; m < 4; ++m) { \
        if constexpr (ES == 2) { _Pragma("unroll") for (int k = 0; k < 2; ++k) dst[m][k] = *(const PG8_LAS bf16x8*)(lds + PG8_SA(b, h) + aoff + m * 2048 + k * 1024); } \
        else { const v4i_ lo_ = *(const PG8_LAS v4i_*)(lds + PG8_SA(b, h) + aoff + m * 2048), hi_ = *(const PG8_LAS v4i_*)(lds + PG8_SA(b, h) + aoff + m * 2048 + 1024); dst##8[m] = __builtin_shufflevector(lo_, hi_, 0, 1, 2, 3, 4, 5, 6, 7); } } } while (0)
#define PG8_LDB(dst, b, h) do { _Pragma("unroll") for (int n = 0; n < 2; ++n) { \
        if constexpr (ES == 2) { _Pragma("unroll") for (int k = 0; k < 2; ++k) dst[n][k] = *(const PG8_LAS bf16x8*)(lds + PG8_SB(b, h) + boff + n * 2048 + k * 1024); } \
        else { const v4i_ lo_ = *(const PG8_LAS v4i_*)(lds + PG8_SB(b, h) + boff + n * 2048), hi_ = *(const PG8_LAS v4i_*)(lds + PG8_SB(b, h) + boff + n * 2048 + 1024); dst##8[n] = __builtin_shufflevector(lo_, hi_, 0, 1, 2, 3, 4, 5, 6, 7); } } } while (0)
#define PG8_MMA(ai, bj, At, Bt) do { __builtin_amdgcn_s_setprio(1); _Pragma("unroll") for (int m = 0; m < 4; ++m) _Pragma("unroll") for (int n = 0; n < 2; ++n) { \
        if constexpr (ES == 2) { _Pragma("unroll") for (int k = 0; k < 2; ++k) acc[ai][bj][m][n] = __builtin_amdgcn_mfma_f32_16x16x32_bf16(Bt[n][k], At[m][k], acc[ai][bj][m][n], 0, 0, 0); } \
        else asm volatile("v_mfma_scale_f32_16x16x128_f8f6f4 %0, %1, %2, %0, %3, %4 op_sel_hi:[0,0,0]" : "+v"(acc[ai][bj][m][n]) : "v"(Bt##8[n]), "v"(At##8[m]), "v"(scw_), "v"(scx_)); } \
        __builtin_amdgcn_s_setprio(0); } while (0)
#define PG8_WAIT_V(n) asm volatile("s_waitcnt vmcnt(" #n ")" ::: "memory")
#define PG8_WAIT_L(n) asm volatile("s_waitcnt lgkmcnt(" #n ")" ::: "memory")
#define PG8_BAR __builtin_amdgcn_s_barrier()
#define PG8_SCHED __builtin_amdgcn_sched_barrier(0)
    Unit cur, nxt; int ui = 0;
    if (!S.next(0, cur)) return;
    f32x4 acc[2][2][4][2];
#pragma unroll
    for (int a = 0; a < 2; ++a)
#pragma unroll
        for (int b = 0; b < 2; ++b)
#pragma unroll
            for (int m = 0; m < 4; ++m)
#pragma unroll
                for (int n = 0; n < 2; ++n) acc[a][b][m][n] = (f32x4){0.f, 0.f, 0.f, 0.f};
    typedef int v4i_ __attribute__((ext_vector_type(4))); typedef int v8i_ __attribute__((ext_vector_type(8)));
    bf16x8 At[4][2], B0[2][2], B1[2][2]; v8i_ At8[4], B08[2], B18[2]; const int scw_ = SCW * 0x01010101, scx_ = SCX * 0x01010101;
    const char* cA = (const char*)g.A + (size_t)cur.pm * tstep; const char* cB = (const char*)g.Bt + (size_t)cur.pn * tstep;
    S.a_ready(cur);
    PG8_STAGE(PG8_SB(0, 0), cB, voffB); PG8_STAGE(PG8_SA(0, 0), cA, voffA); PG8_STAGE(PG8_SB(0, 1), cB + hstep, voffB); PG8_STAGE(PG8_SA(0, 1), cA + hstep, voffA);
    if (wr == 1) PG8_BAR;
    PG8_WAIT_V(4); PG8_BAR;
    PG8_STAGE(PG8_SB(1, 0), cB + kstep, voffB); PG8_STAGE(PG8_SA(1, 0), cA + kstep, voffA); PG8_STAGE(PG8_SB(1, 1), cB + hstep + kstep, voffB);
    PG8_WAIT_V(6); PG8_BAR;
    PG8_STAMP();
    for (;;) {
        const bool has_next = S.next(ui + 1, nxt);
        const char* nA = has_next ? (const char*)g.A + (size_t)nxt.pm * tstep : cA; const char* nB = has_next ? (const char*)g.Bt + (size_t)nxt.pn * tstep : cB;
        for (int t = 0; t < nt; t += 2) {
            const bool last = (t == nt - 2);
            const char* a1 = cA + (size_t)(t + 1) * kstep;
            const char* a2 = last ? nA : cA + (size_t)(t + 2) * kstep; const char* b2 = last ? nB : cB + (size_t)(t + 2) * kstep;
            const char* a3 = a2 + kstep; const char* b3 = b2 + kstep;
            if (last && has_next) S.a_ready(nxt);
            PG8_LDB(B0, 0, 0); PG8_SCHED; PG8_LDA(At, 0, 0); PG8_STAGE(PG8_SA(1, 1), a1 + hstep, voffA);
            PG8_WAIT_L(8); PG8_BAR; PG8_WAIT_L(0); PG8_MMA(0, 0, At, B0); PG8_BAR; PG8_SCHED;
            PG8_LDB(B1, 0, 1); PG8_STAGE(PG8_SB(0, 0), b2, voffB);
            PG8_BAR; PG8_WAIT_L(0); PG8_MMA(0, 1, At, B1); PG8_BAR;
            PG8_LDA(At, 0, 1); PG8_STAGE(PG8_SA(0, 0), a2, voffA);
            PG8_BAR; PG8_WAIT_L(0); PG8_MMA(1, 0, At, B0); PG8_BAR; PG8_SCHED;
            PG8_STAGE(PG8_SB(0, 1), b2 + hstep, voffB);
            PG8_WAIT_V(6); PG8_BAR; PG8_MMA(1, 1, At, B1); PG8_BAR;
            PG8_LDB(B0, 1, 0); PG8_SCHED; PG8_LDA(At, 1, 0); PG8_STAGE(PG8_SA(0, 1), a2 + hstep, voffA);
            PG8_WAIT_L(8); PG8_BAR; PG8_WAIT_L(0); PG8_MMA(0, 0, At, B0); PG8_BAR; PG8_SCHED;
            PG8_LDB(B1, 1, 1); PG8_STAGE(PG8_SB(1, 0), b3, voffB);
            PG8_BAR; PG8_WAIT_L(0); PG8_MMA(0, 1, At, B1); PG8_BAR;
            PG8_LDA(At, 1, 1); PG8_STAGE(PG8_SA(1, 0), a3, voffA);
            PG8_BAR; PG8_WAIT_L(0); PG8_MMA(1, 0, At, B0); PG8_BAR; PG8_SCHED;
            PG8_STAGE(PG8_SB(1, 1), b3 + hstep, voffB);
            PG8_WAIT_V(6); PG8_BAR; PG8_MMA(1, 1, At, B1); PG8_BAR;
        }
        PG8_STAMP();
        if constexpr (ES == 1) { asm volatile("s_nop 15\n\ts_nop 15\n\ts_nop 15" ::: "memory"); __builtin_amdgcn_sched_barrier(0); }
        if constexpr (!Epi::AFTER_DRAIN) { E(acc, cur, wr, wc, fr, fq); S.done(cur); }
        PG8_STAMP();
        if (!has_next) break;
#pragma unroll
        for (int a = 0; a < 2; ++a)
#pragma unroll
            for (int b = 0; b < 2; ++b)
#pragma unroll
                for (int m = 0; m < 4; ++m)
#pragma unroll
                    for (int n = 0; n < 2; ++n) acc[a][b][m][n] = (f32x4){0.f, 0.f, 0.f, 0.f};
        cur = nxt; cA = nA; cB = nB; ++ui;
    }
    PG8_WAIT_V(0);
    if (wr == 0) PG8_BAR;
    PG8_BAR;
    if constexpr (Epi::AFTER_DRAIN) { E.fused(acc, cur, wr, wc, fr, fq, lds, wid, lane); S.done(cur); }
    PG8_STAMP();
    if (STAMP && wid == 0) { stamps[lane] = lane < nts ? (((unsigned long long)(unsigned)ts_hi << 32) | (unsigned)ts_lo) : 0ull;
        if (lane == 62) stamps[62] = rt_entry; if (lane == 63) stamps[63] = (unsigned long long)wall_clock64(); }
#undef PG8_STAMP
#undef PG8_SA
#undef PG8_SB
#undef PG8_STAGE
#undef PG8_LDA
#undef PG8_LDB
#undef PG8_MMA
#undef PG8_WAIT_V
#undef PG8_WAIT_L
#undef PG8_BAR
#undef PG8_SCHED
}
}

#define XB_TMO      128
#define XB_XCNT(j)  (256  + 64 * (j))
#define XB_XSUB(j)  (1280 + 64 * (j))
#define XB_XGEN(j)  (2304 + 64 * (j))
#define XB_TOP      3328
#define XB_TOPGEN   3392
#define XCD_BAR_WORDS 3456
#define XB_SPIN_CAP (1u << 18)
__device__ __forceinline__ unsigned xb_ld(unsigned* p)              { return __hip_atomic_load(p, __ATOMIC_RELAXED, __HIP_MEMORY_SCOPE_AGENT); }
__device__ __forceinline__ unsigned xb_add(unsigned* p, unsigned v) { return __hip_atomic_fetch_add(p, v, __ATOMIC_RELAXED, __HIP_MEMORY_SCOPE_AGENT); }
__device__ __forceinline__ unsigned xb_xcc_id() { return (unsigned)__builtin_amdgcn_s_getreg((3 << 11) | 20) & 0xFu; }
#define XB_SPIN(cond, bar) do { unsigned _sp = 0; while (cond) { __builtin_amdgcn_s_sleep(1); \
    if ((++_sp & 255u) == 0u) { if (xb_ld(&(bar)[XB_TMO])) break; if (_sp > XB_SPIN_CAP) { atomicAdd(&(bar)[XB_TMO], 1u); break; } } } } while (0)
struct XcdBarrier { unsigned* bar; unsigned x; volatile LAS unsigned* st; };
__device__ __forceinline__ XcdBarrier xcd_barrier_post(unsigned* bar, volatile LAS unsigned* st) {
    XcdBarrier b; b.bar = bar; b.x = xb_xcc_id(); b.st = st;
    if (threadIdx.x == 0) (void)xb_add(&bar[XB_XCNT(b.x)], 1u);
    return b;
}
__device__ __forceinline__ void xcd_barrier_complete(unsigned* bar, unsigned x, unsigned& nloc, unsigned& nx) {
    const unsigned G = gridDim.x * gridDim.y * gridDim.z;
    unsigned sum, cnt, mine, sp = 0u;
    for (;;) {
        sum = 0u; cnt = 0u; mine = 0u;
#pragma unroll
        for (unsigned j = 0; j < 16; ++j) { const unsigned c = xb_ld(&bar[XB_XCNT(j)]); sum += c; cnt += (c > 0u) ? 1u : 0u; mine = (j == x) ? c : mine; }
        if (sum == G) break;
        __builtin_amdgcn_s_sleep(1);
        if ((++sp & 255u) == 0u) { if (xb_ld(&bar[XB_TMO])) break; if (sp > XB_SPIN_CAP) { atomicAdd(&bar[XB_TMO], 1u); break; } }
    }
    nloc = mine > 0u ? mine : 1u; nx = cnt > 0u ? cnt : 1u;
}
__device__ __forceinline__ void xcd_barrier(const XcdBarrier& b) {
    asm volatile("s_waitcnt vmcnt(0)" ::: "memory");
    __syncthreads();
    if (threadIdx.x == 0) {
        unsigned* bar = b.bar;
        __builtin_amdgcn_s_waitcnt(0);
        unsigned nloc = b.st[0], nx = b.st[1];
        if (nloc == 0u) { xcd_barrier_complete(bar, b.x, nloc, nx); b.st[0] = nloc; b.st[1] = nx; }
        const unsigned old = xb_add(&bar[XB_XSUB(b.x)], 1u);
        const unsigned gen = old / nloc;
        if (old + 1u == (gen + 1u) * nloc) {
            __builtin_amdgcn_fence(__ATOMIC_RELEASE, "agent");
            asm volatile("s_waitcnt vmcnt(0)" ::: "memory");
            const unsigned og = xb_add(&bar[XB_TOP], 1u);
            const unsigned tg = og / nx;
            if (og + 1u == (tg + 1u) * nx) xb_add(&bar[XB_TOPGEN], 1u);
            else XB_SPIN(xb_ld(&bar[XB_TOPGEN]) == tg, bar);
            __builtin_amdgcn_fence(__ATOMIC_ACQUIRE, "agent");
            xb_add(&bar[XB_XGEN(b.x)], 1u);
            asm volatile("s_waitcnt vmcnt(0)" ::: "memory");
        } else {
            XB_SPIN(xb_ld(&bar[XB_XGEN(b.x)]) == gen, bar);
            __builtin_amdgcn_fence(__ATOMIC_ACQUIRE, "agent");
            asm volatile("s_waitcnt vmcnt(0)" ::: "memory");
        }
    }
    __syncthreads();
}

struct Frame {
    LAS unsigned char* L; unsigned lb; int tid, lane, wave, bid, G; unsigned char* ws;
    DI Frame fresh() const { Frame f = *this; asm volatile("" : "+v"(f.tid), "+s"(f.wave), "+s"(f.bid), "+s"(f.lb), "+s"(f.G)); f.lane = f.tid & 63; f.L = (LAS unsigned char*)(uintptr_t)f.lb; return f; }
    DI float* modp() const { return (float*)(ws + WS_MODP); }
    DI float* mod() const { return (float*)(ws + WS_MOD); }
    DI float* rope() const { return (float*)(ws + WS_ROPE); }
    DI float* tokw() const { return (float*)(ws + WS_TOKW); }
    DI float* slotw() const { return (float*)(ws + WS_SLOTW); }
    DI float* gates() const { return (float*)(ws + WS_GATES); }
    DI float* mlg() const { return (float*)(ws + WS_MLG); }
    DI float* dt() const { return (float*)(ws + WS_DT); }
    DI float* decml() const { return (float*)(ws + WS_DECML); }
    DI float* decss() const { return (float*)(ws + WS_DECSS); }
    DI bf16_t* xbuf() const { return (bf16_t*)(ws + WS_XBUF); }
    DI bf16_t* stml() const { return (bf16_t*)(ws + WS_STML); }
    DI bf16_t* stss() const { return (bf16_t*)(ws + WS_STSS); }
    DI int* toke() const { return (int*)(ws + WS_TOKE); }
    DI int* tokr() const { return (int*)(ws + WS_TOKR); }
    DI int* toks() const { return (int*)(ws + WS_TOKS); }
    DI int* cnt() const { return (int*)(ws + WS_CNT); }
    DI int* mte() const { return (int*)(ws + WS_MTE); }
    DI bf16_t* rwt() const { return (bf16_t*)(ws + WS_RWT); }
    DI bf16_t* win() const { return (bf16_t*)(ws + WS_WIN); }
    DI bf16_t* wout() const { return (bf16_t*)(ws + WS_WOUT); }
    DI bf16_t* w13() const { return (bf16_t*)(ws + WS_W13); }
    DI bf16_t* w2() const { return (bf16_t*)(ws + WS_W2); }
    DI bf16_t* h() const { return (bf16_t*)(ws + WS_H); }
    DI bf16_t* proj() const { return (bf16_t*)(ws + WS_PROJ); }
    DI bf16_t* xbcc() const { return (bf16_t*)(ws + WS_XBCC); }
    DI bf16_t* mix() const { return (bf16_t*)(ws + WS_MIX); }
    DI bf16_t* amoe() const { return (bf16_t*)(ws + WS_AMOE); }
    DI bf16_t* hid() const { return (bf16_t*)(ws + WS_HID); }
    DI bf16_t* ymoe() const { return (bf16_t*)(ws + WS_YMOE); }
};

constexpr int NJ_ADA = 768, NJ_WIN = 2 * 27 * 32, NJ_WOUT = 2 * 8 * 32, NJ_W13 = 64 * 8 * 16, NJ_W2 = 64 * 8 * 8;
constexpr int NJ_TOTAL = NJ_ADA + 1 + NJ_WIN + NJ_WOUT + NJ_W13 + NJ_W2;
DI int win_col(int n) { return n < 5120 ? n : (n < 6656 ? n + 16 : (n < 6672 ? n - 1536 : (n < 6688 ? n : -1))); }

DI void phase_prologue(const Params& p, const Frame& F) {
    LAS float* TL = (LAS float*)F.L;
    for (int job = F.bid; job < (DBG(64) ? 0 : NJ_ADA); job += F.G) {
        __syncthreads();
        {
            const int l = job / 384, kq = (job / 48) & 7, cb = job % 48;
            LAS float* sl = TL; LAS float* sc = TL + 512; LAS float* red = TL + 1024;
            if (F.tid < 256) { const int k = kq * 256 + F.tid; const float a = p.c[k], b = p.c_ctx[k]; sl[F.tid] = siluf(a); sc[F.tid] = siluf(b); }
            __syncthreads();
            const int cg = F.tid & 63, ks = F.tid >> 6;
            f32x4 a0 = {0.f, 0.f, 0.f, 0.f}, a1 = {0.f, 0.f, 0.f, 0.f};
            const float* wp = p.w_mod + ((size_t)l * 2048 + kq * 256 + ks * 32) * 12288 + cb * 256 + cg * 4;
#pragma unroll 16
            for (int k = 0; k < 32; ++k) { const f32x4 w = *(const f32x4*)(wp + (size_t)k * 12288); a0 += sl[ks * 32 + k] * w; a1 += sc[ks * 32 + k] * w; }
            *(LAS f32x4*)(red + (ks * 2 + 0) * 256 + cg * 4) = a0; *(LAS f32x4*)(red + (ks * 2 + 1) * 256 + cg * 4) = a1;
            __syncthreads();
            { const int which = F.tid >> 8, col = F.tid & 255; float s = 0.f;
#pragma unroll
              for (int k8 = 0; k8 < 8; ++k8) s += red[(k8 * 2 + which) * 256 + col];
              F.modp()[((size_t)(l * 8 + kq) * 2 + which) * 12288 + cb * 256 + col] = s; }
        }
    }
    for (int i = F.bid * NTHR + F.tid; i < 320 * 32; i += F.G * NTHR) { const int pos = i >> 5, f = i & 31; const int pp = pos < 256 ? pos : pos - 256;
        const float inv = expf(-logf(10000.0f) * (float)f / 32.0f); float sn, cs; sincosf((float)pp * inv, &sn, &cs);
        F.rope()[(size_t)pos * 64 + f] = cs; F.rope()[(size_t)pos * 64 + 32 + f] = sn; }
    for (int i = F.bid * NTHR + F.tid; i < 2 * 36 * 2048; i += F.G * NTHR) { const int l = i / (36 * 2048), o = (i / 2048) % 36, k = i & 2047;
        F.rwt()[i] = f2bf(o < 4 ? p.rg_w[((size_t)l * 2048 + k) * 4 + o] : p.re_w[((size_t)l * 2048 + k) * 32 + (o - 4)]); }
    __syncthreads();
    const int lane = F.lane, w = F.wave, n4 = lane & 7, kr = lane >> 3;
    LAS unsigned char* WT = F.L + w * 4608;
    const int c4 = w * 32 + n4 * 4;
#pragma unroll 1
    for (int job = F.bid; job < (DBG(128) ? 0 : NJ_WIN + NJ_WOUT); job += F.G) {
        int j = job; int kind, K, ldS; const float* s0; bf16_t* dst; int n0, k0;
        if (j < NJ_WIN) { kind = 0; const int l = j / (27 * 32), r = j % (27 * 32); n0 = (r / 32) * 256; k0 = (r % 32) * 64; K = 2048; ldS = INC; s0 = p.w_in + (size_t)l * 2048 * INC; dst = F.win() + (size_t)l * NPAD * 2048; }
        else { j -= NJ_WIN; kind = 1; const int l = j / 256, r = j % 256; n0 = (r / 32) * 256; k0 = (r % 32) * 64; K = 2048; ldS = 2048; s0 = p.w_out + (size_t)l * 2048 * 2048 + n0; dst = F.wout() + (size_t)l * 2048 * 2048; }
        const float* sp;
        if (kind == 0) { const int sc = win_col(n0 + c4); sp = sc >= 0 ? s0 + (size_t)(k0 + 2 * kr) * ldS + sc : nullptr; }
        else sp = s0 + (size_t)(k0 + 2 * kr) * ldS + c4;
        f32x4 va[4], vb[4];
#pragma unroll
        for (int i = 0; i < 4; ++i) { va[i] = sp ? *(const f32x4*)(sp + (size_t)(16 * i) * ldS) : (f32x4){0.f, 0.f, 0.f, 0.f}; vb[i] = sp ? *(const f32x4*)(sp + (size_t)(16 * i + 1) * ldS) : (f32x4){0.f, 0.f, 0.f, 0.f}; }
#pragma unroll
        for (int i = 0; i < 4; ++i)
#pragma unroll
            for (int c = 0; c < 4; ++c) *(LAS unsigned*)(WT + (n4 * 4 + c) * 144 + (16 * i + 2 * kr) * 2) = pk2(va[i][c], vb[i][c]);
        __builtin_amdgcn_wave_barrier();
#pragma unroll
        for (int i = 0; i < 4; ++i) { const int ci = lane + 64 * i, n = ci >> 3, k8 = ci & 7;
            const u32x4 o = *(LAS u32x4*)(WT + n * 144 + k8 * 16);
            *(u32x4*)(dst + (size_t)(n0 + w * 32 + n) * K + k0 + k8 * 8) = o; }
        __builtin_amdgcn_wave_barrier();
    }
#pragma unroll 1
    for (int job = F.bid; job < NJ_W13 + NJ_W2; job += F.G) {
        int j = job; int K, ldS; const float* sp; unsigned char* dst; int n0, k0; float fs;
        if (j < NJ_W13) { const int le = j / 128, r = j % 128; const int jt = r / 16; n0 = jt * 256; k0 = (r % 16) * 128; K = 2048; ldS = 1024; fs = FS_W13;
            sp = (c4 < 128 ? p.w1 + (size_t)le * 2048 * 1024 + jt * 128 + c4 : p.w3 + (size_t)le * 2048 * 1024 + jt * 128 + (c4 - 128)) + (size_t)(k0 + 4 * kr) * ldS; dst = (unsigned char*)F.w13() + (size_t)le * 2048 * 2048; }
        else { j -= NJ_W13; const int le = j / 64, r = j % 64; n0 = (r / 8) * 256; k0 = (r % 8) * 128; K = 1024; ldS = 2048; fs = FS_W2;
            sp = p.w2 + (size_t)le * 1024 * 2048 + n0 + c4 + (size_t)(k0 + 4 * kr) * ldS; dst = (unsigned char*)F.w2() + (size_t)le * 2048 * 1024; }
        f32x4 v[4][4];
#pragma unroll
        for (int i = 0; i < 4; ++i)
#pragma unroll
            for (int r = 0; r < 4; ++r) v[i][r] = DBG(32) ? (f32x4){1.f, 2.f, 3.f, 4.f} : *(const f32x4*)(sp + (size_t)(32 * i + r) * ldS);
#pragma unroll
        for (int i = 0; i < 4; ++i)
#pragma unroll
            for (int c = 0; c < 4; ++c) *(LAS unsigned*)(WT + (n4 * 4 + c) * 144 + 32 * i + 4 * kr) = pk4_fp8(v[i][0][c] * fs, v[i][1][c] * fs, v[i][2][c] * fs, v[i][3][c] * fs);
        __builtin_amdgcn_wave_barrier();
#pragma unroll
        for (int i = 0; i < 4; ++i) { const int ci = lane + 64 * i, n = ci >> 3, k16 = ci & 7;
            const u32x4 o = *(LAS u32x4*)(WT + n * 144 + k16 * 16);
            if (!DBG(16)) *(u32x4*)(dst + (size_t)(n0 + w * 32 + n) * K + k0 + k16 * 16) = o; }
        __builtin_amdgcn_wave_barrier();
    }
}

DI float mod_from_partials(const Params& p, const Frame& F, int l, int which, int idx) {
    float s = p.b_mod[(size_t)l * 12288 + idx];
#pragma unroll
    for (int kq = 0; kq < 8; ++kq) s += F.modp()[((size_t)(l * 8 + kq) * 2 + which) * 12288 + idx];
    return s;
}

template <int MODE> DI void phase_rows(const Params& p, const Frame& F) {
    constexpr int l = MODE == 0 ? 0 : 1;
    LAS float* nw = (LAS float*)F.L; LAS float* scl = nw + 2048; LAS float* shf = scl + 4096; LAS float* g2v = shf + 4096;
    __syncthreads();
    for (int i = F.tid; i < 2048; i += NTHR) {
        nw[i] = MODE == 2 ? p.final_w[i] : p.norm1_w[l * 2048 + i];
        if (MODE != 2) { for (int w = 0; w < 2; ++w) { scl[w * 2048 + i] = 1.0f + mod_from_partials(p, F, l, w, 2048 + i); shf[w * 2048 + i] = mod_from_partials(p, F, l, w, i); } }
        if (MODE != 0) { for (int w = 0; w < 2; ++w) g2v[w * 2048 + i] = F.mod()[((size_t)(MODE - 1) * 2 + w) * 12288 + 5 * 2048 + i]; }
    }
    if (MODE != 2) {
        for (int i = F.bid * NTHR + F.tid; i < 2 * 12288; i += F.G * NTHR) F.mod()[(size_t)l * 2 * 12288 + i] = mod_from_partials(p, F, l, i / 12288, i % 12288);
    }
    __syncthreads();
    const int nrows = MODE == 2 ? T : NT;
    for (int row = F.bid * 8 + F.wave; row < nrows; row += F.G * 8) {
        const int w = row >= T ? 1 : 0;
        f32x4 v[8];
        if (MODE == 0) { const float* src = w ? p.ctx + (size_t)(row - T) * 2048 : p.x + (size_t)row * 2048;
#pragma unroll
            for (int j = 0; j < 8; ++j) v[j] = *(const f32x4*)(src + j * 256 + F.lane * 4); }
        else {
#pragma unroll
            for (int j = 0; j < 8; ++j) { const u32x2 q = *(const u32x2*)(F.xbuf() + (size_t)row * 2048 + j * 256 + F.lane * 4); v[j] = (f32x4){bflo(q.x), bfhi(q.x), bflo(q.y), bfhi(q.y)}; } }
        if (MODE != 0) {
            const int s0 = F.toks()[row * 2], s1 = F.toks()[row * 2 + 1];
            const unsigned char* y0 = (const unsigned char*)F.ymoe() + (size_t)s0 * 2048; const unsigned char* y1 = (const unsigned char*)F.ymoe() + (size_t)s1 * 2048;
#pragma unroll
            for (int j = 0; j < 8; ++j) { const int c = j * 256 + F.lane * 4; const f32x4 a = unpk4_fp8(*(const unsigned*)(y0 + c)), b = unpk4_fp8(*(const unsigned*)(y1 + c));
                const f32x4 g = *(LAS f32x4*)(g2v + w * 2048 + c) * (1.0f / FS_Y);
                v[j] += g * (a + b); }
            if (MODE == 1) {
#pragma unroll
                for (int j = 0; j < 8; ++j) { u32x2 q; q.x = pk2(v[j][0], v[j][1]); q.y = pk2(v[j][2], v[j][3]); *(u32x2*)(F.xbuf() + (size_t)row * 2048 + j * 256 + F.lane * 4) = q; }
            }
        }
        float ss = 0.f;
#pragma unroll
        for (int j = 0; j < 8; ++j) ss += v[j][0] * v[j][0] + v[j][1] * v[j][1] + v[j][2] * v[j][2] + v[j][3] * v[j][3];
        ss = wsum(ss);
        const float rstd = rsqrtf(ss * (1.0f / 2048.0f) + 1e-6f);
#pragma unroll
        for (int j = 0; j < 8; ++j) { const int c = j * 256 + F.lane * 4; const f32x4 nwv = *(LAS f32x4*)(nw + c);
            f32x4 o = v[j] * rstd * nwv;
            if (MODE == 2) *(f32x4*)(p.out + (size_t)row * 2048 + c) = o;
            else { o = o * *(LAS f32x4*)(scl + w * 2048 + c) + *(LAS f32x4*)(shf + w * 2048 + c);
                u32x2 pk; pk.x = pk2(o[0], o[1]); pk.y = pk2(o[2], o[3]); *(u32x2*)(F.h() + (size_t)row * 2048 + c) = pk; } }
    }
}

DI void phase_prep(const Params& p, const Frame& F, int l) {
    const int lane = F.lane;
#pragma unroll 2
    for (int row = F.bid * 8 + F.wave; row < NT; row += F.G * 8) {
        const bool lat = row < T;
        bf16_t* pr = F.proj() + (size_t)row * NPROJ;
        if (!DBG(8192))
#pragma unroll
        for (int j = 0; j < 2; ++j) {
            const int head = lane >> 4, half = (lane >> 3) & 1, i4 = (lane & 7) * 4;
            bf16_t* base = pr + (j ? MKO : MQO) + head * 128 + half * 64 + i4;
            const u32x2 a = *(const u32x2*)base, b = *(const u32x2*)(base + 32);
            float x1[4] = {bflo(a.x), bfhi(a.x), bflo(a.y), bfhi(a.y)}, x2[4] = {bflo(b.x), bfhi(b.x), bflo(b.y), bfhi(b.y)}, o1[4], o2[4];
            if (lat) { const int pos = half ? 256 + (row & 63) : (row >> 6); const f32x4 cs = *(const f32x4*)(F.rope() + (size_t)pos * 64 + i4), sn = *(const f32x4*)(F.rope() + (size_t)pos * 64 + 32 + i4);
#pragma unroll
                for (int e = 0; e < 4; ++e) { o1[e] = x1[e] * cs[e] - x2[e] * sn[e]; o2[e] = x1[e] * sn[e] + x2[e] * cs[e]; } }
            else {
#pragma unroll
                for (int e = 0; e < 4; ++e) { o1[e] = x1[e]; o2[e] = x2[e]; } }
            if (j) {
#pragma unroll
                for (int e = 0; e < 4; ++e) { o1[e] *= 0.08838834764831845f; o2[e] *= 0.08838834764831845f; } }
            u32x2 wa, wb; wa.x = pk2(o1[0], o1[1]); wa.y = pk2(o1[2], o1[3]); wb.x = pk2(o2[0], o2[1]); wb.y = pk2(o2[2], o2[3]);
            *(u32x2*)base = wa; *(u32x2*)(base + 32) = wb;
        }
        if (lane < 16) { float v = F.gates()[(size_t)row * 32 + lane] + p.ml_gate_b[l * 16 + lane];
            if ((lane >> 2) & 1) v = fminf(v, 0.f) - __logf(1.0f + __expf(-fabsf(v)));
            F.mlg()[(size_t)row * 16 + lane] = v; }
        else if (lane < 32) { const int idx = lane - 16; const float v = F.gates()[(size_t)row * 32 + lane] + p.dt_bias[l * 16 + idx];
            F.dt()[(size_t)row * 16 + idx] = fmaxf(v, 0.f) + __logf(1.0f + __expf(-fabsf(v))); }
    }
    if (!DBG(16384))
    for (int item = F.bid * 8 + F.wave; item < (T / 8) * 2 + CTXL * 2; item += F.G * 8) {
        const bool lat = item < (T / 8) * 2; const int ci = item - (T / 8) * 2;
        const int ch = ((item & 1) * 64 + lane) * 8, nr = lat ? 8 : 1;
        const int t0 = lat ? (item >> 1) * 8 : T + (ci >> 1); const int tl0 = lat ? t0 : t0 - T, nseq = lat ? T : CTXL, rb = lat ? 0 : T;
        float wgt[4][8], bia[8];
        { const f32x4 b0 = *(const f32x4*)(p.conv_b + l * 1024 + ch), b1 = *(const f32x4*)(p.conv_b + l * 1024 + ch + 4);
          bia[0] = b0[0]; bia[1] = b0[1]; bia[2] = b0[2]; bia[3] = b0[3]; bia[4] = b1[0]; bia[5] = b1[1]; bia[6] = b1[2]; bia[7] = b1[3]; }
#pragma unroll
        for (int tap = 0; tap < 4; ++tap) { const f32x4 w0 = *(const f32x4*)(p.conv_w + ((size_t)l * 4 + tap) * 1024 + ch), w1 = *(const f32x4*)(p.conv_w + ((size_t)l * 4 + tap) * 1024 + ch + 4);
            wgt[tap][0] = w0[0]; wgt[tap][1] = w0[1]; wgt[tap][2] = w0[2]; wgt[tap][3] = w0[3]; wgt[tap][4] = w1[0]; wgt[tap][5] = w1[1]; wgt[tap][6] = w1[2]; wgt[tap][7] = w1[3]; }
        u32x4 xr[11];
#pragma unroll
        for (int r = 0; r < 11; ++r) { const int tt = tl0 + r - 2; xr[r] = (tt >= 0 && tt < nseq && r < nr + 3) ? *(const u32x4*)(F.proj() + (size_t)(rb + tt) * NPROJ + XBO + ch) : (u32x4){0u, 0u, 0u, 0u}; }
#pragma unroll
        for (int r = 0; r < 8; ++r) { float acc[8];
#pragma unroll
            for (int e = 0; e < 8; ++e) acc[e] = bia[e];
#pragma unroll
            for (int tap = 0; tap < 4; ++tap) { float xv[8]; unpack8(xr[r + tap], xv);
#pragma unroll
                for (int e = 0; e < 8; ++e) acc[e] += wgt[tap][e] * xv[e]; }
#pragma unroll
            for (int e = 0; e < 8; ++e) acc[e] = siluf(acc[e]);
            if (r < nr) *(u32x4*)(F.xbcc() + (size_t)(t0 + r) * 1024 + ch) = __builtin_bit_cast(u32x4, pack8(acc)); }
    }
}

DI void na_block64(const Params& p, LAS unsigned char* L, unsigned lb, unsigned ktA, unsigned vtA, int kbA, bool actA, const LAS float* rpA,
                   unsigned ktB, unsigned vtB, int kbB, bool actB, const LAS float* rpB, bool masked, int qc, int cs, int lane,
                   const bf16x8 (&qf)[4], f32x4 (&o)[8], float& m_run, float& l_run) {
    constexpr unsigned PB = 272, PVB = 288; const int g = lane >> 4;
    f32x4 s0 = {0.f, 0.f, 0.f, 0.f}, s1 = s0, s2 = s0, s3 = s0;
    if (actA && !DBG(8)) {
#pragma unroll
        for (int ks = 0; ks < 4; ++ks) { s0 = mfma16(frag_row(L, ktA, PB, kbA, ks * 32, lane), qf[ks], s0); s1 = mfma16(frag_row(L, ktA, PB, kbA + 16, ks * 32, lane), qf[ks], s1); } }
    if (actB && !DBG(8)) {
#pragma unroll
        for (int ks = 0; ks < 4; ++ks) { s2 = mfma16(frag_row(L, ktB, PB, kbB, ks * 32, lane), qf[ks], s2); s3 = mfma16(frag_row(L, ktB, PB, kbB + 16, ks * 32, lane), qf[ks], s3); } }
    float sv[16];
#pragma unroll
    for (int e = 0; e < 4; ++e) { sv[e] = s0[e] * 0.08838834764831845f; sv[4 + e] = s1[e] * 0.08838834764831845f; sv[8 + e] = s2[e] * 0.08838834764831845f; sv[12 + e] = s3[e] * 0.08838834764831845f; }
    if (masked) {
#pragma unroll
        for (int e = 0; e < 8; ++e) { const int kc = kbA + (e < 4 ? 4 * g + e : 16 + 4 * g + (e - 4)); const bool valid = (unsigned)(kc - cs) < 16u; const int bi = valid ? kc - qc + 15 : 0;
            const float ba = actA ? rpA[bi] : 0.f, bb = actB ? rpB[bi] : 0.f;
            sv[e] = (valid && actA) ? sv[e] + ba : -INFINITY; sv[8 + e] = (valid && actB) ? sv[8 + e] + bb : -INFINITY; } }
    float mx = sv[0];
#pragma unroll
    for (int e = 1; e < 16; ++e) mx = fmaxf(mx, sv[e]);
    mx = fmaxf(mx, __shfl_xor(mx, 16)); mx = fmaxf(mx, __shfl_xor(mx, 32));
    const float m_new = fmaxf(m_run, mx), alpha = __expf(m_run - m_new);
    float pa[8], pb[8], ps = 0.f;
#pragma unroll
    for (int e = 0; e < 8; ++e) { pa[e] = __expf(sv[e] - m_new); pb[e] = __expf(sv[8 + e] - m_new); ps += pa[e] + pb[e]; }
    l_run = l_run * alpha + ps; m_run = m_new;
    const bf16x8 pfa = pack8(pa), pfb = pack8(pb);
#pragma unroll
    for (int i = 0; i < 8; ++i) o[i] *= alpha;
    if (actA && !DBG(4)) {
#pragma unroll
        for (int hf = 0; hf < 2; ++hf) { bf16x8 vf[4]; frag_tr_x4(vf, lb, vtA, PVB, kbA + 4 * g, kbA + 16 + 4 * g, hf * 64, lane);
#pragma unroll
            for (int i = 0; i < 4; ++i) o[hf * 4 + i] = mfma16(vf[i], pfa, o[hf * 4 + i]); } }
    if (actB && !DBG(4)) {
#pragma unroll
        for (int hf = 0; hf < 2; ++hf) { bf16x8 vf[4]; frag_tr_x4(vf, lb, vtB, PVB, kbB + 4 * g, kbB + 16 + 4 * g, hf * 64, lane);
#pragma unroll
            for (int i = 0; i < 4; ++i) o[hf * 4 + i] = mfma16(vf[i], pfb, o[hf * 4 + i]); } }
}
DI void na_task(const Params& p, const Frame& F, int l, int task) {
    constexpr unsigned BUF = 71680, TIL = 35840, RPB = 143360, PB = 272, PVB = 288;
    LAS unsigned char* L = F.L; const int lane = F.lane, g = lane >> 4, n = lane & 15;
    const bool isctx = task >= 1024;
    const int r0 = isctx ? 0 : (task >> 3) * 2, head = task & 7;
    const int rsel = F.wave >> 2, qt = F.wave & 3, rw = r0 + rsel;
    const int rsA = r0 - 4 < 0 ? 0 : (r0 - 4 > 248 ? 248 : r0 - 4), rsB = r0 - 3 < 0 ? 0 : (r0 - 3 > 248 ? 248 : r0 - 3);
    const int rsw = rsel ? rsB : rsA;
    const int nwin = isctx ? 0 : rsB + 8 - rsA, nwp = (nwin + 1) >> 1;
    const int qrow = isctx ? T + ((task - 1024) >> 3) * 128 + rsel * 64 : rw * 64;
    const bf16_t* proj = F.proj();
    bf16x8 qa[4];
#pragma unroll
    for (int ks = 0; ks < 4; ++ks) qa[ks] = *(const bf16x8*)(proj + (size_t)(qrow + qt * 16 + n) * NPROJ + QO + head * 128 + ks * 32 + g * 8);
    f32x4 oa[8];
#pragma unroll
    for (int i = 0; i < 8; ++i) oa[i] = (f32x4){0.f, 0.f, 0.f, 0.f};
    float ma = -INFINITY, la = 0.f;
    const int cb = qt == 0 ? 0 : (qt == 1 ? 8 : (qt == 2 ? 24 : 32));
    const int qc = qt * 16 + n, cs = qc - 8 < 0 ? 0 : (qc - 8 > 48 ? 48 : qc - 8);
    const int nsteps = nwp + 2;
    u32x4 pre[8];
    const bf16_t* gp = proj + (size_t)(F.tid >> 4) * NPROJ + KO + head * 128 + (F.tid & 15) * 8;
    const unsigned lp = (unsigned)(F.tid >> 4) * PB + (unsigned)(F.tid & 15) * 16u, lpv = 17408u + (unsigned)(F.tid >> 4) * PVB + (unsigned)(F.tid & 15) * 16u;
#define NA_TOK(step, t) ((step) < nwp ? (rsA + ((2 * (step) + (t)) < nwin ? 2 * (step) + (t) : 2 * (step))) * 64 : T + (2 * ((step) - nwp) + (t)) * 64)
#define NA_LOAD(step) do { const bf16_t* g0_ = gp + (size_t)NA_TOK(step, 0) * NPROJ; const bf16_t* g1_ = gp + (size_t)NA_TOK(step, 1) * NPROJ; _Pragma("unroll") for (int i = 0; i < 8; ++i) \
        pre[i] = *(const u32x4*)(((i >> 2) ? g1_ : g0_) + (size_t)((i & 1) * 32) * NPROJ + ((i >> 1) & 1) * 1024); } while (0)
#define NA_STORE(bufo) do { _Pragma("unroll") for (int i = 0; i < 8; ++i) *(LAS u32x4*)(L + (bufo) + (i >> 2) * TIL + (((i >> 1) & 1) ? lpv + (i & 1) * 32 * PVB : lp + (i & 1) * 32 * PB)) = pre[i]; } while (0)
    NA_LOAD(0);
    __syncthreads();
    if (!isctx) { LAS float* rp = (LAS float*)(L + RPB); for (int i = F.tid; i < 465; i += NTHR) rp[i] = p.na_rpb[((size_t)(l * 8 + head)) * 465 + i]; }
#pragma unroll 1
    for (int step = 0; step < nsteps; ++step) {
        const unsigned bufo = (step & 1) * BUF;
        NA_STORE(bufo);
        if (step + 1 < nsteps && !DBG(1)) NA_LOAD(step + 1);
        __syncthreads();
        if (DBG(2)) continue;
        unsigned t0 = bufo, t1 = bufo + TIL;
        asm volatile("" : "+v"(t0), "+v"(t1));
        if (step < nwp) { const int kr0 = rsA + 2 * step, kr1 = kr0 + 1;
            const bool a0 = kr0 >= rsw && kr0 < rsw + 8, a1 = (2 * step + 1 < nwin) && kr1 >= rsw && kr1 < rsw + 8;
            const LAS float* rpw = (const LAS float*)(L + RPB);
            if (a0 || a1) na_block64(p, L, F.lb, t0, t0 + 17408, cb, a0, rpw + (a0 ? kr0 - rw + 7 : 0) * 31, t1, t1 + 17408, cb, a1, rpw + (a1 ? kr1 - rw + 7 : 0) * 31, true, qc, cs, lane, qa, oa, ma, la);
        } else {
#pragma unroll 1
            for (int tt = 0; tt < 2; ++tt) { unsigned tb = tt ? t1 : t0; asm volatile("" : "+v"(tb));
                na_block64(p, L, F.lb, tb, tb + 17408, 0, true, nullptr, tb, tb + 17408, 32, true, nullptr, false, qc, cs, lane, qa, oa, ma, la); }
        }
    }
#undef NA_TOK
#undef NA_LOAD
#undef NA_STORE
    const float inva = 1.0f / gsum4(la);
#pragma unroll
    for (int dvt = 0; dvt < 8; ++dvt) { u32x2 w; w.x = pk2(oa[dvt][0] * inva, oa[dvt][1] * inva); w.y = pk2(oa[dvt][2] * inva, oa[dvt][3] * inva);
        *(u32x2*)(F.mix() + (size_t)(qrow + qt * 16 + n) * 2048 + head * 128 + dvt * 16 + 4 * g) = w; }
}

DI void ml_state_task(const Params& p, const Frame& F, int tc, int h) {
    constexpr unsigned KT = 0, VF = 17408, VB = 34816, WF = 52224, PB = 272;
    LAS unsigned char* L = F.L; const int lane = F.lane, g = lane >> 4, n = lane & 15;
    LAS float* Wt = (LAS float*)(L + WF);
    __syncthreads();
    if (F.wave < 2) { const int d = F.wave, tok = tc * 64 + lane;
        const float ig = F.mlg()[(size_t)tok * 16 + d * 8 + h], lf = F.mlg()[(size_t)tok * 16 + d * 8 + 4 + h];
        const float b = wscan(lf, d, lane); const float G = __shfl(b, d ? 0 : 63);
        Wt[d * 64 + lane] = __expf(G - b + ig);
        if (lane == 0) F.decml()[(d * 4 + h) * NCH + tc] = __expf(G); }
    __syncthreads();
#pragma unroll
    for (int i = 0; i < 2; ++i) { const int ci = F.tid + NTHR * i, row = ci >> 4, c16 = ci & 15; const size_t tok = (size_t)tc * 64 + row;
        const u32x4 kv = *(const u32x4*)(F.proj() + tok * NPROJ + MKO + h * 128 + c16 * 8);
        *(LAS u32x4*)(L + KT + row * PB + c16 * 16) = kv;
        float v[8], a[8], b[8]; unpack8(*(const u32x4*)(F.proj() + tok * NPROJ + MVO + h * 128 + c16 * 8), v);
        const float wf = Wt[row], wb = Wt[64 + row];
#pragma unroll
        for (int e = 0; e < 8; ++e) { a[e] = v[e] * wf; b[e] = v[e] * wb; }
        *(LAS bf16x8*)(L + VF + row * PB + c16 * 16) = pack8(a); *(LAS bf16x8*)(L + VB + row * PB + c16 * 16) = pack8(b); }
    __syncthreads();
    const int w = F.wave;
    const bf16x8 k0 = frag_tr(F.lb, KT, PB, 8 * g, 8 * g + 4, 16 * w, lane), k1 = frag_tr(F.lb, KT, PB, 32 + 8 * g, 32 + 8 * g + 4, 16 * w, lane);
#pragma unroll
    for (int d = 0; d < 2; ++d) { const unsigned vt = d ? VB : VF;
        bf16_t* dst = F.stml() + ((size_t)(d * 4 + h) * NCH + tc) * 16512;
#pragma unroll 1
        for (int jh = 0; jh < 2; ++jh) { bf16x8 y0[4], y1[4];
            frag_tr_x4(y0, F.lb, vt, PB, 8 * g, 8 * g + 4, 64 * jh, lane); frag_tr_x4(y1, F.lb, vt, PB, 32 + 8 * g, 32 + 8 * g + 4, 64 * jh, lane);
#pragma unroll
            for (int q = 0; q < 4; ++q) { f32x4 acc = {0.f, 0.f, 0.f, 0.f}; acc = mfma16(k0, y0[q], acc); acc = mfma16(k1, y1[q], acc);
                u32x2 pk; pk.x = pk2(acc[0], acc[1]); pk.y = pk2(acc[2], acc[3]);
                *(u32x2*)(dst + (size_t)(64 * jh + 16 * q + n) * 128 + 16 * w + 4 * g) = pk; } } }
    if (F.tid < 256) { const int d = F.tid >> 7, dk = F.tid & 127; float sacc = 0.f;
        for (int t = 0; t < 64; ++t) sacc += Wt[d * 64 + t] * bf2f(*(LAS bf16_t*)(L + KT + t * PB + dk * 2));
        F.stml()[((size_t)(d * 4 + h) * NCH + tc) * 16512 + 16384 + dk] = f2bf(sacc); }
}

DI void ml_out_task(const Params& p, const Frame& F, int l, int tc, int h) {
    constexpr unsigned QT = 0, KT = 17408, VT = 34816, CF = 54272, CB = 93440, GA = 132608, PB = 272, PV = 304;
    LAS unsigned char* L = F.L; const int lane = F.lane, g = lane >> 4, n = lane & 15;
    LAS float* Bg = (LAS float*)(L + GA);
    LAS float* Ig = Bg + 128;
    __syncthreads();
    if (F.wave < 2) { const int d = F.wave, tok = tc * 64 + lane;
        const float ig = F.mlg()[(size_t)tok * 16 + d * 8 + h], lf = F.mlg()[(size_t)tok * 16 + d * 8 + 4 + h];
        Bg[d * 64 + lane] = wscan(lf, d, lane); Ig[d * 64 + lane] = ig; }
    if (!DBG(256)) {
#pragma unroll
    for (int i = 0; i < 2; ++i) { const int ci = F.tid + NTHR * i, row = ci >> 4, c16 = ci & 15; const size_t tok = (size_t)tc * 64 + row;
        *(LAS u32x4*)(L + QT + row * PB + c16 * 16) = *(const u32x4*)(F.proj() + tok * NPROJ + MQO + h * 128 + c16 * 8);
        *(LAS u32x4*)(L + KT + row * PB + c16 * 16) = *(const u32x4*)(F.proj() + tok * NPROJ + MKO + h * 128 + c16 * 8);
        *(LAS u32x4*)(L + VT + row * PV + c16 * 16) = *(const u32x4*)(F.proj() + tok * NPROJ + MVO + h * 128 + c16 * 8); }
    if (F.tid < 128) { const int row = F.tid >> 1, hf = F.tid & 1; u32x4 v = {0u, 0u, 0u, 0u}; if (!hf) v.x = 0x3f80u; *(LAS u32x4*)(L + VT + row * PV + 256 + hf * 16) = v; }
#pragma unroll
    for (int d = 0; d < 2; ++d) { const bf16_t* src = F.stml() + ((size_t)(d * 4 + h) * NCH + tc) * 16512; const unsigned ct = d ? CB : CF;
        { u32x4 cv[5];
#pragma unroll
          for (int i = 0; i < 4; ++i) cv[i] = *(const u32x4*)(src + (size_t)(F.tid + NTHR * i) * 8);
          cv[4] = F.tid < 16 ? *(const u32x4*)(src + (size_t)(2048 + F.tid) * 8) : (u32x4){0u, 0u, 0u, 0u};
#pragma unroll
          for (int i = 0; i < 4; ++i) { const int ci = F.tid + NTHR * i; *(LAS u32x4*)(L + ct + (ci >> 4) * PB + (ci & 15) * 16) = cv[i]; }
          if (F.tid < 16) *(LAS u32x4*)(L + ct + 128 * PB + F.tid * 16) = cv[4]; }
        for (int i = F.tid; i < 15 * 17; i += NTHR) { const int row = 129 + i / 17, c = i % 17; *(LAS u32x4*)(L + ct + row * PB + c * 16) = (u32x4){0u, 0u, 0u, 0u}; } }
    }
    __syncthreads();
    if (DBG(512)) return;
    const int d = F.wave >> 2, qt = F.wave & 3;
    bf16x8 qf[4];
#pragma unroll
    for (int ks = 0; ks < 4; ++ks) qf[ks] = frag_row(L, QT, PB, 16 * qt, 32 * ks, lane);
    const int t = 16 * qt + n; const float bt = Bg[d * 64 + t];
    float wv[4][4];
    { f32x4 sa[4];
#pragma unroll
      for (int st = 0; st < 4; ++st) sa[st] = (f32x4){0.f, 0.f, 0.f, 0.f};
#pragma unroll
      for (int ks = 0; ks < 4; ++ks)
#pragma unroll
        for (int st = 0; st < 4; ++st) sa[st] = mfma16(frag_row(L, KT, PB, 16 * st, 32 * ks, lane), qf[ks], sa[st]);
#pragma unroll
      for (int st = 0; st < 4; ++st) { const f32x4 bs = *(LAS f32x4*)(Bg + d * 64 + 16 * st + 4 * g), is = *(LAS f32x4*)(Ig + d * 64 + 16 * st + 4 * g);
#pragma unroll
        for (int e = 0; e < 4; ++e) { const int s = 16 * st + 4 * g + e; const bool valid = d ? (s >= t) : (s <= t);
            wv[st][e] = valid ? sa[st][e] * __expf(bt - bs[e] + is[e]) : 0.f; } } }
    f32x4 num[9];
#pragma unroll
    for (int it = 0; it < 9; ++it) num[it] = (f32x4){0.f, 0.f, 0.f, 0.f};
#pragma unroll
    for (int kk = 0; kk < 2; ++kk) {
        const bool need = d ? (2 * kk + 1 >= qt) : (2 * kk <= qt);
        if (need) { float pv[8];
#pragma unroll
            for (int e = 0; e < 4; ++e) { pv[e] = wv[2 * kk][e]; pv[4 + e] = wv[2 * kk + 1][e]; }
            const bf16x8 pf = pack8(pv);
#pragma unroll
            for (int hf = 0; hf < 2; ++hf) { bf16x8 vf[4]; frag_tr_x4(vf, F.lb, VT, PV, 32 * kk + 4 * g, 32 * kk + 16 + 4 * g, 64 * hf, lane);
#pragma unroll
                for (int q = 0; q < 4; ++q) num[hf * 4 + q] = mfma16(vf[q], pf, num[hf * 4 + q]); }
            num[8] = mfma16(frag_tr(F.lb, VT, PV, 32 * kk + 4 * g, 32 * kk + 16 + 4 * g, 128, lane), pf, num[8]); }
    }
    const unsigned ct = d ? CB : CF; const float eb = __expf(bt);
    { f32x4 ia[9];
#pragma unroll
      for (int it = 0; it < 9; ++it) ia[it] = (f32x4){0.f, 0.f, 0.f, 0.f};
#pragma unroll
      for (int ks = 0; ks < 4; ++ks)
#pragma unroll
        for (int it = 0; it < 9; ++it) ia[it] = mfma16(frag_row(L, ct, PB, 16 * it, 32 * ks, lane), qf[ks], ia[it]);
#pragma unroll
      for (int it = 0; it < 9; ++it) num[it] += eb * ia[it]; }
    const float den = __shfl(num[8][0], n);
    const float dn = 1.0f / fmaxf(fabsf(den), 1.0f);
#pragma unroll
    for (int it = 0; it < 8; ++it) num[it] *= dn;
    __syncthreads();
    LAS float* HX = (LAS float*)(L + CF);
    if (d == 1) {
#pragma unroll
        for (int it = 0; it < 8; ++it) *(LAS f32x4*)(HX + t * 132 + 16 * it + 4 * g) = num[it]; }
    __syncthreads();
    if (d == 0 && (l == 0 || tc < 256)) {
        float sm = 0.f;
#pragma unroll
        for (int it = 0; it < 8; ++it) { num[it] += *(LAS f32x4*)(HX + t * 132 + 16 * it + 4 * g); sm += num[it][0] + num[it][1] + num[it][2] + num[it][3]; }
        const float mean = gsum4(sm) * (1.0f / 128.0f); float vs = 0.f;
#pragma unroll
        for (int it = 0; it < 8; ++it) { num[it] -= mean; vs += num[it][0] * num[it][0] + num[it][1] * num[it][1] + num[it][2] * num[it][2] + num[it][3] * num[it][3]; }
        const float rstd = rsqrtf(gsum4(vs) * (1.0f / 128.0f) + 1e-6f);
        const size_t tok = (size_t)tc * 64 + t;
#pragma unroll
        for (int it = 0; it < 8; ++it) { const int c = h * 128 + 16 * it + 4 * g;
            const u32x2 mo = *(const u32x2*)(F.proj() + tok * NPROJ + MOO + c); const f32x4 nwv = *(const f32x4*)(p.ml_norm_w + l * 512 + c);
            const float o0 = num[it][0] * rstd * nwv[0] * sigmf(bflo(mo.x)), o1 = num[it][1] * rstd * nwv[1] * sigmf(bfhi(mo.x));
            const float o2 = num[it][2] * rstd * nwv[2] * sigmf(bflo(mo.y)), o3 = num[it][3] * rstd * nwv[3] * sigmf(bfhi(mo.y));
            u32x2 w; w.x = pk2(o0, o1); w.y = pk2(o2, o3); *(u32x2*)(F.mix() + tok * 2048 + 1024 + c) = w; }
    }
}

constexpr int NC2 = 130;
DI void wscan128(float& lo, float& hi, int rev, int lane) {
    lo = wscan(lo, rev, lane); hi = wscan(hi, rev, lane);
    if (!rev) hi += __shfl(lo, 63); else lo += __shfl(hi, 0);
}
DI void ml_state128_task(const Params& p, const Frame& F, int tc2, int h, int dsel) {
    constexpr unsigned KT = 0, VF = 34816, VB = 69632, WF = 104448, PB = 272;
    LAS unsigned char* L = F.L; const int lane = F.lane, g = lane >> 4, n = lane & 15;
    LAS float* Wt = (LAS float*)(L + WF);
    __syncthreads();
    if (F.wave < 2) { const int d = F.wave; const size_t t0 = (size_t)tc2 * 128 + lane, t1 = t0 + 64;
        const float ig0 = F.mlg()[t0 * 16 + d * 8 + h], ig1 = F.mlg()[t1 * 16 + d * 8 + h];
        float b0 = F.mlg()[t0 * 16 + d * 8 + 4 + h], b1 = F.mlg()[t1 * 16 + d * 8 + 4 + h];
        wscan128(b0, b1, d, lane); const float G = d ? __shfl(b0, 0) : __shfl(b1, 63);
        Wt[d * 128 + lane] = __expf(G - b0 + ig0); Wt[d * 128 + 64 + lane] = __expf(G - b1 + ig1);
        if (lane == 0) F.decml()[(d * 4 + h) * NC2 + tc2] = __expf(G); }
    __syncthreads();
#pragma unroll
    for (int i = 0; i < 4; ++i) { const int ci = F.tid + NTHR * i, row = ci >> 4, c16 = ci & 15; const size_t tok = (size_t)tc2 * 128 + row;
        const u32x4 kv = *(const u32x4*)(F.proj() + tok * NPROJ + MKO + h * 128 + c16 * 8);
        *(LAS u32x4*)(L + KT + row * PB + c16 * 16) = kv;
        float v[8], a[8], b[8]; unpack8(*(const u32x4*)(F.proj() + tok * NPROJ + MVO + h * 128 + c16 * 8), v);
        const float wf = Wt[row], wb = Wt[128 + row];
#pragma unroll
        for (int e = 0; e < 8; ++e) { a[e] = v[e] * wf; b[e] = v[e] * wb; }
        *(LAS bf16x8*)(L + VF + row * PB + c16 * 16) = pack8(a); *(LAS bf16x8*)(L + VB + row * PB + c16 * 16) = pack8(b); }
    __syncthreads();
    const int w = F.wave;
    bf16x8 kf[4];
#pragma unroll
    for (int ks = 0; ks < 4; ++ks) kf[ks] = frag_tr(F.lb, KT, PB, 32 * ks + 8 * g, 32 * ks + 8 * g + 4, 16 * w, lane);
#pragma unroll
    for (int d = 0; d < 2; ++d) { const unsigned vt = d ? VB : VF; if (dsel >= 0 && dsel != d) continue;
        bf16_t* dst = F.stml() + ((size_t)(d * 4 + h) * NC2 + tc2) * 16512;
#pragma unroll 1
        for (int jh = 0; jh < 2; ++jh) { f32x4 acc[4];
#pragma unroll
            for (int q = 0; q < 4; ++q) acc[q] = (f32x4){0.f, 0.f, 0.f, 0.f};
#pragma unroll
            for (int ks = 0; ks < 4; ++ks) { bf16x8 y[4]; frag_tr_x4(y, F.lb, vt, PB, 32 * ks + 8 * g, 32 * ks + 8 * g + 4, 64 * jh, lane);
#pragma unroll
                for (int q = 0; q < 4; ++q) acc[q] = mfma16(kf[ks], y[q], acc[q]); }
#pragma unroll
            for (int q = 0; q < 4; ++q) { u32x2 pk; pk.x = pk2(acc[q][0], acc[q][1]); pk.y = pk2(acc[q][2], acc[q][3]);
                *(u32x2*)(dst + (size_t)(64 * jh + 16 * q + n) * 128 + 16 * w + 4 * g) = pk; } } }
    if (F.tid < 256 && (dsel < 0 || dsel == (F.tid >> 7))) { const int d = F.tid >> 7, dk = F.tid & 127; float sacc = 0.f;
        for (int t = 0; t < 128; ++t) sacc += Wt[d * 128 + t] * bf2f(*(LAS bf16_t*)(L + KT + t * PB + dk * 2));
        F.stml()[((size_t)(d * 4 + h) * NC2 + tc2) * 16512 + 16384 + dk] = f2bf(sacc); }
}
DI void ml_stage_c(const Frame& F, LAS unsigned char* L, unsigned ct, const bf16_t* src) {
    constexpr unsigned PB = 272; u32x4 cv[5];
#pragma unroll
    for (int i = 0; i < 4; ++i) cv[i] = *(const u32x4*)(src + (size_t)(F.tid + NTHR * i) * 8);
    cv[4] = F.tid < 16 ? *(const u32x4*)(src + (size_t)(2048 + F.tid) * 8) : (u32x4){0u, 0u, 0u, 0u};
#pragma unroll
    for (int i = 0; i < 4; ++i) { const int ci = F.tid + NTHR * i; *(LAS u32x4*)(L + ct + (ci >> 4) * PB + (ci & 15) * 16) = cv[i]; }
    if (F.tid < 16) *(LAS u32x4*)(L + ct + 128 * PB + F.tid * 16) = cv[4];
    for (int i = F.tid; i < 15 * 17; i += NTHR) { const int row = 129 + i / 17, c = i % 17; *(LAS u32x4*)(L + ct + row * PB + c * 16) = (u32x4){0u, 0u, 0u, 0u}; }
}
DI void ml_out128_task(const Params& p, const Frame& F0, int l, int tc2, int h) {
    constexpr unsigned QT = 0, KT = 34816, VT = 69632, CT = 108544, GA = 147712, PB = 272, PV = 304;
    Frame F = F0; asm volatile("" : "+v"(F.tid)); F.lane = F.tid & 63;
    LAS unsigned char* L = F.L; const int lane = F.lane, g = lane >> 4, n = lane & 15, w = F.wave;
    LAS float* Bg = (LAS float*)(L + GA);
    LAS float* Ig = Bg + 256;
    __syncthreads();
    if (F.wave < 2) { const int d = F.wave; const size_t t0 = (size_t)tc2 * 128 + lane, t1 = t0 + 64;
        const float ig0 = F.mlg()[t0 * 16 + d * 8 + h], ig1 = F.mlg()[t1 * 16 + d * 8 + h];
        float b0 = F.mlg()[t0 * 16 + d * 8 + 4 + h], b1 = F.mlg()[t1 * 16 + d * 8 + 4 + h];
        wscan128(b0, b1, d, lane);
        Bg[d * 128 + lane] = b0; Bg[d * 128 + 64 + lane] = b1; Ig[d * 128 + lane] = ig0; Ig[d * 128 + 64 + lane] = ig1; }
#pragma unroll 2
    for (int i = 0; i < 4; ++i) { const int ci = F.tid + NTHR * i, row = ci >> 4, c16 = ci & 15; const size_t tok = (size_t)tc2 * 128 + row;
        *(LAS u32x4*)(L + QT + row * PB + c16 * 16) = *(const u32x4*)(F.proj() + tok * NPROJ + MQO + h * 128 + c16 * 8);
        *(LAS u32x4*)(L + KT + row * PB + c16 * 16) = *(const u32x4*)(F.proj() + tok * NPROJ + MKO + h * 128 + c16 * 8);
        *(LAS u32x4*)(L + VT + row * PV + c16 * 16) = *(const u32x4*)(F.proj() + tok * NPROJ + MVO + h * 128 + c16 * 8); }
    if (F.tid < 256) { const int row = F.tid >> 1, hf = F.tid & 1; u32x4 v = {0u, 0u, 0u, 0u}; if (!hf) v.x = 0x3f80u; *(LAS u32x4*)(L + VT + row * PV + 256 + hf * 16) = v; }
    ml_stage_c(F, L, CT, F.stml() + ((size_t)(0 * 4 + h) * NC2 + tc2) * 16512);
    __syncthreads();
    bf16x8 qf[4];
#pragma unroll
    for (int ks = 0; ks < 4; ++ks) qf[ks] = frag_row(L, QT, PB, 16 * w, 32 * ks, lane);
    const int t = 16 * w + n;
    f32x4 hsum[8];
#pragma unroll
    for (int it = 0; it < 8; ++it) hsum[it] = (f32x4){0.f, 0.f, 0.f, 0.f};
#pragma unroll 1
    for (int d = 0; d < 2; ++d) {
        if (d == 1) { __syncthreads(); ml_stage_c(F, L, CT, F.stml() + ((size_t)(1 * 4 + h) * NC2 + tc2) * 16512); __syncthreads(); }
        const float bt = Bg[d * 128 + t];
        unsigned kt_ = KT, ct_ = CT, vt_ = VT; asm volatile("" : "+v"(kt_), "+v"(ct_), "+v"(vt_));
        bf16x8 pf[4];
#pragma unroll
        for (int hk = 0; hk < 2; ++hk) {
            f32x4 sa[4];
#pragma unroll
            for (int q = 0; q < 4; ++q) sa[q] = (f32x4){0.f, 0.f, 0.f, 0.f};
#pragma unroll
            for (int ks = 0; ks < 4; ++ks)
#pragma unroll
                for (int q = 0; q < 4; ++q) { const int st = 4 * hk + q; if (d ? (st >= w) : (st <= w)) sa[q] = mfma16(frag_row(L, kt_, PB, 16 * st, 32 * ks, lane), qf[ks], sa[q]); }
#pragma unroll
            for (int k2 = 0; k2 < 2; ++k2) { float pv[8];
#pragma unroll
                for (int hh = 0; hh < 2; ++hh) { const int st = 4 * hk + 2 * k2 + hh; const f32x4 bs = *(LAS f32x4*)(Bg + d * 128 + 16 * st + 4 * g), is = *(LAS f32x4*)(Ig + d * 128 + 16 * st + 4 * g);
#pragma unroll
                    for (int e = 0; e < 4; ++e) { const int s = 16 * st + 4 * g + e; const bool valid = d ? (s >= t) : (s <= t);
                        pv[hh * 4 + e] = valid ? sa[2 * k2 + hh][e] * __expf(bt - bs[e] + is[e]) : 0.f; } }
                pf[2 * hk + k2] = pack8(pv); } }
        const float eb = __expf(bt);
#define ML_QS(ks) ({ float qv_[8]; unpack8(__builtin_bit_cast(u32x4, qf[ks]), qv_); _Pragma("unroll") for (int e_ = 0; e_ < 8; ++e_) qv_[e_] *= eb; pack8(qv_); })
        float dn;
        { f32x4 na[5];
#pragma unroll
          for (int it = 0; it < 5; ++it) na[it] = (f32x4){0.f, 0.f, 0.f, 0.f};
#pragma unroll
          for (int kk = 0; kk < 4; ++kk) {
            if (d ? (2 * kk + 1 >= w) : (2 * kk <= w)) { bf16x8 vf[4]; frag_tr_x4(vf, F.lb, vt_, PV, 32 * kk + 4 * g, 32 * kk + 16 + 4 * g, 0, lane);
#pragma unroll
                for (int q = 0; q < 4; ++q) na[q] = mfma16(vf[q], pf[kk], na[q]);
                na[4] = mfma16(frag_tr(F.lb, vt_, PV, 32 * kk + 4 * g, 32 * kk + 16 + 4 * g, 128, lane), pf[kk], na[4]); } }
#pragma unroll
          for (int ks = 0; ks < 4; ++ks) { const bf16x8 qsk = ML_QS(ks);
#pragma unroll
            for (int q = 0; q < 4; ++q) na[q] = mfma16(frag_row(L, ct_, PB, 16 * q, 32 * ks, lane), qsk, na[q]);
            na[4] = mfma16(frag_row(L, ct_, PB, 128, 32 * ks, lane), qsk, na[4]); }
          const float den = __shfl(na[4][0], n);
          dn = 1.0f / fmaxf(fabsf(den), 1.0f);
#pragma unroll
          for (int q = 0; q < 4; ++q) hsum[q] += na[q] * dn; }
        { f32x4 nb[4];
#pragma unroll
          for (int q = 0; q < 4; ++q) nb[q] = (f32x4){0.f, 0.f, 0.f, 0.f};
#pragma unroll
          for (int kk = 0; kk < 4; ++kk) {
            if (d ? (2 * kk + 1 >= w) : (2 * kk <= w)) { bf16x8 vf[4]; frag_tr_x4(vf, F.lb, vt_, PV, 32 * kk + 4 * g, 32 * kk + 16 + 4 * g, 64, lane);
#pragma unroll
                for (int q = 0; q < 4; ++q) nb[q] = mfma16(vf[q], pf[kk], nb[q]); } }
#pragma unroll
          for (int ks = 0; ks < 4; ++ks) { const bf16x8 qsk = ML_QS(ks);
#pragma unroll
            for (int q = 0; q < 4; ++q) nb[q] = mfma16(frag_row(L, ct_, PB, 64 + 16 * q, 32 * ks, lane), qsk, nb[q]); }
#pragma unroll
          for (int q = 0; q < 4; ++q) hsum[4 + q] += nb[q] * dn; }
#undef ML_QS
    }
    if (l == 0 || tc2 < 128) {
        float sm = 0.f;
#pragma unroll
        for (int it = 0; it < 8; ++it) sm += hsum[it][0] + hsum[it][1] + hsum[it][2] + hsum[it][3];
        const float mean = gsum4(sm) * (1.0f / 128.0f); float vs = 0.f;
#pragma unroll
        for (int it = 0; it < 8; ++it) { hsum[it] -= mean; vs += hsum[it][0] * hsum[it][0] + hsum[it][1] * hsum[it][1] + hsum[it][2] * hsum[it][2] + hsum[it][3] * hsum[it][3]; }
        const float rstd = rsqrtf(gsum4(vs) * (1.0f / 128.0f) + 1e-6f);
        const size_t tok = (size_t)tc2 * 128 + t;
#pragma unroll
        for (int it = 0; it < 8; ++it) { const int c = h * 128 + 16 * it + 4 * g;
            const u32x2 mo = *(const u32x2*)(F.proj() + tok * NPROJ + MOO + c); const f32x4 nwv = *(const f32x4*)(p.ml_norm_w + l * 512 + c);
            const float o0 = hsum[it][0] * rstd * nwv[0] * sigmf(bflo(mo.x)), o1 = hsum[it][1] * rstd * nwv[1] * sigmf(bfhi(mo.x));
            const float o2 = hsum[it][2] * rstd * nwv[2] * sigmf(bflo(mo.y)), o3 = hsum[it][3] * rstd * nwv[3] * sigmf(bfhi(mo.y));
            u32x2 wq; wq.x = pk2(o0, o1); wq.y = pk2(o2, o3); *(u32x2*)(F.mix() + tok * 2048 + 1024 + c) = wq; }
    }
}

DI void ss_state_task(const Params& p, const Frame& F, int l, int tc, int gi) {
    constexpr unsigned BT = 0, XS = 17408, WA = 91136, PB = 272, PX = 144;
    LAS unsigned char* L = F.L; const int lane = F.lane, g = lane >> 4, n = lane & 15, w = F.wave;
    LAS float* Wt = (LAS float*)(L + WA);
    const int hl = w & 3, d = w >> 2, hh = gi * 4 + hl;
    __syncthreads();
    { const int tok = tc * 64 + lane; const float dt = F.dt()[(size_t)tok * 16 + d * 8 + hh], a = -__expf(p.a_log[(l * 2 + d) * 8 + hh]);
      const float la = wscan(dt * a, d, lane); const float G = __shfl(la, d ? 0 : 63);
      Wt[w * 64 + lane] = __expf(G - la) * dt;
      if (lane == 0) F.decss()[(d * 8 + hh) * NCH + tc] = __expf(G); }
    __syncthreads();
#pragma unroll
    for (int i = 0; i < 2; ++i) { const int ci = F.tid + NTHR * i, row = ci >> 4, c16 = ci & 15;
        *(LAS u32x4*)(L + BT + row * PB + c16 * 16) = *(const u32x4*)(F.xbcc() + ((size_t)tc * 64 + row) * 1024 + 512 + gi * 128 + c16 * 8); }
#pragma unroll
    for (int i = 0; i < 8; ++i) { const int ci = F.tid + NTHR * i, ww = ci >> 9, row = (ci >> 3) & 63, c8 = ci & 7; float v[8];
        unpack8(*(const u32x4*)(F.xbcc() + ((size_t)tc * 64 + row) * 1024 + (gi * 4 + (ww & 3)) * 64 + c8 * 8), v);
        const float ws = Wt[ww * 64 + row];
#pragma unroll
        for (int e = 0; e < 8; ++e) v[e] *= ws;
        *(LAS bf16x8*)(L + XS + ww * 9216 + row * PX + c8 * 16) = pack8(v); }
    __syncthreads();
    bf16_t* dst = F.stss() + ((size_t)(d * 8 + hh) * NCH + tc) * 8192;
    const unsigned xt = XS + w * 9216;
    bf16x8 x0[4], x1[4];
    frag_tr_x4(x0, F.lb, xt, PX, 8 * g, 8 * g + 4, 0, lane); frag_tr_x4(x1, F.lb, xt, PX, 32 + 8 * g, 32 + 8 * g + 4, 0, lane);
#pragma unroll 1
    for (int ih = 0; ih < 2; ++ih) { bf16x8 b0[4], b1[4];
        frag_tr_x4(b0, F.lb, BT, PB, 8 * g, 8 * g + 4, 64 * ih, lane); frag_tr_x4(b1, F.lb, BT, PB, 32 + 8 * g, 32 + 8 * g + 4, 64 * ih, lane);
#pragma unroll
        for (int q = 0; q < 4; ++q)
#pragma unroll
            for (int jt = 0; jt < 4; ++jt) { f32x4 acc = {0.f, 0.f, 0.f, 0.f}; acc = mfma16(b0[q], x0[jt], acc); acc = mfma16(b1[q], x1[jt], acc);
                u32x2 pk; pk.x = pk2(acc[0], acc[1]); pk.y = pk2(acc[2], acc[3]);
                *(u32x2*)(dst + (size_t)(16 * jt + n) * 128 + 64 * ih + 16 * q + 4 * g) = pk; } }
}

DI void ss_out_task(const Params& p, const Frame& F, int l, int tc, int gi) {
    constexpr unsigned CT = 0, BT = 17408, XT = 34816, SS = 68608, LA = 138240, DS = 140288, SQ = 142336, PB = 272, PX = 528;
    LAS unsigned char* L = F.L; const int lane = F.lane, g = lane >> 4, n = lane & 15, w = F.wave;
    LAS float* La = (LAS float*)(L + LA); LAS float* Dt = (LAS float*)(L + DS); LAS float* Sq = (LAS float*)(L + SQ);
    __syncthreads();
    { const int hl = w & 3, d = w >> 2, hh = gi * 4 + hl; const int tok = tc * 64 + lane;
      const float dt = F.dt()[(size_t)tok * 16 + d * 8 + hh], a = -__expf(p.a_log[(l * 2 + d) * 8 + hh]);
      La[w * 64 + lane] = wscan(dt * a, d, lane); Dt[w * 64 + lane] = dt; }
#pragma unroll
    for (int i = 0; i < 2; ++i) { const int ci = F.tid + NTHR * i, row = ci >> 4, c16 = ci & 15; const size_t tok = (size_t)tc * 64 + row;
        *(LAS u32x4*)(L + CT + row * PB + c16 * 16) = *(const u32x4*)(F.xbcc() + tok * 1024 + 768 + gi * 128 + c16 * 8);
        *(LAS u32x4*)(L + BT + row * PB + c16 * 16) = *(const u32x4*)(F.xbcc() + tok * 1024 + 512 + gi * 128 + c16 * 8); }
#pragma unroll
    for (int i = 0; i < 4; ++i) { const int ci = F.tid + NTHR * i, row = ci >> 5, c32 = ci & 31;
        *(LAS u32x4*)(L + XT + row * PX + c32 * 16) = *(const u32x4*)(F.xbcc() + ((size_t)tc * 64 + row) * 1024 + gi * 256 + c32 * 8); }
    __syncthreads();
    const int qt = w & 3, hp2 = w >> 2, t = 16 * qt + n;
    bf16x8 cf[4];
#pragma unroll
    for (int ks = 0; ks < 4; ++ks) cf[ks] = frag_row(L, CT, PB, 16 * qt, 32 * ks, lane);
    f32x4 ga[4];
#pragma unroll
    for (int st = 0; st < 4; ++st) ga[st] = (f32x4){0.f, 0.f, 0.f, 0.f};
#pragma unroll
    for (int ks = 0; ks < 4; ++ks)
#pragma unroll
        for (int st = 0; st < 4; ++st) ga[st] = mfma16(frag_row(L, BT, PB, 16 * st, 32 * ks, lane), cf[ks], ga[st]);
    f32x4 y[2][4];
#pragma unroll
    for (int a = 0; a < 2; ++a)
#pragma unroll
        for (int it = 0; it < 4; ++it) y[a][it] = (f32x4){0.f, 0.f, 0.f, 0.f};
#pragma unroll 1
    for (int d = 0; d < 2; ++d) {
        __syncthreads();
        { u32x4 sv[8];
#pragma unroll
          for (int i = 0; i < 8; ++i) { const int ci = F.tid + NTHR * i, hl = ci >> 10, r = ci & 1023; sv[i] = *(const u32x4*)(F.stss() + ((size_t)(d * 8 + gi * 4 + hl) * NCH + tc) * 8192 + (size_t)r * 8); }
#pragma unroll
          for (int i = 0; i < 8; ++i) { const int ci = F.tid + NTHR * i, hl = ci >> 10, r = ci & 1023; *(LAS u32x4*)(L + SS + hl * 17408 + (r >> 4) * PB + (r & 15) * 16) = sv[i]; } }
        __syncthreads();
#pragma unroll
        for (int a = 0; a < 2; ++a) { const int hl = 2 * hp2 + a, wi = d * 4 + hl; const float lat = La[wi * 64 + t];
            float wv[4][4];
#pragma unroll
            for (int st = 0; st < 4; ++st) { const f32x4 ls = *(LAS f32x4*)(La + wi * 64 + 16 * st + 4 * g), ds = *(LAS f32x4*)(Dt + wi * 64 + 16 * st + 4 * g);
#pragma unroll
                for (int e = 0; e < 4; ++e) { const int s = 16 * st + 4 * g + e; const bool valid = d ? (s >= t) : (s <= t);
                    wv[st][e] = valid ? ga[st][e] * __expf(lat - ls[e]) * ds[e] : 0.f; } }
            const float el = __expf(lat);
            { f32x4 ia[4];
#pragma unroll
              for (int it = 0; it < 4; ++it) ia[it] = (f32x4){0.f, 0.f, 0.f, 0.f};
#pragma unroll
              for (int ks = 0; ks < 4; ++ks)
#pragma unroll
                for (int it = 0; it < 4; ++it) ia[it] = mfma16(frag_row(L, SS + hl * 17408, PB, 16 * it, 32 * ks, lane), cf[ks], ia[it]);
#pragma unroll
              for (int it = 0; it < 4; ++it) y[a][it] += el * ia[it]; }
#pragma unroll
            for (int kk = 0; kk < 2; ++kk) { float pv[8];
#pragma unroll
                for (int e = 0; e < 4; ++e) { pv[e] = wv[2 * kk][e]; pv[4 + e] = wv[2 * kk + 1][e]; }
                const bf16x8 pf = pack8(pv);
                bf16x8 xf[4]; frag_tr_x4(xf, F.lb, XT, PX, 32 * kk + 4 * g, 32 * kk + 16 + 4 * g, hl * 64, lane);
#pragma unroll
                for (int it = 0; it < 4; ++it) y[a][it] = mfma16(xf[it], pf, y[a][it]); }
        }
    }
    const size_t tok = (size_t)tc * 64 + t; float ssq = 0.f;
#pragma unroll
    for (int a = 0; a < 2; ++a) { const int hl = 2 * hp2 + a, hh = gi * 4 + hl; const float dsk = p.ssm_d[l * 8 + hh];
#pragma unroll
        for (int it = 0; it < 4; ++it) { const int pi = 16 * it + 4 * g;
            const u32x2 xv = *(LAS u32x2*)(L + XT + t * PX + (hl * 64 + pi) * 2); const u32x2 zv = *(const u32x2*)(F.proj() + tok * NPROJ + ZO + hh * 64 + pi);
            f32x4 v = y[a][it];
            v[0] = (v[0] + dsk * bflo(xv.x)) * siluf(bflo(zv.x)); v[1] = (v[1] + dsk * bfhi(xv.x)) * siluf(bfhi(zv.x));
            v[2] = (v[2] + dsk * bflo(xv.y)) * siluf(bflo(zv.y)); v[3] = (v[3] + dsk * bfhi(xv.y)) * siluf(bfhi(zv.y));
            y[a][it] = v; ssq += v[0] * v[0] + v[1] * v[1] + v[2] * v[2] + v[3] * v[3]; } }
    ssq = gsum4(ssq);
    if (g == 0) Sq[hp2 * 64 + t] = ssq;
    __syncthreads();
    if (l == 0 || tc < 256) {
        const float rstd = rsqrtf((Sq[t] + Sq[64 + t]) * (1.0f / 256.0f) + 1e-6f);
#pragma unroll
        for (int a = 0; a < 2; ++a) { const int hh = gi * 4 + 2 * hp2 + a;
#pragma unroll
            for (int it = 0; it < 4; ++it) { const int c = hh * 64 + 16 * it + 4 * g; const f32x4 nwv = *(const f32x4*)(p.ssm_norm_w + l * 512 + c); const f32x4 v = y[a][it] * rstd * nwv;
                u32x2 wq; wq.x = pk2(v[0], v[1]); wq.y = pk2(v[2], v[3]); *(u32x2*)(F.mix() + tok * 2048 + 1536 + c) = wq; } }
    }
}

DI void phase_scan(const Frame& F) {
    int item;
    if (F.tid < 128) item = F.bid * 128 + F.tid; else if (F.tid == 128 && F.bid < 128) item = 32768 + F.bid; else return;
    const bool isml = item < 16512;
    bf16_t* base; const float* dec; int d; size_t stride; int nch, nctx;
    if (isml) { const int ch = item / 2064, e = item % 2064; base = F.stml() + (size_t)ch * NC2 * 16512 + e * 8; dec = F.decml() + ch * NC2; d = ch >> 2; stride = 16512; nch = NC2; nctx = 2; }
    else { const int it2 = item - 16512, ch = it2 >> 10, e = it2 & 1023; base = F.stss() + (size_t)ch * NCH * 8192 + e * 8; dec = F.decss() + ch * NCH; d = ch >> 3; stride = 8192; nch = NCH; nctx = 4; }
    float s[8];
#pragma unroll
    for (int e = 0; e < 8; ++e) s[e] = 0.f;
#pragma unroll 1
    for (int p0 = 0; p0 < nch; p0 += 13) {
        u32x4 tmp[13]; float dc[13]; int tcs[13];
#pragma unroll
        for (int j = 0; j < 13; ++j) { const int pp = p0 + j; const int tc = d ? nch - 1 - pp : (pp < nctx ? nch - nctx + pp : pp - nctx); tcs[j] = tc;
            tmp[j] = *(const u32x4*)(base + (size_t)tc * stride); dc[j] = dec[tc]; }
#pragma unroll
        for (int j = 0; j < 13; ++j) { *(u32x4*)(base + (size_t)tcs[j] * stride) = __builtin_bit_cast(u32x4, pack8(s)); float t[8]; unpack8(tmp[j], t);
#pragma unroll
            for (int e = 0; e < 8; ++e) s[e] = dc[j] * s[e] + t[e]; }
    }
}

DI void phase_route(const Params& p, const Frame& F, int l) {
    constexpr unsigned RP = 4112;
    LAS unsigned char* L = F.L; const int lane = F.lane, g = lane >> 4, n = lane & 15;
    LAS int* lcnt = (LAS int*)(L + 36 * RP);
    __syncthreads();
    if (!DBG(1024)) { const bf16_t* rw = F.rwt() + (size_t)l * 36 * 2048;
      for (int ci = F.tid; ci < 36 * 256; ci += NTHR) { const int row = ci >> 8, c16 = ci & 255; *(LAS u32x4*)(L + row * RP + c16 * 16) = *(const u32x4*)(rw + row * 2048 + c16 * 8); } }
    if (F.tid < 32) lcnt[F.tid] = 0;
    __syncthreads();
    const int nrows = l == 0 ? NT : T;
    const float* modl = F.mod() + (size_t)l * 2 * 12288;
    const int ntile = nrows / 16, ntb = (ntile - F.bid + F.G - 1) / F.G;
    if (!DBG(2048))
#pragma unroll 2
    for (int j = F.wave; j < ntb * 16; j += 8) { const int row = ((j >> 4) * F.G + F.bid) * 16 + (j & 15);
        const float* md = modl + (size_t)(row >= T ? 1 : 0) * 12288;
        f32x4 v[8]; float ss = 0.f;
#pragma unroll
        for (int jj = 0; jj < 8; ++jj) { const u32x2 q = *(const u32x2*)(F.xbuf() + (size_t)row * 2048 + jj * 256 + lane * 4); v[jj] = (f32x4){bflo(q.x), bfhi(q.x), bflo(q.y), bfhi(q.y)}; ss += v[jj][0] * v[jj][0] + v[jj][1] * v[jj][1] + v[jj][2] * v[jj][2] + v[jj][3] * v[jj][3]; }
        ss = wsum(ss); const float rstd = rsqrtf(ss * (1.0f / 2048.0f) + 1e-6f);
#pragma unroll
        for (int jj = 0; jj < 8; ++jj) { const int c = jj * 256 + lane * 4;
            const f32x4 nwv = *(const f32x4*)(p.norm2_w + l * 2048 + c), sc = *(const f32x4*)(md + 4 * 2048 + c), sh = *(const f32x4*)(md + 3 * 2048 + c);
            const f32x4 o = v[jj] * rstd * nwv * (1.0f + sc) + sh;
            u32x2 pk; pk.x = pk2(o[0], o[1]); pk.y = pk2(o[2], o[3]); *(u32x2*)(F.h() + (size_t)row * 2048 + c) = pk; } }
    asm volatile("s_waitcnt vmcnt(0)" ::: "memory");
    __syncthreads();
    __builtin_amdgcn_fence(__ATOMIC_ACQUIRE, "agent");
    asm volatile("s_waitcnt vmcnt(0)" ::: "memory");
    const int r0 = (F.wave * F.G + F.bid) * 16;
    if (r0 < nrows) {
        if (!DBG(4096)) {
        f32x4 acc[3];
#pragma unroll
        for (int nt = 0; nt < 3; ++nt) acc[nt] = (f32x4){0.f, 0.f, 0.f, 0.f};
        const bf16_t* ap = F.h() + (size_t)(r0 + n) * 2048 + 8 * g;
        const unsigned bo0 = (unsigned)n * RP + 16u * g, bo1 = (unsigned)(16 + n) * RP + 16u * g, bo2 = (unsigned)(32 + n > 35 ? 35 : 32 + n) * RP + 16u * g;
#pragma unroll 16
        for (int ks = 0; ks < 64; ++ks) { const bf16x8 a = *(const bf16x8*)(ap + ks * 32);
            acc[0] = mfma16(*(LAS bf16x8*)(L + bo0 + ks * 64), a, acc[0]); acc[1] = mfma16(*(LAS bf16x8*)(L + bo1 + ks * 64), a, acc[1]); acc[2] = mfma16(*(LAS bf16x8*)(L + bo2 + ks * 64), a, acc[2]); }
        float gl[4];
#pragma unroll
        for (int r = 0; r < 4; ++r) gl[r] = __shfl(acc[0][r], n) + p.rg_b[l * 4 + r];
        int gs = 0; float gm = gl[0];
#pragma unroll
        for (int o = 1; o < 4; ++o) { if (gl[o] > gm) { gm = gl[o]; gs = o; } }
        float gden = 0.f;
#pragma unroll
        for (int o = 0; o < 4; ++o) gden += __expf(gl[o] - gm);
        const float gw = 1.0f / gden;
        float le[8];
#pragma unroll
        for (int i = 0; i < 8; ++i) { const int o = 4 + 8 * gs + i, nt = o >> 4, src = n + 16 * ((o >> 2) & 3);
            const float t0 = __shfl(acc[0][i & 3], src), t1 = __shfl(acc[1][i & 3], src), t2 = __shfl(acc[2][i & 3], src);
            le[i] = (nt == 0 ? t0 : (nt == 1 ? t1 : t2)) + p.re_b[l * 32 + gs * 8 + i]; }
        int i1 = 0; float v1 = le[0];
#pragma unroll
        for (int i = 1; i < 8; ++i) if (le[i] > v1) { v1 = le[i]; i1 = i; }
        int i2 = -1; float v2 = -INFINITY;
#pragma unroll
        for (int i = 0; i < 8; ++i) if (i != i1 && le[i] > v2) { v2 = le[i]; i2 = i; }
        const float w1 = 1.0f / (1.0f + __expf(v2 - v1)), w2 = 1.0f - w1;
        if (g == 0) { const int row = r0 + n, e1 = gs * 8 + i1, e2 = gs * 8 + i2;
            const int r1 = atomicAdd((int*)(lcnt + e1), 1), r2 = atomicAdd((int*)(lcnt + e2), 1);
            F.toke()[row * 2] = e1; F.toke()[row * 2 + 1] = e2; F.tokw()[row * 2] = w1 * gw; F.tokw()[row * 2 + 1] = w2 * gw; F.tokr()[row * 2] = r1; F.tokr()[row * 2 + 1] = r2; }
        }
    }
    __syncthreads();
    if (F.tid < 32) F.cnt()[F.bid * 32 + F.tid] = lcnt[F.tid];
}

DI void phase_slot(const Params& p, const Frame& F, int l) {
    LAS int* tot = (LAS int*)F.L; LAS int* pre = tot + 32; LAS int* pst = tot + 64; LAS int* pend = tot + 96; LAS int* part = tot + 128;
    __syncthreads();
    { const int e = F.tid & 31, pt = F.tid >> 5; int t = 0, pr = 0;
#pragma unroll 4
      for (int b = pt * 16; b < pt * 16 + 16; ++b) { const int c = F.cnt()[b * 32 + e]; t += c; pr += (b < F.bid) ? c : 0; }
      part[(pt * 2) * 32 + e] = t; part[(pt * 2 + 1) * 32 + e] = pr; }
    __syncthreads();
    if (F.tid < 32) { int t = 0, pr = 0; for (int pt = 0; pt < 16; ++pt) { t += part[(pt * 2) * 32 + F.tid]; pr += part[(pt * 2 + 1) * 32 + F.tid]; } tot[F.tid] = t; pre[F.tid] = pr; }
    __syncthreads();
    if (F.tid == 0) { int acc = 0; for (int e = 0; e < 32; ++e) { pst[e] = acc; acc += (tot[e] + 255) & ~255; pend[e] = acc; } }
    __syncthreads();
    if (F.bid == 0 && F.tid == 0) { int idx = 0; for (int e = 0; e < 32; ++e) { const int nt = (pend[e] - pst[e]) >> 8; for (int k = 0; k < nt; ++k) F.mte()[idx++] = e; } F.mte()[MAXMT] = idx; }
    const int nrows = l == 0 ? NT : T;
    const int r0 = (F.wave * F.G + F.bid) * 16;
    if (r0 < nrows) {
#pragma unroll 4
        for (int rr = 0; rr < 16; ++rr) { const int row = r0 + rr;
            const int e1 = F.toke()[row * 2], e2 = F.toke()[row * 2 + 1];
            const int s1 = pst[e1] + pre[e1] + F.tokr()[row * 2], s2 = pst[e2] + pre[e2] + F.tokr()[row * 2 + 1];
            if (F.lane == 0) { F.toks()[row * 2] = s1; F.toks()[row * 2 + 1] = s2; F.slotw()[s1] = F.tokw()[row * 2]; F.slotw()[s2] = F.tokw()[row * 2 + 1]; }
#pragma unroll
            for (int j = 0; j < 2; ++j) { float a[8], b[8]; unpack8(*(const u32x4*)(F.h() + (size_t)row * 2048 + j * 1024 + F.lane * 16), a); unpack8(*(const u32x4*)(F.h() + (size_t)row * 2048 + j * 1024 + F.lane * 16 + 8), b);
                u32x4 v; v.x = pk4_fp8(a[0] * FS_X, a[1] * FS_X, a[2] * FS_X, a[3] * FS_X); v.y = pk4_fp8(a[4] * FS_X, a[5] * FS_X, a[6] * FS_X, a[7] * FS_X);
                v.z = pk4_fp8(b[0] * FS_X, b[1] * FS_X, b[2] * FS_X, b[3] * FS_X); v.w = pk4_fp8(b[4] * FS_X, b[5] * FS_X, b[6] * FS_X, b[7] * FS_X);
                unsigned char* am = (unsigned char*)F.amoe();
                *(u32x4*)(am + (size_t)s1 * 2048 + j * 1024 + F.lane * 16) = v; *(u32x4*)(am + (size_t)s2 * 2048 + j * 1024 + F.lane * 16) = v; } }
    }
    { const int e = F.bid >> 3, part8 = F.bid & 7;
      unsigned zz = 0u; asm volatile("" : "+v"(zz)); const u32x4 zv = {zz, zz, zz, zz};
      if (e < 32) for (int s = pst[e] + tot[e] + part8 * 8 + F.wave; s < pend[e]; s += 64) {
          if (F.lane == 0) F.slotw()[s] = 0.f;
#pragma unroll
          for (int j = 0; j < 2; ++j) *(u32x4*)((unsigned char*)F.amoe() + (size_t)s * 2048 + j * 1024 + F.lane * 16) = zv; } }
}

__global__ void __launch_bounds__(NTHR, 2) fwd_kernel(Params p) {
    extern __shared__ __attribute__((aligned(16))) unsigned char lds_raw[];
    Frame F;
    F.L = (LAS unsigned char*)lds_raw; F.lb = (unsigned)(uintptr_t)F.L;
    F.tid = threadIdx.x; F.lane = F.tid & 63; F.wave = __builtin_amdgcn_readfirstlane(F.tid >> 6); F.bid = blockIdx.x; F.G = gridDim.x;
    unsigned char* ws = p.ws; F.ws = ws;

    volatile LAS unsigned* xbw = (volatile LAS unsigned*)(F.L + LDS_MISC);
    if (F.tid == 0) { xbw[0] = 0u; xbw[1] = 0u; }
    __syncthreads();
    const int lo = p.ph_lo, hi = p.ph_hi;
    const bool multi = (hi - lo) > 1;
    XcdBarrier bar; bar.bar = (unsigned*)(ws + WS_BAR); bar.x = 0; bar.st = xbw;
    if (multi) bar = xcd_barrier_post((unsigned*)(ws + WS_BAR), xbw);
#ifndef PH_MASK
#define PH_MASK 0xFFF
#endif
#ifndef TM
#define TM (p.tmask)
#endif
#define IN(k) (lo <= (k) && (k) < hi)
#define ON(j) (((PH_MASK) >> (j)) & 1)
#define SEAM(k) do { if (IN(k) && IN((k) + 1)) xcd_barrier(bar); } while (0)

    if (ON(0) && IN(0)) { phase_prologue(p, F.fresh()); } SEAM(0);
#ifdef EXTRA_BARRIERS
    if (hi - lo > 1) for (int eb = 0; eb < EXTRA_BARRIERS; ++eb) xcd_barrier(bar);
#endif
    for (int l = 0; l < 2; ++l) {
        const int pb = 1 + 11 * l;
        if (ON(1) && IN(pb + 0)) { if (l == 0) phase_rows<0>(p, F.fresh()); else phase_rows<1>(p, F.fresh()); } SEAM(pb + 0);
        if (ON(2) && IN(pb + 1)) {
            pg8::Gemm g{F.h(), F.win() + (size_t)l * NPAD * 2048, NT, NPAD, 2048}; pg8::StaticOrder S; S.init(NT, NPAD, F.G, F.bid);
            pg8::EpiProj E{F.proj(), F.gates()};
            pg8::gemm_phase<pg8::EpiProj, pg8::StaticOrder>(F.L, g, S, E, nullptr);
        } SEAM(pb + 1);
        if (ON(3) && IN(pb + 2)) { phase_prep(p, F.fresh(), l); } SEAM(pb + 2);
        if (ON(4) && IN(pb + 3)) {
            const Frame Fq = F.fresh(); const int ntask = l == 0 ? 1040 : 1024;
            if (TM & 1) for (int t = F.bid; t < ntask; t += F.G) na_task(p, Fq, l, t);
            if (TM & 2) for (int t = F.bid; t < 512 + 16; t += F.G) { if (t < 512) ml_state128_task(p, Fq, t >> 2, t & 3, -1); else { const int ix = t - 512; ml_state128_task(p, Fq, 128 + (ix >> 3), (ix >> 1) & 3, ix & 1); } }
            if (TM & 4) for (int t = F.bid; t < NCH * 2; t += F.G) ss_state_task(p, Fq, l, t >> 1, t & 1);
        } SEAM(pb + 3);
        if (ON(5) && IN(pb + 4)) { phase_scan(F.fresh()); } SEAM(pb + 4);
        if (ON(6) && IN(pb + 5)) {
            const Frame Fq = F.fresh(); const int nc = l == 0 ? NCH : 256;
            if (TM & 8) for (int t = F.bid; t < (nc >> 1) * 4; t += F.G) ml_out128_task(p, Fq, l, t >> 2, t & 3);
            if (TM & 16) for (int t = F.bid; t < nc * 2; t += F.G) ss_out_task(p, Fq, l, t >> 1, t & 1);
        } SEAM(pb + 5);
        if (ON(7) && IN(pb + 6)) {
            const int M = l == 0 ? NT : T;
            pg8::Gemm g{F.mix(), F.wout() + (size_t)l * 2048 * 2048, M, 2048, 2048}; pg8::StaticOrder S; S.init(M, 2048, F.G, F.bid);
            const float* gl = F.mod() + ((size_t)l * 2 + 0) * 12288 + 2 * 2048; const float* gc = F.mod() + ((size_t)l * 2 + 1) * 12288 + 2 * 2048;
            if (l == 0) { pg8::EpiRes<true> E{p.x, p.ctx, F.xbuf(), gl, gc}; pg8::gemm_phase<pg8::EpiRes<true>, pg8::StaticOrder>(F.L, g, S, E, nullptr); }
            else { pg8::EpiRes<false> E{nullptr, nullptr, F.xbuf(), gl, gc}; pg8::gemm_phase<pg8::EpiRes<false>, pg8::StaticOrder>(F.L, g, S, E, nullptr); }
        } SEAM(pb + 6);
        if (ON(8) && IN(pb + 7)) { phase_route(p, F.fresh(), l); } SEAM(pb + 7);
        if (ON(9) && IN(pb + 8)) { phase_slot(p, F.fresh(), l); } SEAM(pb + 8);
        if (ON(10) && IN(pb + 9)) {
            pg8::Gemm g{F.amoe(), (const bf16_t*)((const unsigned char*)F.w13() + (size_t)l * NEXP * 2048 * 2048), NSLOT, 2048, 2048};
            pg8::MoeOrder S{F.mte(), F.mte()[MAXMT] * 8, F.G, F.bid};
            pg8::EpiGateUp E{(unsigned char*)F.hid()};
            pg8::gemm_phase<pg8::EpiGateUp, pg8::MoeOrder, false, 1, SC_W13, SC_X>(F.L, g, S, E, nullptr);
        } SEAM(pb + 9);
        if (ON(11) && IN(pb + 10)) {
            pg8::Gemm g{F.hid(), (const bf16_t*)((const unsigned char*)F.w2() + (size_t)l * NEXP * 2048 * 1024), NSLOT, 2048, 1024};
            pg8::MoeOrder S{F.mte(), F.mte()[MAXMT] * 8, F.G, F.bid};
            pg8::EpiDown E{(unsigned char*)F.ymoe(), F.slotw()};
            pg8::gemm_phase<pg8::EpiDown, pg8::MoeOrder, false, 1, SC_W2, SC_X2>(F.L, g, S, E, nullptr);
        } SEAM(pb + 10);
    }
    if (ON(1) && IN(23)) { phase_rows<2>(p, F.fresh()); }
#undef IN
#undef SEAM
}

constexpr int NPHASE = 24;
#ifndef N_LAUNCH_MODE
#define N_LAUNCH_MODE 1
#endif

extern "C" void kernel_launch(void* const* d_in, const int* in_sizes, int n_in, void* d_out, int out_size, void* d_ws, size_t ws_size, hipStream_t stream) {
    static int grid = 0;
    if (grid == 0) {
        if (n_in != 27 || ws_size < WS_END) { fprintf(stderr, "kernel_launch: unexpected inputs (n_in %d) or workspace %zu < %zu\n", n_in, ws_size, (size_t)WS_END); grid = -1; return; }
        int dev = 0, cus = 0, per_cu = 0;
        hipGetDevice(&dev); hipDeviceGetAttribute(&cus, hipDeviceAttributeMultiprocessorCount, dev);
        if (hipFuncSetAttribute((const void*)fwd_kernel, hipFuncAttributeMaxDynamicSharedMemorySize, LDS_BYTES) != hipSuccess) { fprintf(stderr, "kernel_launch: hipFuncSetAttribute failed\n"); grid = -1; return; }
        hipOccupancyMaxActiveBlocksPerMultiprocessor(&per_cu, (const void*)fwd_kernel, NTHR, LDS_BYTES);
        (void)hipGetLastError();
        if (cus < 256 || per_cu < 1) { fprintf(stderr, "kernel_launch: needs 256 CUs with one resident workgroup each (cus %d, per_cu %d)\n", cus, per_cu); grid = -1; return; }
        grid = 256;
    }
    if (grid < 0) return;
    hipMemsetAsync((char*)d_ws + WS_BAR, 0, 65536, stream);
    Params p{};
    const float** pp = (const float**)&p;
    for (int i = 0; i < 27; ++i) pp[i] = (const float*)d_in[i];
    p.out = (float*)d_out; p.ws = (unsigned char*)d_ws;
#if N_LAUNCH_MODE == 1
    p.ph_lo = 0; p.ph_hi = NPHASE; p.tmask = 31; p.pad = 0;
    hipLaunchKernelGGL(fwd_kernel, dim3(grid), dim3(NTHR), LDS_BYTES, stream, p);
#ifdef PROBE_LIST
    { const int pl[] = PROBE_LIST; for (int pv : pl) { const int ph = pv & 255; p.tmask = ((pv >> 8) & 255) ? ((pv >> 8) & 255) : 31; p.pad = pv >> 16; p.ph_lo = ph; p.ph_hi = ph + 1; hipLaunchKernelGGL(fwd_kernel, dim3(grid), dim3(NTHR), LDS_BYTES, stream, p); } }
#endif
#else
    p.tmask = 31; p.pad = 0; for (int ph = 0; ph < NPHASE; ++ph) { p.ph_lo = ph; p.ph_hi = ph + 1; hipLaunchKernelGGL(fwd_kernel, dim3(grid), dim3(NTHR), LDS_BYTES, stream, p); }
#endif
}
```

```cpp
#include <hip/hip_runtime.h>
#include <stdint.h>
#include <stdio.h>

#ifdef PROBE_LIST
#define DBG(x) (p.pad & (x))
#else
#define DBG(x) 0
#endif
#define LAS __attribute__((address_space(3)))
#define DI __device__ __forceinline__
typedef unsigned short bf16_t;
typedef short bf16x8 __attribute__((ext_vector_type(8)));
typedef short bf16x4 __attribute__((ext_vector_type(4)));
typedef float f32x4 __attribute__((ext_vector_type(4)));
typedef float f32x2 __attribute__((ext_vector_type(2)));
typedef unsigned u32x4 __attribute__((ext_vector_type(4)));
typedef unsigned u32x2 __attribute__((ext_vector_type(2)));
typedef __bf16 bfv2 __attribute__((ext_vector_type(2)));

constexpr int D = 2048, T = 16384, CTXL = 256, NT = T + CTXL;
constexpr int INC = 6688, NPROJ = 6656, NPAD = 6912;
constexpr int QO = 0, KO = 1024, VO = 2048, MQO = 3072, MKO = 3584, MVO = 4096, MOO = 4608, ZO = 5120, XBO = 5632;
constexpr int NCH = 260;
constexpr int NEXP = 32, FF = 1024;
constexpr int MAXMT = 162, NSLOT = MAXMT * 256;
constexpr int NTHR = 512;
constexpr int LDS_BYTES = 155648;
constexpr int LDS_MISC = LDS_BYTES - 256;

constexpr size_t al256(size_t x) { return (x + 255) & ~(size_t)255; }
constexpr size_t WS_BAR   = 0;
constexpr size_t WS_MODP  = 65536;
constexpr size_t WS_MOD   = WS_MODP  + al256((size_t)2 * 8 * 2 * 12288 * 4);
constexpr size_t WS_ROPE  = WS_MOD   + al256((size_t)2 * 2 * 12288 * 4);
constexpr size_t WS_TOKE  = WS_ROPE  + al256((size_t)(256 + 64) * 32 * 2 * 4);
constexpr size_t WS_TOKW  = WS_TOKE  + al256((size_t)NT * 2 * 4);
constexpr size_t WS_TOKR  = WS_TOKW  + al256((size_t)NT * 2 * 4);
constexpr size_t WS_TOKS  = WS_TOKR  + al256((size_t)NT * 2 * 4);
constexpr size_t WS_CNT   = WS_TOKS  + al256((size_t)NT * 2 * 4);
constexpr size_t WS_MTE   = WS_CNT   + al256((size_t)256 * 32 * 4);
constexpr size_t WS_SLOTW = WS_MTE   + al256((size_t)(MAXMT + 2) * 4);
constexpr size_t WS_GATES = WS_SLOTW + al256((size_t)NSLOT * 4);
constexpr size_t WS_MLG   = WS_GATES + al256((size_t)NT * 32 * 4);
constexpr size_t WS_DT    = WS_MLG   + al256((size_t)NT * 16 * 4);
constexpr size_t WS_DECML = WS_DT    + al256((size_t)NT * 16 * 4);
constexpr size_t WS_DECSS = WS_DECML + al256((size_t)8 * NCH * 4);
constexpr size_t WS_MVEC  = WS_DECSS + al256((size_t)16 * NCH * 4);
constexpr size_t WS_RSTD  = WS_MVEC  + al256((size_t)2 * 2 * 2048 * 4);
constexpr size_t WS_RWT   = WS_RSTD  + al256((size_t)NT * 4);
constexpr size_t WS_WIN   = WS_RWT   + al256((size_t)2 * 36 * 2048 * 2);
constexpr size_t WS_WOUT  = WS_WIN   + (size_t)2 * NPAD * D * 2;
constexpr size_t WS_W13   = WS_WOUT  + (size_t)2 * D * D * 2;
constexpr size_t WS_W2    = WS_W13   + (size_t)2 * NEXP * 2048 * D * 2;
constexpr size_t WS_H     = WS_W2    + (size_t)2 * NEXP * D * FF * 2;
constexpr size_t WS_XBUF  = WS_H     + (size_t)NT * D * 2;
constexpr size_t WS_PROJ  = WS_XBUF  + (size_t)NT * D * 4;
constexpr size_t WS_XBCC  = WS_PROJ  + (size_t)NT * NPROJ * 2;
constexpr size_t WS_MIX   = WS_XBCC  + (size_t)NT * 1024 * 2;
constexpr size_t WS_STML  = WS_MIX   + (size_t)NT * D * 2;
constexpr size_t WS_STSS  = WS_STML  + (size_t)8 * NCH * 16512 * 4;
constexpr size_t WS_END   = WS_STSS  + (size_t)16 * NCH * 8192 * 4;
constexpr size_t WS_AMOE  = WS_PROJ;
constexpr size_t WS_HID   = WS_AMOE + (size_t)NSLOT * D * 2;
constexpr size_t WS_YMOE  = WS_MIX;
static_assert(WS_HID + (size_t)NSLOT * FF * 2 <= WS_MIX, "moe alias 1");
static_assert(WS_YMOE + (size_t)NSLOT * D * 2 <= WS_STSS, "moe alias 2");

struct Params {
    const float *x, *c, *ctx, *c_ctx, *w_mod, *b_mod, *norm1_w, *norm2_w, *w_in, *w_out, *na_rpb, *ml_gate_b, *ml_norm_w,
                *conv_w, *conv_b, *dt_bias, *a_log, *ssm_d, *ssm_norm_w, *rg_w, *rg_b, *re_w, *re_b, *w1, *w3, *w2, *final_w;
    float* out; unsigned char* ws; int ph_lo, ph_hi, tmask, pad;
};

DI unsigned pk2(float lo, float hi) { f32x2 v = {lo, hi}; bfv2 b = __builtin_convertvector(v, bfv2); return __builtin_bit_cast(unsigned, b); }
DI float bflo(unsigned u) { return __uint_as_float(u << 16); }
DI float bfhi(unsigned u) { return __uint_as_float(u & 0xffff0000u); }
DI float bf2f(bf16_t b) { return __uint_as_float(((unsigned)b) << 16); }
DI bf16_t f2bf(float f) { return (bf16_t)(pk2(f, 0.f) & 0xffffu); }
DI float wsum(float v) { v += __shfl_xor(v, 32); v += __shfl_xor(v, 16); v += __shfl_xor(v, 8); v += __shfl_xor(v, 4); v += __shfl_xor(v, 2); v += __shfl_xor(v, 1); return v; }
DI float gsum4(float v) { v += __shfl_xor(v, 16); v += __shfl_xor(v, 32); return v; }
DI f32x4 mfma16(bf16x8 a, bf16x8 b, f32x4 c) { return __builtin_amdgcn_mfma_f32_16x16x32_bf16(a, b, c, 0, 0, 0); }
DI float siluf(float v) { return v / (1.0f + __expf(-v)); }
DI float sigmf(float v) { return 1.0f / (1.0f + __expf(-v)); }
DI bf16x8 pack8(const float (&v)[8]) { u32x4 p; p.x = pk2(v[0], v[1]); p.y = pk2(v[2], v[3]); p.z = pk2(v[4], v[5]); p.w = pk2(v[6], v[7]); return __builtin_bit_cast(bf16x8, p); }
DI void unpack8(u32x4 u, float (&v)[8]) { v[0] = bflo(u.x); v[1] = bfhi(u.x); v[2] = bflo(u.y); v[3] = bfhi(u.y); v[4] = bflo(u.z); v[5] = bfhi(u.z); v[6] = bflo(u.w); v[7] = bfhi(u.w); }
DI bf16x8 frag_row(LAS unsigned char* L, unsigned tb, unsigned pb, int r0, int k0, int lane) {
    return *(LAS bf16x8*)(L + tb + (unsigned)(r0 + (lane & 15)) * pb + (unsigned)(k0 + 8 * (lane >> 4)) * 2u);
}
DI bf16x8 frag_tr(unsigned lbase, unsigned tb, unsigned pb, int rA, int rB, int c0, int lane) {
    const int q = (lane & 15) >> 2, pq = lane & 3;
    const unsigned a0 = lbase + tb + (unsigned)(rA + q) * pb + (unsigned)(c0 + 4 * pq) * 2u;
    const unsigned a1 = lbase + tb + (unsigned)(rB + q) * pb + (unsigned)(c0 + 4 * pq) * 2u;
    bf16x4 lo, hi;
    asm volatile("ds_read_b64_tr_b16 %0, %2\n\tds_read_b64_tr_b16 %1, %3\n\ts_waitcnt lgkmcnt(0)" : "=&v"(lo), "=&v"(hi) : "v"(a0), "v"(a1) : "memory");
    bf16x8 r; r[0] = lo[0]; r[1] = lo[1]; r[2] = lo[2]; r[3] = lo[3]; r[4] = hi[0]; r[5] = hi[1]; r[6] = hi[2]; r[7] = hi[3]; return r;
}
DI float wscan(float v, int rev, int lane) {
#pragma unroll
    for (int off = 1; off < 64; off <<= 1) {
        const float t = rev ? __shfl_down(v, off) : __shfl_up(v, off);
        const bool ok = rev ? (lane + off < 64) : (lane >= off);
        v += ok ? t : 0.f;
    }
    return v;
}
DI void frag_tr_x4(bf16x8 (&f)[4], unsigned lbase, unsigned tb, unsigned pb, int rA, int rB, int c0, int lane) {
    const int q = (lane & 15) >> 2, pq = lane & 3;
    const unsigned a0 = lbase + tb + (unsigned)(rA + q) * pb + (unsigned)(c0 + 4 * pq) * 2u;
    const unsigned a1 = lbase + tb + (unsigned)(rB + q) * pb + (unsigned)(c0 + 4 * pq) * 2u;
    bf16x4 l0, l1, l2, l3, h0, h1, h2, h3;
    asm volatile("ds_read_b64_tr_b16 %0, %8\n\tds_read_b64_tr_b16 %1, %8 offset:32\n\tds_read_b64_tr_b16 %2, %8 offset:64\n\tds_read_b64_tr_b16 %3, %8 offset:96\n\t"
                 "ds_read_b64_tr_b16 %4, %9\n\tds_read_b64_tr_b16 %5, %9 offset:32\n\tds_read_b64_tr_b16 %6, %9 offset:64\n\tds_read_b64_tr_b16 %7, %9 offset:96\n\ts_waitcnt lgkmcnt(0)"
                 : "=&v"(l0), "=&v"(l1), "=&v"(l2), "=&v"(l3), "=&v"(h0), "=&v"(h1), "=&v"(h2), "=&v"(h3) : "v"(a0), "v"(a1) : "memory");
    f[0] = __builtin_shufflevector(l0, h0, 0, 1, 2, 3, 4, 5, 6, 7); f[1] = __builtin_shufflevector(l1, h1, 0, 1, 2, 3, 4, 5, 6, 7);
    f[2] = __builtin_shufflevector(l2, h2, 0, 1, 2, 3, 4, 5, 6, 7); f[3] = __builtin_shufflevector(l3, h3, 0, 1, 2, 3, 4, 5, 6, 7);
}
DI unsigned pk4_fp8(float a, float b, float c, float d) { int w = 0; w = __builtin_amdgcn_cvt_pk_fp8_f32(a, b, w, false); w = __builtin_amdgcn_cvt_pk_fp8_f32(c, d, w, true); return (unsigned)w; }
constexpr float FS_W13 = 64.f, FS_W2 = 32.f, FS_X = 4.f, FS_Y = 16.f;
constexpr int SC_W13 = 127 - 4, SC_W2 = 127 - 4, SC_X = 127 - 4, SC_X2 = 127 - 3;
DI f32x4 unpk4_fp8(unsigned w) { const f32x2 lo = __builtin_amdgcn_cvt_pk_f32_fp8((int)w, false), hi = __builtin_amdgcn_cvt_pk_f32_fp8((int)w, true); return (f32x4){lo[0], lo[1], hi[0], hi[1]}; }

namespace pg8 {
#define PG8_LAS __attribute__((address_space(3)))
typedef unsigned short bf16_t;
typedef short bf16x8 __attribute__((ext_vector_type(8)));
typedef float f32x4 __attribute__((ext_vector_type(4)));
typedef unsigned u32x4 __attribute__((ext_vector_type(4)));
constexpr int BM = 256, BK = 64, HALF = 128, HTB = HALF * BK * 2, STAGE_BYTES = 8 * HTB, NXCD = 8, WGM = 8;
__host__ __device__ __forceinline__ int lds_byte(int r, int c) { const int st = (r >> 4) * 2 + (c >> 5), rr = r & 15, cc = c & 31, ob = rr * 64 + cc * 2; return st * 1024 + (ob ^ (((ob >> 9) & 1) << 5)); }
__host__ __device__ __forceinline__ void stage_rc(int b, int& R, int& C) { const int st = b / 1024, sb = b % 1024, swz = sb ^ (((sb >> 9) & 1) << 5); R = (st >> 1) * 16 + swz / 64; C = (st & 1) * 32 + (swz % 64) / 2; }
__host__ __device__ __forceinline__ int perm32(int rho) { const int n = rho >> 4, i = rho & 15; return 8 * (i >> 2) + 4 * n + (i & 3); }
struct Unit { int pm, pn; };
struct Gemm { const bf16_t* A; const bf16_t* Bt; int M, N, K; };
struct StaticOrder {
    int nM, nN, nwg, G, c;
    __host__ __device__ void init(int M, int N, int G_, int c_) { nM = M / BM; nN = N / BM; nwg = nM * nN; G = G_; c = c_; }
    __host__ __device__ bool next(int i, Unit& u) const {
        const long L = (long)i * G + c; if (L >= nwg) return false;
        int wgid = (int)L; { const int q = nwg / NXCD, r = nwg % NXCD, xcd = wgid % NXCD, off = wgid / NXCD; wgid = (xcd < r ? xcd * (q + 1) : r * (q + 1) + (xcd - r) * q) + off; }
        const int nig = WGM * nN, gid = wgid / nig, fm = gid * WGM, gsz = (nM - fm) < WGM ? (nM - fm) : WGM;
        u.pm = fm + ((wgid % nig) % gsz); u.pn = (wgid % nig) / gsz; return true;
    }
    __device__ __forceinline__ void a_ready(const Unit&) const {}
    __device__ __forceinline__ void done(const Unit&) const {}
};
struct MoeOrder {
    const int* mte; int nunits, G, c;
    __device__ bool next(int i, Unit& u) const { const int L = i * G + c; if (L >= nunits) return false; const int mt = L >> 3; u.pm = mt; u.pn = mte[mt] * 8 + (L & 7); return true; }
    __device__ __forceinline__ void a_ready(const Unit&) const {}
    __device__ __forceinline__ void done(const Unit&) const {}
};
DI unsigned pk2(float lo, float hi) { return ::pk2(lo, hi); }
DI unsigned pk4_fp8(float a, float b, float c, float d) { return ::pk4_fp8(a, b, c, d); }
using ::FS_X; using ::FS_Y;

struct EpiProj {
    static constexpr bool PERM = true, AFTER_DRAIN = false;
    bf16_t* O; float* gates;
    __device__ __forceinline__ void operator()(const f32x4 (&acc)[2][2][4][2], const Unit& u, int wr, int wc, int fr, int fq) const {
        const int row0 = u.pm * BM + wr * 64 + fr;
        if (u.pn < 26) {
            const int col0 = u.pn * BM + wc * 32 + 8 * fq;
#pragma unroll
            for (int ai = 0; ai < 2; ++ai)
#pragma unroll
                for (int m = 0; m < 4; ++m) { bf16_t* rowp = O + (size_t)(row0 + ai * HALF + m * 16) * 6656 + col0;
#pragma unroll
                    for (int bj = 0; bj < 2; ++bj) { const f32x4 v0 = acc[ai][bj][m][0], v1 = acc[ai][bj][m][1];
                        u32x4 w; w.x = pk2(v0[0], v0[1]); w.y = pk2(v0[2], v0[3]); w.z = pk2(v1[0], v1[1]); w.w = pk2(v1[2], v1[3]);
                        *(u32x4*)(rowp + bj * HALF) = w; } }
        } else if (wc == 0) {
#pragma unroll
            for (int ai = 0; ai < 2; ++ai)
#pragma unroll
                for (int m = 0; m < 4; ++m) { float* rowp = gates + (size_t)(row0 + ai * HALF + m * 16) * 32 + 8 * fq;
                    *(f32x4*)(rowp) = acc[ai][0][m][0]; *(f32x4*)(rowp + 4) = acc[ai][0][m][1]; }
        }
    }
};
template <bool BF32> struct EpiRes {
    static constexpr bool PERM = true, AFTER_DRAIN = false;
    const float* base_lat; const float* base_ctx; bf16_t* out; const float* g_lat; const float* g_ctx;
    __device__ __forceinline__ void operator()(const f32x4 (&acc)[2][2][4][2], const Unit& u, int wr, int wc, int fr, int fq) const {
        const bool isctx = u.pm >= 64;
        const float* base = isctx ? base_ctx - (size_t)16384 * 2048 : base_lat; const float* gv = isctx ? g_ctx : g_lat;
        const int row0 = u.pm * BM + wr * 64 + fr, col0 = u.pn * BM + wc * 32 + 8 * fq;
        f32x4 gg[2][2];
#pragma unroll
        for (int bj = 0; bj < 2; ++bj)
#pragma unroll
            for (int n = 0; n < 2; ++n) gg[bj][n] = *(const f32x4*)(gv + col0 + bj * HALF + n * 4);
#pragma unroll
        for (int ai = 0; ai < 2; ++ai)
#pragma unroll
            for (int m = 0; m < 4; ++m) { const size_t off = (size_t)(row0 + ai * HALF + m * 16) * 2048 + col0;
#pragma unroll
                for (int bj = 0; bj < 2; ++bj) { f32x4 b0, b1;
                    if constexpr (BF32) { b0 = *(const f32x4*)(base + off + bj * HALF); b1 = *(const f32x4*)(base + off + bj * HALF + 4); }
                    else { const u32x4 q = *(const u32x4*)(out + off + bj * HALF); b0 = (f32x4){__uint_as_float(q.x << 16), __uint_as_float(q.x & 0xffff0000u), __uint_as_float(q.y << 16), __uint_as_float(q.y & 0xffff0000u)};
                           b1 = (f32x4){__uint_as_float(q.z << 16), __uint_as_float(q.z & 0xffff0000u), __uint_as_float(q.w << 16), __uint_as_float(q.w & 0xffff0000u)}; }
                    const f32x4 v0 = b0 + gg[bj][0] * acc[ai][bj][m][0], v1 = b1 + gg[bj][1] * acc[ai][bj][m][1];
                    u32x4 w; w.x = pk2(v0[0], v0[1]); w.y = pk2(v0[2], v0[3]); w.z = pk2(v1[0], v1[1]); w.w = pk2(v1[2], v1[3]);
                    *(u32x4*)(out + off + bj * HALF) = w; } }
    }
};
struct EpiGateUp {
    static constexpr bool PERM = true, AFTER_DRAIN = false;
    unsigned char* O;
    __device__ __forceinline__ void operator()(const f32x4 (&acc)[2][2][4][2], const Unit& u, int wr, int wc, int fr, int fq) const {
        const int row0 = u.pm * BM + wr * 64 + fr, col0 = (u.pn & 7) * 128 + wc * 32 + 8 * fq;
#pragma unroll
        for (int ai = 0; ai < 2; ++ai)
#pragma unroll
            for (int m = 0; m < 4; ++m) { float h[8];
#pragma unroll
                for (int n = 0; n < 2; ++n)
#pragma unroll
                    for (int j = 0; j < 4; ++j) { const float gt = acc[ai][0][m][n][j], up = acc[ai][1][m][n][j]; h[n * 4 + j] = gt / (1.0f + __expf(-gt)) * up * FS_X; }
                u32x2 w; w.x = pk4_fp8(h[0], h[1], h[2], h[3]); w.y = pk4_fp8(h[4], h[5], h[6], h[7]);
                *(u32x2*)(O + (size_t)(row0 + ai * HALF + m * 16) * 1024 + col0) = w; }
    }
};
struct EpiDown {
    static constexpr bool PERM = true, AFTER_DRAIN = false;
    unsigned char* O; const float* sw;
    __device__ __forceinline__ void operator()(const f32x4 (&acc)[2][2][4][2], const Unit& u, int wr, int wc, int fr, int fq) const {
        const int row0 = u.pm * BM + wr * 64 + fr, col0 = (u.pn & 7) * BM + wc * 32 + 8 * fq;
#pragma unroll
        for (int ai = 0; ai < 2; ++ai)
#pragma unroll
            for (int m = 0; m < 4; ++m) { const int row = row0 + ai * HALF + m * 16; const float s = sw[row] * FS_Y; unsigned char* rowp = O + (size_t)row * 2048 + col0;
#pragma unroll
                for (int bj = 0; bj < 2; ++bj) { const f32x4 v0 = acc[ai][bj][m][0] * s, v1 = acc[ai][bj][m][1] * s;
                    u32x2 w; w.x = pk4_fp8(v0[0], v0[1], v0[2], v0[3]); w.y = pk4_fp8(v1[0], v1[1], v1[2], v1[3]);
                    *(u32x2*)(rowp + bj * HALF) = w; } }
    }
};

template <class Epi, class Sched, bool STAMP = false, int ES = 2, int SCW = 127, int SCX = 127>
__device__ __forceinline__ void gemm_phase(PG8_LAS unsigned char* lds, const Gemm g, const Sched& S, const Epi& E, unsigned long long* stamps) {
    int tid_ = threadIdx.x; asm volatile("" : "+v"(tid_)); const int tid = tid_, wid = __builtin_amdgcn_readfirstlane(tid >> 6), lane = tid & 63, wr = wid >> 2, wc = wid & 3, fr = lane & 15, fq = lane >> 4;
    const int K = g.K * ES / 2  , nt = K / BK;
    int ts_lo = 0, ts_hi = 0, nts = 0; const unsigned long long rt_entry = STAMP ? (unsigned long long)wall_clock64() : 0ull;
#define PG8_STAMP() do { if (STAMP && wid == 0 && nts < 64) { const unsigned long long _c = (unsigned long long)clock64(); \
        ts_lo = (lane == nts) ? (int)(unsigned)_c : ts_lo; ts_hi = (lane == nts) ? (int)(unsigned)(_c >> 32) : ts_hi; ++nts; } } while (0)
    PG8_STAMP();
    unsigned voffA[2], voffB[2];
#pragma unroll
    for (int i = 0; i < 2; ++i) { int R, C; stage_rc(tid * 16 + i * 8192, R, C); const int Rb = Epi::PERM ? ((R & ~31) + perm32(R & 31)) : R;
        voffA[i] = (unsigned)(R * K + C) * 2u; voffB[i] = (unsigned)(Rb * K + C) * 2u; }
    const size_t kstep = (size_t)(BK * 2);
    const size_t hstep = (size_t)HALF * K * 2;
    const size_t tstep = 2 * hstep;
    const unsigned ldsw = (unsigned)wid * 1024u;
    const int aoff = lds_byte(wr * 64 + fr, fq * 8), boff = lds_byte(wc * 32 + fr, fq * 8);
#define PG8_SA(b, h) (((b) * 2 + (h)) * HTB)
#define PG8_SB(b, h) ((4 + (b) * 2 + (h)) * HTB)
#define PG8_STAGE(bufoff, gbase, voff) do { _Pragma("unroll") for (int _i = 0; _i < 2; ++_i) \
        __builtin_amdgcn_global_load_lds((const unsigned*)((const char*)(gbase) + (voff)[_i]), (PG8_LAS unsigned*)(lds + (bufoff) + ldsw + _i * 8192), 16, 0, 0); } while (0)
#define PG8_LDA(dst, b, h) do { _Pragma("unroll") for (int m = 0; m < 4; ++m) { \
        if constexpr (ES == 2) { _Pragma("unroll") for (int k = 0; k < 2; ++k) dst[m][k] = *(const PG8_LAS bf16x8*)(lds + PG8_SA(b, h) + aoff + m * 2048 + k * 1024); } \
        else { const v4i_ lo_ = *(const PG8_LAS v4i_*)(lds + PG8_SA(b, h) + aoff + m * 2048), hi_ = *(const PG8_LAS v4i_*)(lds + PG8_SA(b, h) + aoff + m * 2048 + 1024); dst##8[m] = __builtin_shufflevector(lo_, hi_, 0, 1, 2, 3, 4, 5, 6, 7); } } } while (0)
#define PG8_LDB(dst, b, h) do { _Pragma("unroll") for (int n = 0; n < 2; ++n) { \
        if constexpr (ES == 2) { _Pragma("unroll") for (int k = 0; k < 2; ++k) dst[n][k] = *(const PG8_LAS bf16x8*)(lds + PG8_SB(b, h) + boff + n * 2048 + k * 1024); } \
        else { const v4i_ lo_ = *(const PG8_LAS v4i_*)(lds + PG8_SB(b, h) + boff + n * 2048), hi_ = *(const PG8_LAS v4i_*)(lds + PG8_SB(b, h) + boff + n * 2048 + 1024); dst##8[n] = __builtin_shufflevector(lo_, hi_, 0, 1, 2, 3, 4, 5, 6, 7); } } } while (0)
#define PG8_MMA(ai, bj, At, Bt) do { __builtin_amdgcn_s_setprio(1); _Pragma("unroll") for (int m = 0; m < 4; ++m) _Pragma("unroll") for (int n = 0; n < 2; ++n) { \
        if constexpr (ES == 2) { _Pragma("unroll") for (int k = 0; k < 2; ++k) acc[ai][bj][m][n] = __builtin_amdgcn_mfma_f32_16x16x32_bf16(Bt[n][k], At[m][k], acc[ai][bj][m][n], 0, 0, 0); } \
        else asm volatile("v_mfma_scale_f32_16x16x128_f8f6f4 %0, %1, %2, %0, %3, %4 op_sel_hi:[0,0,0]" : "+v"(acc[ai][bj][m][n]) : "v"(Bt##8[n]), "v"(At##8[m]), "v"(scw_), "v"(scx_)); } \
        __builtin_amdgcn_s_setprio(0); } while (0)
#define PG8_WAIT_V(n) asm volatile("s_waitcnt vmcnt(" #n ")" ::: "memory")
#define PG8_WAIT_L(n) asm volatile("s_waitcnt lgkmcnt(" #n ")" ::: "memory")
#define PG8_BAR __builtin_amdgcn_s_barrier()
#define PG8_SCHED __builtin_amdgcn_sched_barrier(0)
    Unit cur, nxt; int ui = 0;
    if (!S.next(0, cur)) return;
    f32x4 acc[2][2][4][2];
#pragma unroll
    for (int a = 0; a < 2; ++a)
#pragma unroll
        for (int b = 0; b < 2; ++b)
#pragma unroll
            for (int m = 0; m < 4; ++m)
#pragma unroll
                for (int n = 0; n < 2; ++n) acc[a][b][m][n] = (f32x4){0.f, 0.f, 0.f, 0.f};
    typedef int v4i_ __attribute__((ext_vector_type(4))); typedef int v8i_ __attribute__((ext_vector_type(8)));
    bf16x8 At[4][2], B0[2][2], B1[2][2]; v8i_ At8[4], B08[2], B18[2]; const int scw_ = SCW * 0x01010101, scx_ = SCX * 0x01010101;
    const char* cA = (const char*)g.A + (size_t)cur.pm * tstep; const char* cB = (const char*)g.Bt + (size_t)cur.pn * tstep;
    S.a_ready(cur);
    PG8_STAGE(PG8_SB(0, 0), cB, voffB); PG8_STAGE(PG8_SA(0, 0), cA, voffA); PG8_STAGE(PG8_SB(0, 1), cB + hstep, voffB); PG8_STAGE(PG8_SA(0, 1), cA + hstep, voffA);
    if (wr == 1) PG8_BAR;
    PG8_WAIT_V(4); PG8_BAR;
    PG8_STAGE(PG8_SB(1, 0), cB + kstep, voffB); PG8_STAGE(PG8_SA(1, 0), cA + kstep, voffA); PG8_STAGE(PG8_SB(1, 1), cB + hstep + kstep, voffB);
    PG8_WAIT_V(6); PG8_BAR;
    PG8_STAMP();
    for (;;) {
        const bool has_next = S.next(ui + 1, nxt);
        const char* nA = has_next ? (const char*)g.A + (size_t)nxt.pm * tstep : cA; const char* nB = has_next ? (const char*)g.Bt + (size_t)nxt.pn * tstep : cB;
        for (int t = 0; t < nt; t += 2) {
            const bool last = (t == nt - 2);
            const char* a1 = cA + (size_t)(t + 1) * kstep;
            const char* a2 = last ? nA : cA + (size_t)(t + 2) * kstep; const char* b2 = last ? nB : cB + (size_t)(t + 2) * kstep;
            const char* a3 = a2 + kstep; const char* b3 = b2 + kstep;
            if (last && has_next) S.a_ready(nxt);
            PG8_LDB(B0, 0, 0); PG8_SCHED; PG8_LDA(At, 0, 0); PG8_STAGE(PG8_SA(1, 1), a1 + hstep, voffA);
            PG8_WAIT_L(8); PG8_BAR; PG8_WAIT_L(0); PG8_MMA(0, 0, At, B0); PG8_BAR; PG8_SCHED;
            PG8_LDB(B1, 0, 1); PG8_STAGE(PG8_SB(0, 0), b2, voffB);
            PG8_BAR; PG8_WAIT_L(0); PG8_MMA(0, 1, At, B1); PG8_BAR;
            PG8_LDA(At, 0, 1); PG8_STAGE(PG8_SA(0, 0), a2, voffA);
            PG8_BAR; PG8_WAIT_L(0); PG8_MMA(1, 0, At, B0); PG8_BAR; PG8_SCHED;
            PG8_STAGE(PG8_SB(0, 1), b2 + hstep, voffB);
            PG8_WAIT_V(6); PG8_BAR; PG8_MMA(1, 1, At, B1); PG8_BAR;
            PG8_LDB(B0, 1, 0); PG8_SCHED; PG8_LDA(At, 1, 0); PG8_STAGE(PG8_SA(0, 1), a2 + hstep, voffA);
            PG8_WAIT_L(8); PG8_BAR; PG8_WAIT_L(0); PG8_MMA(0, 0, At, B0); PG8_BAR; PG8_SCHED;
            PG8_LDB(B1, 1, 1); PG8_STAGE(PG8_SB(1, 0), b3, voffB);
            PG8_BAR; PG8_WAIT_L(0); PG8_MMA(0, 1, At, B1); PG8_BAR;
            PG8_LDA(At, 1, 1); PG8_STAGE(PG8_SA(1, 0), a3, voffA);
            PG8_BAR; PG8_WAIT_L(0); PG8_MMA(1, 0, At, B0); PG8_BAR; PG8_SCHED;
            PG8_STAGE(PG8_SB(1, 1), b3 + hstep, voffB);
            PG8_WAIT_V(6); PG8_BAR; PG8_MMA(1, 1, At, B1); PG8_BAR;
        }
        PG8_STAMP();
        if constexpr (ES == 1) { asm volatile("s_nop 15\n\ts_nop 15\n\ts_nop 15" ::: "memory"); __builtin_amdgcn_sched_barrier(0); }
        if constexpr (!Epi::AFTER_DRAIN) { E(acc, cur, wr, wc, fr, fq); S.done(cur); }
        PG8_STAMP();
        if (!has_next) break;
#pragma unroll
        for (int a = 0; a < 2; ++a)
#pragma unroll
            for (int b = 0; b < 2; ++b)
#pragma unroll
                for (int m = 0; m < 4; ++m)
#pragma unroll
                    for (int n = 0; n < 2; ++n) acc[a][b][m][n] = (f32x4){0.f, 0.f, 0.f, 0.f};
        cur = nxt; cA = nA; cB = nB; ++ui;
    }
    PG8_WAIT_V(0);
    if (wr == 0) PG8_BAR;
    PG8_BAR;
    if constexpr (Epi::AFTER_DRAIN) { E.fused(acc, cur, wr, wc, fr, fq, lds, wid, lane); S.done(cur); }
    PG8_STAMP();
    if (STAMP && wid == 0) { stamps[lane] = lane < nts ? (((unsigned long long)(unsigned)ts_hi << 32) | (unsigned)ts_lo) : 0ull;
        if (lane == 62) stamps[62] = rt_entry; if (lane == 63) stamps[63] = (unsigned long long)wall_clock64(); }
#undef PG8_STAMP
#undef PG8_SA
#undef PG8_SB
#undef PG8_STAGE
#undef PG8_LDA
#undef PG8_LDB
#undef PG8_MMA
#undef PG8_WAIT_V
#undef PG8_WAIT_L
#undef PG8_BAR
#undef PG8_SCHED
}
}

#define XB_TMO      128
#define XB_XCNT(j)  (256  + 64 * (j))
#define XB_XSUB(j)  (1280 + 64 * (j))
#define XB_XGEN(j)  (2304 + 64 * (j))
#define XB_TOP      3328
#define XB_TOPGEN   3392
#define XCD_BAR_WORDS 3456
#define XB_SPIN_CAP (1u << 18)
__device__ __forceinline__ unsigned xb_ld(unsigned* p)              { return __hip_atomic_load(p, __ATOMIC_RELAXED, __HIP_MEMORY_SCOPE_AGENT); }
__device__ __forceinline__ unsigned xb_add(unsigned* p, unsigned v) { return __hip_atomic_fetch_add(p, v, __ATOMIC_RELAXED, __HIP_MEMORY_SCOPE_AGENT); }
__device__ __forceinline__ unsigned xb_xcc_id() { return (unsigned)__builtin_amdgcn_s_getreg((3 << 11) | 20) & 0xFu; }
#define XB_SPIN(cond, bar) do { unsigned _sp = 0; while (cond) { __builtin_amdgcn_s_sleep(1); \
    if ((++_sp & 255u) == 0u) { if (xb_ld(&(bar)[XB_TMO])) break; if (_sp > XB_SPIN_CAP) { atomicAdd(&(bar)[XB_TMO], 1u); break; } } } } while (0)
struct XcdBarrier { unsigned* bar; unsigned x; volatile LAS unsigned* st; };
__device__ __forceinline__ XcdBarrier xcd_barrier_post(unsigned* bar, volatile LAS unsigned* st) {
    XcdBarrier b; b.bar = bar; b.x = xb_xcc_id(); b.st = st;
    if (threadIdx.x == 0) (void)xb_add(&bar[XB_XCNT(b.x)], 1u);
    return b;
}
__device__ __forceinline__ void xcd_barrier_complete(unsigned* bar, unsigned x, unsigned& nloc, unsigned& nx) {
    const unsigned G = gridDim.x * gridDim.y * gridDim.z;
    unsigned sum, cnt, mine, sp = 0u;
    for (;;) {
        sum = 0u; cnt = 0u; mine = 0u;
#pragma unroll
        for (unsigned j = 0; j < 16; ++j) { const unsigned c = xb_ld(&bar[XB_XCNT(j)]); sum += c; cnt += (c > 0u) ? 1u : 0u; mine = (j == x) ? c : mine; }
        if (sum == G) break;
        __builtin_amdgcn_s_sleep(1);
        if ((++sp & 255u) == 0u) { if (xb_ld(&bar[XB_TMO])) break; if (sp > XB_SPIN_CAP) { atomicAdd(&bar[XB_TMO], 1u); break; } }
    }
    nloc = mine > 0u ? mine : 1u; nx = cnt > 0u ? cnt : 1u;
}
__device__ __forceinline__ void xcd_barrier(const XcdBarrier& b) {
    asm volatile("s_waitcnt vmcnt(0)" ::: "memory");
    __syncthreads();
    if (threadIdx.x == 0) {
        unsigned* bar = b.bar;
        __builtin_amdgcn_s_waitcnt(0);
        unsigned nloc = b.st[0], nx = b.st[1];
        if (nloc == 0u) { xcd_barrier_complete(bar, b.x, nloc, nx); b.st[0] = nloc; b.st[1] = nx; }
        const unsigned old = xb_add(&bar[XB_XSUB(b.x)], 1u);
        const unsigned gen = old / nloc;
        if (old + 1u == (gen + 1u) * nloc) {
            __builtin_amdgcn_fence(__ATOMIC_RELEASE, "agent");
            asm volatile("s_waitcnt vmcnt(0)" ::: "memory");
            const unsigned og = xb_add(&bar[XB_TOP], 1u);
            const unsigned tg = og / nx;
            if (og + 1u == (tg + 1u) * nx) xb_add(&bar[XB_TOPGEN], 1u);
            else XB_SPIN(xb_ld(&bar[XB_TOPGEN]) == tg, bar);
            __builtin_amdgcn_fence(__ATOMIC_ACQUIRE, "agent");
            xb_add(&bar[XB_XGEN(b.x)], 1u);
            asm volatile("s_waitcnt vmcnt(0)" ::: "memory");
        } else {
            XB_SPIN(xb_ld(&bar[XB_XGEN(b.x)]) == gen, bar);
            __builtin_amdgcn_fence(__ATOMIC_ACQUIRE, "agent");
            asm volatile("s_waitcnt vmcnt(0)" ::: "memory");
        }
    }
    __syncthreads();
}

struct Frame {
    LAS unsigned char* L; unsigned lb; int tid, lane, wave, bid, G; unsigned char* ws;
    DI Frame fresh() const { Frame f = *this; asm volatile("" : "+v"(f.tid), "+s"(f.wave), "+s"(f.bid), "+s"(f.lb), "+s"(f.G)); f.lane = f.tid & 63; f.L = (LAS unsigned char*)(uintptr_t)f.lb; return f; }
    DI float* modp() const { return (float*)(ws + WS_MODP); }
    DI float* mod() const { return (float*)(ws + WS_MOD); }
    DI float* rope() const { return (float*)(ws + WS_ROPE); }
    DI float* tokw() const { return (float*)(ws + WS_TOKW); }
    DI float* slotw() const { return (float*)(ws + WS_SLOTW); }
    DI float* gates() const { return (float*)(ws + WS_GATES); }
    DI float* mlg() const { return (float*)(ws + WS_MLG); }
    DI float* dt() const { return (float*)(ws + WS_DT); }
    DI float* decml() const { return (float*)(ws + WS_DECML); }
    DI float* decss() const { return (float*)(ws + WS_DECSS); }
    DI bf16_t* xbuf() const { return (bf16_t*)(ws + WS_XBUF); }
    DI bf16_t* stml() const { return (bf16_t*)(ws + WS_STML); }
    DI bf16_t* stss() const { return (bf16_t*)(ws + WS_STSS); }
    DI int* toke() const { return (int*)(ws + WS_TOKE); }
    DI int* tokr() const { return (int*)(ws + WS_TOKR); }
    DI int* toks() const { return (int*)(ws + WS_TOKS); }
    DI int* cnt() const { return (int*)(ws + WS_CNT); }
    DI int* mte() const { return (int*)(ws + WS_MTE); }
    DI bf16_t* rwt() const { return (bf16_t*)(ws + WS_RWT); }
    DI float* mvec() const { return (float*)(ws + WS_MVEC); }
    DI float* rstd() const { return (float*)(ws + WS_RSTD); }
    DI bf16_t* win() const { return (bf16_t*)(ws + WS_WIN); }
    DI bf16_t* wout() const { return (bf16_t*)(ws + WS_WOUT); }
    DI bf16_t* w13() const { return (bf16_t*)(ws + WS_W13); }
    DI bf16_t* w2() const { return (bf16_t*)(ws + WS_W2); }
    DI bf16_t* h() const { return (bf16_t*)(ws + WS_H); }
    DI bf16_t* proj() const { return (bf16_t*)(ws + WS_PROJ); }
    DI bf16_t* xbcc() const { return (bf16_t*)(ws + WS_XBCC); }
    DI bf16_t* mix() const { return (bf16_t*)(ws + WS_MIX); }
    DI bf16_t* amoe() const { return (bf16_t*)(ws + WS_AMOE); }
    DI bf16_t* hid() const { return (bf16_t*)(ws + WS_HID); }
    DI bf16_t* ymoe() const { return (bf16_t*)(ws + WS_YMOE); }
};

constexpr int NJ_ADA = 768, NJ_WIN = 2 * 27 * 32, NJ_WOUT = 2 * 8 * 32, NJ_W13 = 64 * 8 * 16, NJ_W2 = 64 * 8 * 8;
constexpr int NJ_TOTAL = NJ_ADA + 1 + NJ_WIN + NJ_WOUT + NJ_W13 + NJ_W2;
DI int win_col(int n) { return n < 5120 ? n : (n < 6656 ? n + 16 : (n < 6672 ? n - 1536 : (n < 6688 ? n : -1))); }

DI void phase_prologue(const Params& p, const Frame& F) {
    LAS float* TL = (LAS float*)F.L;
    for (int job = F.bid; job < (DBG(64) ? 0 : NJ_ADA); job += F.G) {
        __syncthreads();
        {
            const int l = job / 384, kq = (job / 48) & 7, cb = job % 48;
            LAS float* sl = TL; LAS float* sc = TL + 512; LAS float* red = TL + 1024;
            if (F.tid < 256) { const int k = kq * 256 + F.tid; const float a = p.c[k], b = p.c_ctx[k]; sl[F.tid] = siluf(a); sc[F.tid] = siluf(b); }
            __syncthreads();
            const int cg = F.tid & 63, ks = F.tid >> 6;
            f32x4 a0 = {0.f, 0.f, 0.f, 0.f}, a1 = {0.f, 0.f, 0.f, 0.f};
            const float* wp = p.w_mod + ((size_t)l * 2048 + kq * 256 + ks * 32) * 12288 + cb * 256 + cg * 4;
#pragma unroll 16
            for (int k = 0; k < 32; ++k) { const f32x4 w = *(const f32x4*)(wp + (size_t)k * 12288); a0 += sl[ks * 32 + k] * w; a1 += sc[ks * 32 + k] * w; }
            *(LAS f32x4*)(red + (ks * 2 + 0) * 256 + cg * 4) = a0; *(LAS f32x4*)(red + (ks * 2 + 1) * 256 + cg * 4) = a1;
            __syncthreads();
            { const int which = F.tid >> 8, col = F.tid & 255; float s = 0.f;
#pragma unroll
              for (int k8 = 0; k8 < 8; ++k8) s += red[(k8 * 2 + which) * 256 + col];
              F.modp()[((size_t)(l * 8 + kq) * 2 + which) * 12288 + cb * 256 + col] = s; }
        }
    }
    for (int i = F.bid * NTHR + F.tid; i < 320 * 32; i += F.G * NTHR) { const int pos = i >> 5, f = i & 31; const int pp = pos < 256 ? pos : pos - 256;
        const float inv = expf(-logf(10000.0f) * (float)f / 32.0f); float sn, cs; sincosf((float)pp * inv, &sn, &cs);
        F.rope()[(size_t)pos * 64 + f] = cs; F.rope()[(size_t)pos * 64 + 32 + f] = sn; }
    for (int i = F.bid * NTHR + F.tid; i < 2 * 36 * 2048; i += F.G * NTHR) { const int l = i / (36 * 2048), o = (i / 2048) % 36, k = i & 2047;
        F.rwt()[i] = f2bf(o < 4 ? p.rg_w[((size_t)l * 2048 + k) * 4 + o] : p.re_w[((size_t)l * 2048 + k) * 32 + (o - 4)]); }
    __syncthreads();
    const int lane = F.lane, w = F.wave, n4 = lane & 7, kr = lane >> 3;
    LAS unsigned char* WT = F.L + w * 4608;
    const int c4 = w * 32 + n4 * 4;
#pragma unroll 1
    for (int job = F.bid; job < (DBG(128) ? 0 : NJ_WIN + NJ_WOUT); job += F.G) {
        int j = job; int kind, K, ldS; const float* s0; bf16_t* dst; int n0, k0;
        if (j < NJ_WIN) { kind = 0; const int l = j / (27 * 32), r = j % (27 * 32); n0 = (r / 32) * 256; k0 = (r % 32) * 64; K = 2048; ldS = INC; s0 = p.w_in + (size_t)l * 2048 * INC; dst = F.win() + (size_t)l * NPAD * 2048; }
        else { j -= NJ_WIN; kind = 1; const int l = j / 256, r = j % 256; n0 = (r / 32) * 256; k0 = (r % 32) * 64; K = 2048; ldS = 2048; s0 = p.w_out + (size_t)l * 2048 * 2048 + n0; dst = F.wout() + (size_t)l * 2048 * 2048; }
        const float* sp;
        if (kind == 0) { const int sc = win_col(n0 + c4); sp = sc >= 0 ? s0 + (size_t)(k0 + 2 * kr) * ldS + sc : nullptr; }
        else sp = s0 + (size_t)(k0 + 2 * kr) * ldS + c4;
        f32x4 va[4], vb[4];
#pragma unroll
        for (int i = 0; i < 4; ++i) { va[i] = sp ? *(const f32x4*)(sp + (size_t)(16 * i) * ldS) : (f32x4){0.f, 0.f, 0.f, 0.f}; vb[i] = sp ? *(const f32x4*)(sp + (size_t)(16 * i + 1) * ldS) : (f32x4){0.f, 0.f, 0.f, 0.f}; }
#pragma unroll
        for (int i = 0; i < 4; ++i)
#pragma unroll
            for (int c = 0; c < 4; ++c) *(LAS unsigned*)(WT + (n4 * 4 + c) * 144 + (16 * i + 2 * kr) * 2) = pk2(va[i][c], vb[i][c]);
        __builtin_amdgcn_wave_barrier();
#pragma unroll
        for (int i = 0; i < 4; ++i) { const int ci = lane + 64 * i, n = ci >> 3, k8 = ci & 7;
            const u32x4 o = *(LAS u32x4*)(WT + n * 144 + k8 * 16);
            *(u32x4*)(dst + (size_t)(n0 + w * 32 + n) * K + k0 + k8 * 8) = o; }
        __builtin_amdgcn_wave_barrier();
    }
#pragma unroll 1
    for (int job = F.bid; job < NJ_W13 + NJ_W2; job += F.G) {
        int j = job; int K, ldS; const float* sp; unsigned char* dst; int n0, k0; float fs;
        if (j < NJ_W13) { const int le = j / 128, r = j % 128; const int jt = r / 16; n0 = jt * 256; k0 = (r % 16) * 128; K = 2048; ldS = 1024; fs = FS_W13;
            sp = (c4 < 128 ? p.w1 + (size_t)le * 2048 * 1024 + jt * 128 + c4 : p.w3 + (size_t)le * 2048 * 1024 + jt * 128 + (c4 - 128)) + (size_t)(k0 + 4 * kr) * ldS; dst = (unsigned char*)F.w13() + (size_t)le * 2048 * 2048; }
        else { j -= NJ_W13; const int le = j / 64, r = j % 64; n0 = (r / 8) * 256; k0 = (r % 8) * 128; K = 1024; ldS = 2048; fs = FS_W2;
            sp = p.w2 + (size_t)le * 1024 * 2048 + n0 + c4 + (size_t)(k0 + 4 * kr) * ldS; dst = (unsigned char*)F.w2() + (size_t)le * 2048 * 1024; }
        f32x4 v[4][4];
#pragma unroll
        for (int i = 0; i < 4; ++i)
#pragma unroll
            for (int r = 0; r < 4; ++r) v[i][r] = DBG(32) ? (f32x4){1.f, 2.f, 3.f, 4.f} : *(const f32x4*)(sp + (size_t)(32 * i + r) * ldS);
#pragma unroll
        for (int i = 0; i < 4; ++i)
#pragma unroll
            for (int c = 0; c < 4; ++c) *(LAS unsigned*)(WT + (n4 * 4 + c) * 144 + 32 * i + 4 * kr) = pk4_fp8(v[i][0][c] * fs, v[i][1][c] * fs, v[i][2][c] * fs, v[i][3][c] * fs);
        __builtin_amdgcn_wave_barrier();
#pragma unroll
        for (int i = 0; i < 4; ++i) { const int ci = lane + 64 * i, n = ci >> 3, k16 = ci & 7;
            const u32x4 o = *(LAS u32x4*)(WT + n * 144 + k16 * 16);
            if (!DBG(16)) *(u32x4*)(dst + (size_t)(n0 + w * 32 + n) * K + k0 + k16 * 16) = o; }
        __builtin_amdgcn_wave_barrier();
    }
}

DI float mod_from_partials(const Params& p, const Frame& F, int l, int which, int idx) {
    float s = p.b_mod[(size_t)l * 12288 + idx];
#pragma unroll
    for (int kq = 0; kq < 8; ++kq) s += F.modp()[((size_t)(l * 8 + kq) * 2 + which) * 12288 + idx];
    return s;
}

template <int MODE> DI void phase_rows(const Params& p, const Frame& F) {
    constexpr int l = MODE == 0 ? 0 : 1;
    LAS float* nw = (LAS float*)F.L; LAS float* scl = nw + 2048; LAS float* shf = scl + 4096; LAS float* g2v = shf + 4096;
    __syncthreads();
    for (int i = F.tid; i < 2048; i += NTHR) {
        nw[i] = MODE == 2 ? p.final_w[i] : p.norm1_w[l * 2048 + i];
        if (MODE != 2) { for (int w = 0; w < 2; ++w) { scl[w * 2048 + i] = 1.0f + mod_from_partials(p, F, l, w, 2048 + i); shf[w * 2048 + i] = mod_from_partials(p, F, l, w, i); } }
        if (MODE != 0) { for (int w = 0; w < 2; ++w) g2v[w * 2048 + i] = F.mod()[((size_t)(MODE - 1) * 2 + w) * 12288 + 5 * 2048 + i]; }
    }
    if (MODE != 2) {
        for (int i = F.bid * NTHR + F.tid; i < 2 * 12288; i += F.G * NTHR) F.mod()[(size_t)l * 2 * 12288 + i] = mod_from_partials(p, F, l, i / 12288, i % 12288);
        for (int i = F.bid * NTHR + F.tid; i < 2 * 2048; i += F.G * NTHR) F.mvec()[(size_t)l * 2 * 2048 + i] = p.norm2_w[l * 2048 + (i & 2047)] * (1.0f + mod_from_partials(p, F, l, i >> 11, 4 * 2048 + (i & 2047)));
    }
    __syncthreads();
    const int nrows = MODE == 2 ? T : NT;
    for (int row = F.bid * 8 + F.wave; row < nrows; row += F.G * 8) {
        const int w = row >= T ? 1 : 0;
        f32x4 v[8];
        if (MODE == 0) { const float* src = w ? p.ctx + (size_t)(row - T) * 2048 : p.x + (size_t)row * 2048;
#pragma unroll
            for (int j = 0; j < 8; ++j) v[j] = *(const f32x4*)(src + j * 256 + F.lane * 4); }
        else {
#pragma unroll
            for (int j = 0; j < 8; ++j) { const u32x2 q = *(const u32x2*)(F.xbuf() + (size_t)row * 2048 + j * 256 + F.lane * 4); v[j] = (f32x4){bflo(q.x), bfhi(q.x), bflo(q.y), bfhi(q.y)}; } }
        if (MODE != 0) {
            const int s0 = F.toks()[row * 2], s1 = F.toks()[row * 2 + 1];
            const unsigned char* y0 = (const unsigned char*)F.ymoe() + (size_t)s0 * 2048; const unsigned char* y1 = (const unsigned char*)F.ymoe() + (size_t)s1 * 2048;
#pragma unroll
            for (int j = 0; j < 8; ++j) { const int c = j * 256 + F.lane * 4; const f32x4 a = unpk4_fp8(*(const unsigned*)(y0 + c)), b = unpk4_fp8(*(const unsigned*)(y1 + c));
                const f32x4 g = *(LAS f32x4*)(g2v + w * 2048 + c) * (1.0f / FS_Y);
                v[j] += g * (a + b); }
            if (MODE == 1) {
#pragma unroll
                for (int j = 0; j < 8; ++j) { u32x2 q; q.x = pk2(v[j][0], v[j][1]); q.y = pk2(v[j][2], v[j][3]); *(u32x2*)(F.xbuf() + (size_t)row * 2048 + j * 256 + F.lane * 4) = q; }
            }
        }
        float ss = 0.f;
#pragma unroll
        for (int j = 0; j < 8; ++j) ss += v[j][0] * v[j][0] + v[j][1] * v[j][1] + v[j][2] * v[j][2] + v[j][3] * v[j][3];
        ss = wsum(ss);
        const float rstd = rsqrtf(ss * (1.0f / 2048.0f) + 1e-6f);
#pragma unroll
        for (int j = 0; j < 8; ++j) { const int c = j * 256 + F.lane * 4; const f32x4 nwv = *(LAS f32x4*)(nw + c);
            f32x4 o = v[j] * rstd * nwv;
            if (MODE == 2) *(f32x4*)(p.out + (size_t)row * 2048 + c) = o;
            else { o = o * *(LAS f32x4*)(scl + w * 2048 + c) + *(LAS f32x4*)(shf + w * 2048 + c);
                u32x2 pk; pk.x = pk2(o[0], o[1]); pk.y = pk2(o[2], o[3]); *(u32x2*)(F.h() + (size_t)row * 2048 + c) = pk; } }
    }
}

DI void phase_prep(const Params& p, const Frame& F, int l) {
    const int lane = F.lane;
#pragma unroll 2
    for (int row = F.bid * 8 + F.wave; row < NT; row += F.G * 8) {
        const bool lat = row < T;
        bf16_t* pr = F.proj() + (size_t)row * NPROJ;
        if (!DBG(8192))
#pragma unroll
        for (int j = 0; j < 2; ++j) {
            const int head = lane >> 4, half = (lane >> 3) & 1, i4 = (lane & 7) * 4;
            bf16_t* base = pr + (j ? MKO : MQO) + head * 128 + half * 64 + i4;
            const u32x2 a = *(const u32x2*)base, b = *(const u32x2*)(base + 32);
            float x1[4] = {bflo(a.x), bfhi(a.x), bflo(a.y), bfhi(a.y)}, x2[4] = {bflo(b.x), bfhi(b.x), bflo(b.y), bfhi(b.y)}, o1[4], o2[4];
            if (lat) { const int pos = half ? 256 + (row & 63) : (row >> 6); const f32x4 cs = *(const f32x4*)(F.rope() + (size_t)pos * 64 + i4), sn = *(const f32x4*)(F.rope() + (size_t)pos * 64 + 32 + i4);
#pragma unroll
                for (int e = 0; e < 4; ++e) { o1[e] = x1[e] * cs[e] - x2[e] * sn[e]; o2[e] = x1[e] * sn[e] + x2[e] * cs[e]; } }
            else {
#pragma unroll
                for (int e = 0; e < 4; ++e) { o1[e] = x1[e]; o2[e] = x2[e]; } }
            if (j) {
#pragma unroll
                for (int e = 0; e < 4; ++e) { o1[e] *= 0.08838834764831845f; o2[e] *= 0.08838834764831845f; } }
            u32x2 wa, wb; wa.x = pk2(o1[0], o1[1]); wa.y = pk2(o1[2], o1[3]); wb.x = pk2(o2[0], o2[1]); wb.y = pk2(o2[2], o2[3]);
            *(u32x2*)base = wa; *(u32x2*)(base + 32) = wb;
        }
        if (lane < 16) { float v = F.gates()[(size_t)row * 32 + lane] + p.ml_gate_b[l * 16 + lane];
            if ((lane >> 2) & 1) v = fminf(v, 0.f) - __logf(1.0f + __expf(-fabsf(v)));
            F.mlg()[(size_t)row * 16 + lane] = v; }
        else if (lane < 32) { const int idx = lane - 16; const float v = F.gates()[(size_t)row * 32 + lane] + p.dt_bias[l * 16 + idx];
            F.dt()[(size_t)row * 16 + idx] = fmaxf(v, 0.f) + __logf(1.0f + __expf(-fabsf(v))); }
    }
    if (!DBG(16384))
    for (int item = F.bid * 8 + F.wave; item < (T / 8) * 2 + CTXL * 2; item += F.G * 8) {
        const bool lat = item < (T / 8) * 2; const int ci = item - (T / 8) * 2;
        const int ch = ((item & 1) * 64 + lane) * 8, nr = lat ? 8 : 1;
        const int t0 = lat ? (item >> 1) * 8 : T + (ci >> 1); const int tl0 = lat ? t0 : t0 - T, nseq = lat ? T : CTXL, rb = lat ? 0 : T;
        float wgt[4][8], bia[8];
        { const f32x4 b0 = *(const f32x4*)(p.conv_b + l * 1024 + ch), b1 = *(const f32x4*)(p.conv_b + l * 1024 + ch + 4);
          bia[0] = b0[0]; bia[1] = b0[1]; bia[2] = b0[2]; bia[3] = b0[3]; bia[4] = b1[0]; bia[5] = b1[1]; bia[6] = b1[2]; bia[7] = b1[3]; }
#pragma unroll
        for (int tap = 0; tap < 4; ++tap) { const f32x4 w0 = *(const f32x4*)(p.conv_w + ((size_t)l * 4 + tap) * 1024 + ch), w1 = *(const f32x4*)(p.conv_w + ((size_t)l * 4 + tap) * 1024 + ch + 4);
            wgt[tap][0] = w0[0]; wgt[tap][1] = w0[1]; wgt[tap][2] = w0[2]; wgt[tap][3] = w0[3]; wgt[tap][4] = w1[0]; wgt[tap][5] = w1[1]; wgt[tap][6] = w1[2]; wgt[tap][7] = w1[3]; }
        u32x4 xr[11];
#pragma unroll
        for (int r = 0; r < 11; ++r) { const int tt = tl0 + r - 2; xr[r] = (tt >= 0 && tt < nseq && r < nr + 3) ? *(const u32x4*)(F.proj() + (size_t)(rb + tt) * NPROJ + XBO + ch) : (u32x4){0u, 0u, 0u, 0u}; }
#pragma unroll
        for (int r = 0; r < 8; ++r) { float acc[8];
#pragma unroll
            for (int e = 0; e < 8; ++e) acc[e] = bia[e];
#pragma unroll
            for (int tap = 0; tap < 4; ++tap) { float xv[8]; unpack8(xr[r + tap], xv);
#pragma unroll
                for (int e = 0; e < 8; ++e) acc[e] += wgt[tap][e] * xv[e]; }
#pragma unroll
            for (int e = 0; e < 8; ++e) acc[e] = siluf(acc[e]);
            if (r < nr) *(u32x4*)(F.xbcc() + (size_t)(t0 + r) * 1024 + ch) = __builtin_bit_cast(u32x4, pack8(acc)); }
    }
}

DI void na_block64(const Params& p, LAS unsigned char* L, unsigned lb, unsigned ktA, unsigned vtA, int kbA, bool actA, const LAS float* rpA,
                   unsigned ktB, unsigned vtB, int kbB, bool actB, const LAS float* rpB, bool masked, int qc, int cs, int lane,
                   const bf16x8 (&qf)[4], f32x4 (&o)[8], float& m_run, float& l_run) {
    constexpr unsigned PB = 272, PVB = 288; const int g = lane >> 4;
    f32x4 s0 = {0.f, 0.f, 0.f, 0.f}, s1 = s0, s2 = s0, s3 = s0;
    if (actA && !DBG(8)) {
#pragma unroll
        for (int ks = 0; ks < 4; ++ks) { s0 = mfma16(frag_row(L, ktA, PB, kbA, ks * 32, lane), qf[ks], s0); s1 = mfma16(frag_row(L, ktA, PB, kbA + 16, ks * 32, lane), qf[ks], s1); } }
    if (actB && !DBG(8)) {
#pragma unroll
        for (int ks = 0; ks < 4; ++ks) { s2 = mfma16(frag_row(L, ktB, PB, kbB, ks * 32, lane), qf[ks], s2); s3 = mfma16(frag_row(L, ktB, PB, kbB + 16, ks * 32, lane), qf[ks], s3); } }
    float sv[16];
#pragma unroll
    for (int e = 0; e < 4; ++e) { sv[e] = s0[e] * 0.08838834764831845f; sv[4 + e] = s1[e] * 0.08838834764831845f; sv[8 + e] = s2[e] * 0.08838834764831845f; sv[12 + e] = s3[e] * 0.08838834764831845f; }
    if (masked) {
#pragma unroll
        for (int e = 0; e < 8; ++e) { const int kc = kbA + (e < 4 ? 4 * g + e : 16 + 4 * g + (e - 4)); const bool valid = (unsigned)(kc - cs) < 16u; const int bi = valid ? kc - qc + 15 : 0;
            const float ba = actA ? rpA[bi] : 0.f, bb = actB ? rpB[bi] : 0.f;
            sv[e] = (valid && actA) ? sv[e] + ba : -INFINITY; sv[8 + e] = (valid && actB) ? sv[8 + e] + bb : -INFINITY; } }
    float mx = sv[0];
#pragma unroll
    for (int e = 1; e < 16; ++e) mx = fmaxf(mx, sv[e]);
    mx = fmaxf(mx, __shfl_xor(mx, 16)); mx = fmaxf(mx, __shfl_xor(mx, 32));
    const float m_new = fmaxf(m_run, mx), alpha = __expf(m_run - m_new);
    float pa[8], pb[8], ps = 0.f;
#pragma unroll
    for (int e = 0; e < 8; ++e) { pa[e] = __expf(sv[e] - m_new); pb[e] = __expf(sv[8 + e] - m_new); ps += pa[e] + pb[e]; }
    l_run = l_run * alpha + ps; m_run = m_new;
    const bf16x8 pfa = pack8(pa), pfb = pack8(pb);
#pragma unroll
    for (int i = 0; i < 8; ++i) o[i] *= alpha;
    if (actA && !DBG(4)) {
#pragma unroll
        for (int hf = 0; hf < 2; ++hf) { bf16x8 vf[4]; frag_tr_x4(vf, lb, vtA, PVB, kbA + 4 * g, kbA + 16 + 4 * g, hf * 64, lane);
#pragma unroll
            for (int i = 0; i < 4; ++i) o[hf * 4 + i] = mfma16(vf[i], pfa, o[hf * 4 + i]); } }
    if (actB && !DBG(4)) {
#pragma unroll
        for (int hf = 0; hf < 2; ++hf) { bf16x8 vf[4]; frag_tr_x4(vf, lb, vtB, PVB, kbB + 4 * g, kbB + 16 + 4 * g, hf * 64, lane);
#pragma unroll
            for (int i = 0; i < 4; ++i) o[hf * 4 + i] = mfma16(vf[i], pfb, o[hf * 4 + i]); } }
}
DI void na_task(const Params& p, const Frame& F, int l, int task) {
    constexpr unsigned BUF = 71680, TIL = 35840, RPB = 143360, PB = 272, PVB = 288;
    LAS unsigned char* L = F.L; const int lane = F.lane, g = lane >> 4, n = lane & 15;
    const bool isctx = task >= 1024;
    const int r0 = isctx ? 0 : (task >> 3) * 2, head = task & 7;
    const int rsel = F.wave >> 2, qt = F.wave & 3, rw = r0 + rsel;
    const int rsA = r0 - 4 < 0 ? 0 : (r0 - 4 > 248 ? 248 : r0 - 4), rsB = r0 - 3 < 0 ? 0 : (r0 - 3 > 248 ? 248 : r0 - 3);
    const int rsw = rsel ? rsB : rsA;
    const int nwin = isctx ? 0 : rsB + 8 - rsA, nwp = (nwin + 1) >> 1;
    const int qrow = isctx ? T + ((task - 1024) >> 3) * 128 + rsel * 64 : rw * 64;
    const bf16_t* proj = F.proj();
    bf16x8 qa[4];
#pragma unroll
    for (int ks = 0; ks < 4; ++ks) qa[ks] = *(const bf16x8*)(proj + (size_t)(qrow + qt * 16 + n) * NPROJ + QO + head * 128 + ks * 32 + g * 8);
    f32x4 oa[8];
#pragma unroll
    for (int i = 0; i < 8; ++i) oa[i] = (f32x4){0.f, 0.f, 0.f, 0.f};
    float ma = -INFINITY, la = 0.f;
    const int cb = qt == 0 ? 0 : (qt == 1 ? 8 : (qt == 2 ? 24 : 32));
    const int qc = qt * 16 + n, cs = qc - 8 < 0 ? 0 : (qc - 8 > 48 ? 48 : qc - 8);
    const int nsteps = nwp + 2;
    u32x4 pre[8];
    const bf16_t* gp = proj + (size_t)(F.tid >> 4) * NPROJ + KO + head * 128 + (F.tid & 15) * 8;
    const unsigned lp = (unsigned)(F.tid >> 4) * PB + (unsigned)(F.tid & 15) * 16u, lpv = 17408u + (unsigned)(F.tid >> 4) * PVB + (unsigned)(F.tid & 15) * 16u;
#define NA_TOK(step, t) ((step) < nwp ? (rsA + ((2 * (step) + (t)) < nwin ? 2 * (step) + (t) : 2 * (step))) * 64 : T + (2 * ((step) - nwp) + (t)) * 64)
#define NA_LOAD(step) do { const bf16_t* g0_ = gp + (size_t)NA_TOK(step, 0) * NPROJ; const bf16_t* g1_ = gp + (size_t)NA_TOK(step, 1) * NPROJ; _Pragma("unroll") for (int i = 0; i < 8; ++i) \
        pre[i] = *(const u32x4*)(((i >> 2) ? g1_ : g0_) + (size_t)((i & 1) * 32) * NPROJ + ((i >> 1) & 1) * 1024); } while (0)
#define NA_STORE(bufo) do { _Pragma("unroll") for (int i = 0; i < 8; ++i) *(LAS u32x4*)(L + (bufo) + (i >> 2) * TIL + (((i >> 1) & 1) ? lpv + (i & 1) * 32 * PVB : lp + (i & 1) * 32 * PB)) = pre[i]; } while (0)
    NA_LOAD(0);
    __syncthreads();
    if (!isctx) { LAS float* rp = (LAS float*)(L + RPB); for (int i = F.tid; i < 465; i += NTHR) rp[i] = p.na_rpb[((size_t)(l * 8 + head)) * 465 + i]; }
#pragma unroll 1
    for (int step = 0; step < nsteps; ++step) {
        const unsigned bufo = (step & 1) * BUF;
        NA_STORE(bufo);
        if (step + 1 < nsteps && !DBG(1)) NA_LOAD(step + 1);
        __syncthreads();
        if (DBG(2)) continue;
        unsigned t0 = bufo, t1 = bufo + TIL;
        asm volatile("" : "+v"(t0), "+v"(t1));
        if (step < nwp) { const int kr0 = rsA + 2 * step, kr1 = kr0 + 1;
            const bool a0 = kr0 >= rsw && kr0 < rsw + 8, a1 = (2 * step + 1 < nwin) && kr1 >= rsw && kr1 < rsw + 8;
            const LAS float* rpw = (const LAS float*)(L + RPB);
            if (a0 || a1) na_block64(p, L, F.lb, t0, t0 + 17408, cb, a0, rpw + (a0 ? kr0 - rw + 7 : 0) * 31, t1, t1 + 17408, cb, a1, rpw + (a1 ? kr1 - rw + 7 : 0) * 31, true, qc, cs, lane, qa, oa, ma, la);
        } else {
#pragma unroll 1
            for (int tt = 0; tt < 2; ++tt) { unsigned tb = tt ? t1 : t0; asm volatile("" : "+v"(tb));
                na_block64(p, L, F.lb, tb, tb + 17408, 0, true, nullptr, tb, tb + 17408, 32, true, nullptr, false, qc, cs, lane, qa, oa, ma, la); }
        }
    }
#undef NA_TOK
#undef NA_LOAD
#undef NA_STORE
    const float inva = 1.0f / gsum4(la);
#pragma unroll
    for (int dvt = 0; dvt < 8; ++dvt) { u32x2 w; w.x = pk2(oa[dvt][0] * inva, oa[dvt][1] * inva); w.y = pk2(oa[dvt][2] * inva, oa[dvt][3] * inva);
        *(u32x2*)(F.mix() + (size_t)(qrow + qt * 16 + n) * 2048 + head * 128 + dvt * 16 + 4 * g) = w; }
}

DI void ml_state_task(const Params& p, const Frame& F, int tc, int h) {
    constexpr unsigned KT = 0, VF = 17408, VB = 34816, WF = 52224, PB = 272;
    LAS unsigned char* L = F.L; const int lane = F.lane, g = lane >> 4, n = lane & 15;
    LAS float* Wt = (LAS float*)(L + WF);
    __syncthreads();
    if (F.wave < 2) { const int d = F.wave, tok = tc * 64 + lane;
        const float ig = F.mlg()[(size_t)tok * 16 + d * 8 + h], lf = F.mlg()[(size_t)tok * 16 + d * 8 + 4 + h];
        const float b = wscan(lf, d, lane); const float G = __shfl(b, d ? 0 : 63);
        Wt[d * 64 + lane] = __expf(G - b + ig);
        if (lane == 0) F.decml()[(d * 4 + h) * NCH + tc] = __expf(G); }
    __syncthreads();
#pragma unroll
    for (int i = 0; i < 2; ++i) { const int ci = F.tid + NTHR * i, row = ci >> 4, c16 = ci & 15; const size_t tok = (size_t)tc * 64 + row;
        const u32x4 kv = *(const u32x4*)(F.proj() + tok * NPROJ + MKO + h * 128 + c16 * 8);
        *(LAS u32x4*)(L + KT + row * PB + c16 * 16) = kv;
        float v[8], a[8], b[8]; unpack8(*(const u32x4*)(F.proj() + tok * NPROJ + MVO + h * 128 + c16 * 8), v);
        const float wf = Wt[row], wb = Wt[64 + row];
#pragma unroll
        for (int e = 0; e < 8; ++e) { a[e] = v[e] * wf; b[e] = v[e] * wb; }
        *(LAS bf16x8*)(L + VF + row * PB + c16 * 16) = pack8(a); *(LAS bf16x8*)(L + VB + row * PB + c16 * 16) = pack8(b); }
    __syncthreads();
    const int w = F.wave;
    const bf16x8 k0 = frag_tr(F.lb, KT, PB, 8 * g, 8 * g + 4, 16 * w, lane), k1 = frag_tr(F.lb, KT, PB, 32 + 8 * g, 32 + 8 * g + 4, 16 * w, lane);
#pragma unroll
    for (int d = 0; d < 2; ++d) { const unsigned vt = d ? VB : VF;
        bf16_t* dst = F.stml() + ((size_t)(d * 4 + h) * NCH + tc) * 16512;
#pragma unroll 1
        for (int jh = 0; jh < 2; ++jh) { bf16x8 y0[4], y1[4];
            frag_tr_x4(y0, F.lb, vt, PB, 8 * g, 8 * g + 4, 64 * jh, lane); frag_tr_x4(y1, F.lb, vt, PB, 32 + 8 * g, 32 + 8 * g + 4, 64 * jh, lane);
#pragma unroll
            for (int q = 0; q < 4; ++q) { f32x4 acc = {0.f, 0.f, 0.f, 0.f}; acc = mfma16(k0, y0[q], acc); acc = mfma16(k1, y1[q], acc);
                u32x2 pk; pk.x = pk2(acc[0], acc[1]); pk.y = pk2(acc[2], acc[3]);
                *(u32x2*)(dst + (size_t)(64 * jh + 16 * q + n) * 128 + 16 * w + 4 * g) = pk; } } }
    if (F.tid < 256) { const int d = F.tid >> 7, dk = F.tid & 127; float sacc = 0.f;
        for (int t = 0; t < 64; ++t) sacc += Wt[d * 64 + t] * bf2f(*(LAS bf16_t*)(L + KT + t * PB + dk * 2));
        F.stml()[((size_t)(d * 4 + h) * NCH + tc) * 16512 + 16384 + dk] = f2bf(sacc); }
}

DI void ml_out_task(const Params& p, const Frame& F, int l, int tc, int h) {
    constexpr unsigned QT = 0, KT = 17408, VT = 34816, CF = 54272, CB = 93440, GA = 132608, PB = 272, PV = 304;
    LAS unsigned char* L = F.L; const int lane = F.lane, g = lane >> 4, n = lane & 15;
    LAS float* Bg = (LAS float*)(L + GA);
    LAS float* Ig = Bg + 128;
    __syncthreads();
    if (F.wave < 2) { const int d = F.wave, tok = tc * 64 + lane;
        const float ig = F.mlg()[(size_t)tok * 16 + d * 8 + h], lf = F.mlg()[(size_t)tok * 16 + d * 8 + 4 + h];
        Bg[d * 64 + lane] = wscan(lf, d, lane); Ig[d * 64 + lane] = ig; }
    if (!DBG(256)) {
#pragma unroll
    for (int i = 0; i < 2; ++i) { const int ci = F.tid + NTHR * i, row = ci >> 4, c16 = ci & 15; const size_t tok = (size_t)tc * 64 + row;
        *(LAS u32x4*)(L + QT + row * PB + c16 * 16) = *(const u32x4*)(F.proj() + tok * NPROJ + MQO + h * 128 + c16 * 8);
        *(LAS u32x4*)(L + KT + row * PB + c16 * 16) = *(const u32x4*)(F.proj() + tok * NPROJ + MKO + h * 128 + c16 * 8);
        *(LAS u32x4*)(L + VT + row * PV + c16 * 16) = *(const u32x4*)(F.proj() + tok * NPROJ + MVO + h * 128 + c16 * 8); }
    if (F.tid < 128) { const int row = F.tid >> 1, hf = F.tid & 1; u32x4 v = {0u, 0u, 0u, 0u}; if (!hf) v.x = 0x3f80u; *(LAS u32x4*)(L + VT + row * PV + 256 + hf * 16) = v; }
#pragma unroll
    for (int d = 0; d < 2; ++d) { const bf16_t* src = F.stml() + ((size_t)(d * 4 + h) * NCH + tc) * 16512; const unsigned ct = d ? CB : CF;
        { u32x4 cv[5];
#pragma unroll
          for (int i = 0; i < 4; ++i) cv[i] = *(const u32x4*)(src + (size_t)(F.tid + NTHR * i) * 8);
          cv[4] = F.tid < 16 ? *(const u32x4*)(src + (size_t)(2048 + F.tid) * 8) : (u32x4){0u, 0u, 0u, 0u};
#pragma unroll
          for (int i = 0; i < 4; ++i) { const int ci = F.tid + NTHR * i; *(LAS u32x4*)(L + ct + (ci >> 4) * PB + (ci & 15) * 16) = cv[i]; }
          if (F.tid < 16) *(LAS u32x4*)(L + ct + 128 * PB + F.tid * 16) = cv[4]; }
        for (int i = F.tid; i < 15 * 17; i += NTHR) { const int row = 129 + i / 17, c = i % 17; *(LAS u32x4*)(L + ct + row * PB + c * 16) = (u32x4){0u, 0u, 0u, 0u}; } }
    }
    __syncthreads();
    if (DBG(512)) return;
    const int d = F.wave >> 2, qt = F.wave & 3;
    bf16x8 qf[4];
#pragma unroll
    for (int ks = 0; ks < 4; ++ks) qf[ks] = frag_row(L, QT, PB, 16 * qt, 32 * ks, lane);
    const int t = 16 * qt + n; const float bt = Bg[d * 64 + t];
    float wv[4][4];
    { f32x4 sa[4];
#pragma unroll
      for (int st = 0; st < 4; ++st) sa[st] = (f32x4){0.f, 0.f, 0.f, 0.f};
#pragma unroll
      for (int ks = 0; ks < 4; ++ks)
#pragma unroll
        for (int st = 0; st < 4; ++st) sa[st] = mfma16(frag_row(L, KT, PB, 16 * st, 32 * ks, lane), qf[ks], sa[st]);
#pragma unroll
      for (int st = 0; st < 4; ++st) { const f32x4 bs = *(LAS f32x4*)(Bg + d * 64 + 16 * st + 4 * g), is = *(LAS f32x4*)(Ig + d * 64 + 16 * st + 4 * g);
#pragma unroll
        for (int e = 0; e < 4; ++e) { const int s = 16 * st + 4 * g + e; const bool valid = d ? (s >= t) : (s <= t);
            wv[st][e] = valid ? sa[st][e] * __expf(bt - bs[e] + is[e]) : 0.f; } } }
    f32x4 num[9];
#pragma unroll
    for (int it = 0; it < 9; ++it) num[it] = (f32x4){0.f, 0.f, 0.f, 0.f};
#pragma unroll
    for (int kk = 0; kk < 2; ++kk) {
        const bool need = d ? (2 * kk + 1 >= qt) : (2 * kk <= qt);
        if (need) { float pv[8];
#pragma unroll
            for (int e = 0; e < 4; ++e) { pv[e] = wv[2 * kk][e]; pv[4 + e] = wv[2 * kk + 1][e]; }
            const bf16x8 pf = pack8(pv);
#pragma unroll
            for (int hf = 0; hf < 2; ++hf) { bf16x8 vf[4]; frag_tr_x4(vf, F.lb, VT, PV, 32 * kk + 4 * g, 32 * kk + 16 + 4 * g, 64 * hf, lane);
#pragma unroll
                for (int q = 0; q < 4; ++q) num[hf * 4 + q] = mfma16(vf[q], pf, num[hf * 4 + q]); }
            num[8] = mfma16(frag_tr(F.lb, VT, PV, 32 * kk + 4 * g, 32 * kk + 16 + 4 * g, 128, lane), pf, num[8]); }
    }
    const unsigned ct = d ? CB : CF; const float eb = __expf(bt);
    { f32x4 ia[9];
#pragma unroll
      for (int it = 0; it < 9; ++it) ia[it] = (f32x4){0.f, 0.f, 0.f, 0.f};
#pragma unroll
      for (int ks = 0; ks < 4; ++ks)
#pragma unroll
        for (int it = 0; it < 9; ++it) ia[it] = mfma16(frag_row(L, ct, PB, 16 * it, 32 * ks, lane), qf[ks], ia[it]);
#pragma unroll
      for (int it = 0; it < 9; ++it) num[it] += eb * ia[it]; }
    const float den = __shfl(num[8][0], n);
    const float dn = 1.0f / fmaxf(fabsf(den), 1.0f);
#pragma unroll
    for (int it = 0; it < 8; ++it) num[it] *= dn;
    __syncthreads();
    LAS float* HX = (LAS float*)(L + CF);
    if (d == 1) {
#pragma unroll
        for (int it = 0; it < 8; ++it) *(LAS f32x4*)(HX + t * 132 + 16 * it + 4 * g) = num[it]; }
    __syncthreads();
    if (d == 0 && (l == 0 || tc < 256)) {
        float sm = 0.f;
#pragma unroll
        for (int it = 0; it < 8; ++it) { num[it] += *(LAS f32x4*)(HX + t * 132 + 16 * it + 4 * g); sm += num[it][0] + num[it][1] + num[it][2] + num[it][3]; }
        const float mean = gsum4(sm) * (1.0f / 128.0f); float vs = 0.f;
#pragma unroll
        for (int it = 0; it < 8; ++it) { num[it] -= mean; vs += num[it][0] * num[it][0] + num[it][1] * num[it][1] + num[it][2] * num[it][2] + num[it][3] * num[it][3]; }
        const float rstd = rsqrtf(gsum4(vs) * (1.0f / 128.0f) + 1e-6f);
        const size_t tok = (size_t)tc * 64 + t;
#pragma unroll
        for (int it = 0; it < 8; ++it) { const int c = h * 128 + 16 * it + 4 * g;
            const u32x2 mo = *(const u32x2*)(F.proj() + tok * NPROJ + MOO + c); const f32x4 nwv = *(const f32x4*)(p.ml_norm_w + l * 512 + c);
            const float o0 = num[it][0] * rstd * nwv[0] * sigmf(bflo(mo.x)), o1 = num[it][1] * rstd * nwv[1] * sigmf(bfhi(mo.x));
            const float o2 = num[it][2] * rstd * nwv[2] * sigmf(bflo(mo.y)), o3 = num[it][3] * rstd * nwv[3] * sigmf(bfhi(mo.y));
            u32x2 w; w.x = pk2(o0, o1); w.y = pk2(o2, o3); *(u32x2*)(F.mix() + tok * 2048 + 1024 + c) = w; }
    }
}

DI void ss_state_task(const Params& p, const Frame& F, int l, int tc, int gi) {
    constexpr unsigned BT = 0, XS = 17408, WA = 91136, PB = 272, PX = 144;
    LAS unsigned char* L = F.L; const int lane = F.lane, g = lane >> 4, n = lane & 15, w = F.wave;
    LAS float* Wt = (LAS float*)(L + WA);
    const int hl = w & 3, d = w >> 2, hh = gi * 4 + hl;
    __syncthreads();
    { const int tok = tc * 64 + lane; const float dt = F.dt()[(size_t)tok * 16 + d * 8 + hh], a = -__expf(p.a_log[(l * 2 + d) * 8 + hh]);
      const float la = wscan(dt * a, d, lane); const float G = __shfl(la, d ? 0 : 63);
      Wt[w * 64 + lane] = __expf(G - la) * dt;
      if (lane == 0) F.decss()[(d * 8 + hh) * NCH + tc] = __expf(G); }
    __syncthreads();
#pragma unroll
    for (int i = 0; i < 2; ++i) { const int ci = F.tid + NTHR * i, row = ci >> 4, c16 = ci & 15;
        *(LAS u32x4*)(L + BT + row * PB + c16 * 16) = *(const u32x4*)(F.xbcc() + ((size_t)tc * 64 + row) * 1024 + 512 + gi * 128 + c16 * 8); }
#pragma unroll
    for (int i = 0; i < 8; ++i) { const int ci = F.tid + NTHR * i, ww = ci >> 9, row = (ci >> 3) & 63, c8 = ci & 7; float v[8];
        unpack8(*(const u32x4*)(F.xbcc() + ((size_t)tc * 64 + row) * 1024 + (gi * 4 + (ww & 3)) * 64 + c8 * 8), v);
        const float ws = Wt[ww * 64 + row];
#pragma unroll
        for (int e = 0; e < 8; ++e) v[e] *= ws;
        *(LAS bf16x8*)(L + XS + ww * 9216 + row * PX + c8 * 16) = pack8(v); }
    __syncthreads();
    bf16_t* dst = F.stss() + ((size_t)(d * 8 + hh) * NCH + tc) * 8192;
    const unsigned xt = XS + w * 9216;
    bf16x8 x0[4], x1[4];
    frag_tr_x4(x0, F.lb, xt, PX, 8 * g, 8 * g + 4, 0, lane); frag_tr_x4(x1, F.lb, xt, PX, 32 + 8 * g, 32 + 8 * g + 4, 0, lane);
#pragma unroll 1
    for (int ih = 0; ih < 2; ++ih) { bf16x8 b0[4], b1[4];
        frag_tr_x4(b0, F.lb, BT, PB, 8 * g, 8 * g + 4, 64 * ih, lane); frag_tr_x4(b1, F.lb, BT, PB, 32 + 8 * g, 32 + 8 * g + 4, 64 * ih, lane);
#pragma unroll
        for (int q = 0; q < 4; ++q)
#pragma unroll
            for (int jt = 0; jt < 4; ++jt) { f32x4 acc = {0.f, 0.f, 0.f, 0.f}; acc = mfma16(b0[q], x0[jt], acc); acc = mfma16(b1[q], x1[jt], acc);
                u32x2 pk; pk.x = pk2(acc[0], acc[1]); pk.y = pk2(acc[2], acc[3]);
                *(u32x2*)(dst + (size_t)(16 * jt + n) * 128 + 64 * ih + 16 * q + 4 * g) = pk; } }
}

DI void ss_out_task(const Params& p, const Frame& F, int l, int tc, int gi) {
    constexpr unsigned CT = 0, BT = 17408, XT = 34816, SS = 68608, LA = 138240, DS = 140288, SQ = 142336, PB = 272, PX = 528;
    LAS unsigned char* L = F.L; const int lane = F.lane, g = lane >> 4, n = lane & 15, w = F.wave;
    LAS float* La = (LAS float*)(L + LA); LAS float* Dt = (LAS float*)(L + DS); LAS float* Sq = (LAS float*)(L + SQ);
    __syncthreads();
    { const int hl = w & 3, d = w >> 2, hh = gi * 4 + hl; const int tok = tc * 64 + lane;
      const float dt = F.dt()[(size_t)tok * 16 + d * 8 + hh], a = -__expf(p.a_log[(l * 2 + d) * 8 + hh]);
      La[w * 64 + lane] = wscan(dt * a, d, lane); Dt[w * 64 + lane] = dt; }
#pragma unroll
    for (int i = 0; i < 2; ++i) { const int ci = F.tid + NTHR * i, row = ci >> 4, c16 = ci & 15; const size_t tok = (size_t)tc * 64 + row;
        *(LAS u32x4*)(L + CT + row * PB + c16 * 16) = *(const u32x4*)(F.xbcc() + tok * 1024 + 768 + gi * 128 + c16 * 8);
        *(LAS u32x4*)(L + BT + row * PB + c16 * 16) = *(const u32x4*)(F.xbcc() + tok * 1024 + 512 + gi * 128 + c16 * 8); }
#pragma unroll
    for (int i = 0; i < 4; ++i) { const int ci = F.tid + NTHR * i, row = ci >> 5, c32 = ci & 31;
        *(LAS u32x4*)(L + XT + row * PX + c32 * 16) = *(const u32x4*)(F.xbcc() + ((size_t)tc * 64 + row) * 1024 + gi * 256 + c32 * 8); }
    __syncthreads();
    const int qt = w & 3, hp2 = w >> 2, t = 16 * qt + n;
    bf16x8 cf[4];
#pragma unroll
    for (int ks = 0; ks < 4; ++ks) cf[ks] = frag_row(L, CT, PB, 16 * qt, 32 * ks, lane);
    f32x4 ga[4];
#pragma unroll
    for (int st = 0; st < 4; ++st) ga[st] = (f32x4){0.f, 0.f, 0.f, 0.f};
#pragma unroll
    for (int ks = 0; ks < 4; ++ks)
#pragma unroll
        for (int st = 0; st < 4; ++st) ga[st] = mfma16(frag_row(L, BT, PB, 16 * st, 32 * ks, lane), cf[ks], ga[st]);
    f32x4 y[2][4];
#pragma unroll
    for (int a = 0; a < 2; ++a)
#pragma unroll
        for (int it = 0; it < 4; ++it) y[a][it] = (f32x4){0.f, 0.f, 0.f, 0.f};
#pragma unroll 1
    for (int d = 0; d < 2; ++d) {
        __syncthreads();
        { u32x4 sv[8];
#pragma unroll
          for (int i = 0; i < 8; ++i) { const int ci = F.tid + NTHR * i, hl = ci >> 10, r = ci & 1023; sv[i] = *(const u32x4*)(F.stss() + ((size_t)(d * 8 + gi * 4 + hl) * NCH + tc) * 8192 + (size_t)r * 8); }
#pragma unroll
          for (int i = 0; i < 8; ++i) { const int ci = F.tid + NTHR * i, hl = ci >> 10, r = ci & 1023; *(LAS u32x4*)(L + SS + hl * 17408 + (r >> 4) * PB + (r & 15) * 16) = sv[i]; } }
        __syncthreads();
#pragma unroll
        for (int a = 0; a < 2; ++a) { const int hl = 2 * hp2 + a, wi = d * 4 + hl; const float lat = La[wi * 64 + t];
            float wv[4][4];
#pragma unroll
            for (int st = 0; st < 4; ++st) { const f32x4 ls = *(LAS f32x4*)(La + wi * 64 + 16 * st + 4 * g), ds = *(LAS f32x4*)(Dt + wi * 64 + 16 * st + 4 * g);
#pragma unroll
                for (int e = 0; e < 4; ++e) { const int s = 16 * st + 4 * g + e; const bool valid = d ? (s >= t) : (s <= t);
                    wv[st][e] = valid ? ga[st][e] * __expf(lat - ls[e]) * ds[e] : 0.f; } }
            const float el = __expf(lat);
            { f32x4 ia[4];
#pragma unroll
              for (int it = 0; it < 4; ++it) ia[it] = (f32x4){0.f, 0.f, 0.f, 0.f};
#pragma unroll
              for (int ks = 0; ks < 4; ++ks)
#pragma unroll
                for (int it = 0; it < 4; ++it) ia[it] = mfma16(frag_row(L, SS + hl * 17408, PB, 16 * it, 32 * ks, lane), cf[ks], ia[it]);
#pragma unroll
              for (int it = 0; it < 4; ++it) y[a][it] += el * ia[it]; }
#pragma unroll
            for (int kk = 0; kk < 2; ++kk) { float pv[8];
#pragma unroll
                for (int e = 0; e < 4; ++e) { pv[e] = wv[2 * kk][e]; pv[4 + e] = wv[2 * kk + 1][e]; }
                const bf16x8 pf = pack8(pv);
                bf16x8 xf[4]; frag_tr_x4(xf, F.lb, XT, PX, 32 * kk + 4 * g, 32 * kk + 16 + 4 * g, hl * 64, lane);
#pragma unroll
                for (int it = 0; it < 4; ++it) y[a][it] = mfma16(xf[it], pf, y[a][it]); }
        }
    }
    const size_t tok = (size_t)tc * 64 + t; float ssq = 0.f;
#pragma unroll
    for (int a = 0; a < 2; ++a) { const int hl = 2 * hp2 + a, hh = gi * 4 + hl; const float dsk = p.ssm_d[l * 8 + hh];
#pragma unroll
        for (int it = 0; it < 4; ++it) { const int pi = 16 * it + 4 * g;
            const u32x2 xv = *(LAS u32x2*)(L + XT + t * PX + (hl * 64 + pi) * 2); const u32x2 zv = *(const u32x2*)(F.proj() + tok * NPROJ + ZO + hh * 64 + pi);
            f32x4 v = y[a][it];
            v[0] = (v[0] + dsk * bflo(xv.x)) * siluf(bflo(zv.x)); v[1] = (v[1] + dsk * bfhi(xv.x)) * siluf(bfhi(zv.x));
            v[2] = (v[2] + dsk * bflo(xv.y)) * siluf(bflo(zv.y)); v[3] = (v[3] + dsk * bfhi(xv.y)) * siluf(bfhi(zv.y));
            y[a][it] = v; ssq += v[0] * v[0] + v[1] * v[1] + v[2] * v[2] + v[3] * v[3]; } }
    ssq = gsum4(ssq);
    if (g == 0) Sq[hp2 * 64 + t] = ssq;
    __syncthreads();
    if (l == 0 || tc < 256) {
        const float rstd = rsqrtf((Sq[t] + Sq[64 + t]) * (1.0f / 256.0f) + 1e-6f);
#pragma unroll
        for (int a = 0; a < 2; ++a) { const int hh = gi * 4 + 2 * hp2 + a;
#pragma unroll
            for (int it = 0; it < 4; ++it) { const int c = hh * 64 + 16 * it + 4 * g; const f32x4 nwv = *(const f32x4*)(p.ssm_norm_w + l * 512 + c); const f32x4 v = y[a][it] * rstd * nwv;
                u32x2 wq; wq.x = pk2(v[0], v[1]); wq.y = pk2(v[2], v[3]); *(u32x2*)(F.mix() + tok * 2048 + 1536 + c) = wq; } }
    }
}

DI void phase_scan(const Frame& F) {
    int item;
    if (F.tid < 128) item = F.bid * 128 + F.tid; else if (F.tid == 128 && F.bid < 128) item = 32768 + F.bid; else return;
    bf16_t* base; const float* dec; int d; size_t stride;
    if (item < 16512) { const int ch = item / 2064, e = item % 2064; base = F.stml() + (size_t)ch * NCH * 16512 + e * 8; dec = F.decml() + ch * NCH; d = ch >> 2; stride = 16512; }
    else { const int it2 = item - 16512, ch = it2 >> 10, e = it2 & 1023; base = F.stss() + (size_t)ch * NCH * 8192 + e * 8; dec = F.decss() + ch * NCH; d = ch >> 3; stride = 8192; }
    float s[8];
#pragma unroll
    for (int e = 0; e < 8; ++e) s[e] = 0.f;
#pragma unroll 1
    for (int p0 = 0; p0 < NCH; p0 += 13) {
        u32x4 tmp[13]; float dc[13]; int tcs[13];
#pragma unroll
        for (int j = 0; j < 13; ++j) { const int pp = p0 + j; const int tc = d ? 259 - pp : (pp < 4 ? 256 + pp : pp - 4); tcs[j] = tc;
            tmp[j] = *(const u32x4*)(base + (size_t)tc * stride); dc[j] = dec[tc]; }
#pragma unroll
        for (int j = 0; j < 13; ++j) { *(u32x4*)(base + (size_t)tcs[j] * stride) = __builtin_bit_cast(u32x4, pack8(s)); float t[8]; unpack8(tmp[j], t);
#pragma unroll
            for (int e = 0; e < 8; ++e) s[e] = dc[j] * s[e] + t[e]; }
    }
}

DI void phase_route(const Params& p, const Frame& F, int l) {
    constexpr unsigned RP = 4112, LC = 36 * RP, MVO = LC + 128, CRO = MVO + 4096;
    LAS unsigned char* L = F.L; const int lane = F.lane, g = lane >> 4, n = lane & 15;
    LAS int* lcnt = (LAS int*)(L + LC); LAS bf16_t* MV = (LAS bf16_t*)(L + MVO); LAS float* CR = (LAS float*)(L + CRO);
    __syncthreads();
    { const bf16_t* rw = F.rwt() + (size_t)l * 36 * 2048;
      for (int ci = F.tid; ci < 36 * 256; ci += NTHR) { const int row = ci >> 8, c16 = ci & 255; *(LAS u32x4*)(L + row * RP + c16 * 16) = *(const u32x4*)(rw + row * 2048 + c16 * 8); } }
    if (F.tid < 32) lcnt[F.tid] = 0;
    for (int i = F.tid; i < 2048; i += NTHR) MV[i] = f2bf(F.mvec()[(size_t)(l * 2) * 2048 + i]);
    __syncthreads();
    for (int idx = F.wave; idx < 72; idx += 8) { const int which = idx / 36, o = idx % 36; const float* sh = F.mod() + ((size_t)l * 2 + which) * 12288 + 3 * 2048; float s = 0.f;
#pragma unroll
        for (int jj = 0; jj < 4; ++jj) { const int c16 = lane + 64 * jj; float wv[8]; unpack8(*(LAS u32x4*)(L + o * RP + c16 * 16), wv);
            const f32x4 s0 = *(const f32x4*)(sh + c16 * 8), s1 = *(const f32x4*)(sh + c16 * 8 + 4);
            s += wv[0] * s0[0] + wv[1] * s0[1] + wv[2] * s0[2] + wv[3] * s0[3] + wv[4] * s1[0] + wv[5] * s1[1] + wv[6] * s1[2] + wv[7] * s1[3]; }
        s = wsum(s); if (lane == 0) CR[idx] = s; }
    __syncthreads();
    const int nrows = l == 0 ? NT : T;
    const int r0 = (F.wave * F.G + F.bid) * 16;
    if (r0 < nrows) {
        const int which = r0 >= T ? 1 : 0;
        f32x4 acc[3];
#pragma unroll
        for (int nt = 0; nt < 3; ++nt) acc[nt] = (f32x4){0.f, 0.f, 0.f, 0.f};
        float ssq = 0.f;
        const bf16_t* ap = F.xbuf() + (size_t)(r0 + n) * 2048 + 8 * g;
        const float* mg = F.mvec() + ((size_t)l * 2 + 1) * 2048 + 8 * g;
        const unsigned bo0 = (unsigned)n * RP + 16u * g, bo1 = (unsigned)(16 + n) * RP + 16u * g, bo2 = (unsigned)(32 + n > 35 ? 35 : 32 + n) * RP + 16u * g;
#pragma unroll 8
        for (int ks = 0; ks < 64; ++ks) { float xv[8], mv[8]; unpack8(*(const u32x4*)(ap + ks * 32), xv);
            if (which) { const f32x4 m0 = *(const f32x4*)(mg + ks * 32), m1 = *(const f32x4*)(mg + ks * 32 + 4); mv[0] = m0[0]; mv[1] = m0[1]; mv[2] = m0[2]; mv[3] = m0[3]; mv[4] = m1[0]; mv[5] = m1[1]; mv[6] = m1[2]; mv[7] = m1[3]; }
            else unpack8(*(LAS u32x4*)(MV + ks * 32 + 8 * g), mv);
#pragma unroll
            for (int e = 0; e < 8; ++e) { ssq += xv[e] * xv[e]; xv[e] *= mv[e]; }
            const bf16x8 a = pack8(xv);
            acc[0] = mfma16(*(LAS bf16x8*)(L + bo0 + ks * 64), a, acc[0]); acc[1] = mfma16(*(LAS bf16x8*)(L + bo1 + ks * 64), a, acc[1]); acc[2] = mfma16(*(LAS bf16x8*)(L + bo2 + ks * 64), a, acc[2]); }
        const float rstd = rsqrtf(gsum4(ssq) * (1.0f / 2048.0f) + 1e-6f);
        const LAS float* cr = CR + which * 36;
        float gl[4];
#pragma unroll
        for (int r = 0; r < 4; ++r) gl[r] = rstd * __shfl(acc[0][r], n) + cr[r] + p.rg_b[l * 4 + r];
        int gs = 0; float gm = gl[0];
#pragma unroll
        for (int o = 1; o < 4; ++o) { if (gl[o] > gm) { gm = gl[o]; gs = o; } }
        float gden = 0.f;
#pragma unroll
        for (int o = 0; o < 4; ++o) gden += __expf(gl[o] - gm);
        const float gw = 1.0f / gden;
        float le[8];
#pragma unroll
        for (int i = 0; i < 8; ++i) { const int o = 4 + 8 * gs + i, nt = o >> 4, src = n + 16 * ((o >> 2) & 3);
            const float t0 = __shfl(acc[0][i & 3], src), t1 = __shfl(acc[1][i & 3], src), t2 = __shfl(acc[2][i & 3], src);
            le[i] = rstd * (nt == 0 ? t0 : (nt == 1 ? t1 : t2)) + cr[o] + p.re_b[l * 32 + gs * 8 + i]; }
        int i1 = 0; float v1 = le[0];
#pragma unroll
        for (int i = 1; i < 8; ++i) if (le[i] > v1) { v1 = le[i]; i1 = i; }
        int i2 = -1; float v2 = -INFINITY;
#pragma unroll
        for (int i = 0; i < 8; ++i) if (i != i1 && le[i] > v2) { v2 = le[i]; i2 = i; }
        const float w1 = 1.0f / (1.0f + __expf(v2 - v1)), w2 = 1.0f - w1;
        if (g == 0) { const int row = r0 + n, e1 = gs * 8 + i1, e2 = gs * 8 + i2;
            const int r1 = atomicAdd((int*)(lcnt + e1), 1), r2 = atomicAdd((int*)(lcnt + e2), 1);
            F.toke()[row * 2] = e1; F.toke()[row * 2 + 1] = e2; F.tokw()[row * 2] = w1 * gw; F.tokw()[row * 2 + 1] = w2 * gw; F.tokr()[row * 2] = r1; F.tokr()[row * 2 + 1] = r2;
            F.rstd()[row] = rstd; }
    }
    __syncthreads();
    if (F.tid < 32) F.cnt()[F.bid * 32 + F.tid] = lcnt[F.tid];
}

DI void phase_slot(const Params& p, const Frame& F, int l) {
    LAS int* tot = (LAS int*)F.L; LAS int* pre = tot + 32; LAS int* pst = tot + 64; LAS int* pend = tot + 96; LAS int* part = tot + 128;
    __syncthreads();
    { const int e = F.tid & 31, pt = F.tid >> 5; int t = 0, pr = 0;
#pragma unroll 4
      for (int b = pt * 16; b < pt * 16 + 16; ++b) { const int c = F.cnt()[b * 32 + e]; t += c; pr += (b < F.bid) ? c : 0; }
      part[(pt * 2) * 32 + e] = t; part[(pt * 2 + 1) * 32 + e] = pr; }
    __syncthreads();
    if (F.tid < 32) { int t = 0, pr = 0; for (int pt = 0; pt < 16; ++pt) { t += part[(pt * 2) * 32 + F.tid]; pr += part[(pt * 2 + 1) * 32 + F.tid]; } tot[F.tid] = t; pre[F.tid] = pr; }
    __syncthreads();
    if (F.tid == 0) { int acc = 0; for (int e = 0; e < 32; ++e) { pst[e] = acc; acc += (tot[e] + 255) & ~255; pend[e] = acc; } }
    __syncthreads();
    if (F.bid == 0 && F.tid == 0) { int idx = 0; for (int e = 0; e < 32; ++e) { const int nt = (pend[e] - pst[e]) >> 8; for (int k = 0; k < nt; ++k) F.mte()[idx++] = e; } F.mte()[MAXMT] = idx; }
    const int nrows = l == 0 ? NT : T;
    const int r0 = (F.wave * F.G + F.bid) * 16;
    if (r0 < nrows) {
        const int which = r0 >= T ? 1 : 0;
        const float* mp = F.mvec() + ((size_t)l * 2 + which) * 2048; const float* sp = F.mod() + ((size_t)l * 2 + which) * 12288 + 3 * 2048;
        float mv[2][16], sv[2][16];
#pragma unroll
        for (int j = 0; j < 2; ++j)
#pragma unroll
            for (int q = 0; q < 4; ++q) { const f32x4 a = *(const f32x4*)(mp + j * 1024 + F.lane * 16 + q * 4), b = *(const f32x4*)(sp + j * 1024 + F.lane * 16 + q * 4);
#pragma unroll
                for (int e = 0; e < 4; ++e) { mv[j][q * 4 + e] = a[e] * FS_X; sv[j][q * 4 + e] = b[e] * FS_X; } }
#pragma unroll 2
        for (int rr = 0; rr < 16; ++rr) { const int row = r0 + rr;
            const int e1 = F.toke()[row * 2], e2 = F.toke()[row * 2 + 1];
            const int s1 = pst[e1] + pre[e1] + F.tokr()[row * 2], s2 = pst[e2] + pre[e2] + F.tokr()[row * 2 + 1];
            const float rs = F.rstd()[row];
            if (F.lane == 0) { F.toks()[row * 2] = s1; F.toks()[row * 2 + 1] = s2; F.slotw()[s1] = F.tokw()[row * 2]; F.slotw()[s2] = F.tokw()[row * 2 + 1]; }
#pragma unroll
            for (int j = 0; j < 2; ++j) { float a[8], b[8]; unpack8(*(const u32x4*)(F.xbuf() + (size_t)row * 2048 + j * 1024 + F.lane * 16), a); unpack8(*(const u32x4*)(F.xbuf() + (size_t)row * 2048 + j * 1024 + F.lane * 16 + 8), b);
#pragma unroll
                for (int e = 0; e < 8; ++e) { a[e] = a[e] * rs * mv[j][e] + sv[j][e]; b[e] = b[e] * rs * mv[j][8 + e] + sv[j][8 + e]; }
                u32x4 v; v.x = pk4_fp8(a[0], a[1], a[2], a[3]); v.y = pk4_fp8(a[4], a[5], a[6], a[7]); v.z = pk4_fp8(b[0], b[1], b[2], b[3]); v.w = pk4_fp8(b[4], b[5], b[6], b[7]);
                unsigned char* am = (unsigned char*)F.amoe();
                *(u32x4*)(am + (size_t)s1 * 2048 + j * 1024 + F.lane * 16) = v; *(u32x4*)(am + (size_t)s2 * 2048 + j * 1024 + F.lane * 16) = v; } }
    }
    { const int e = F.bid >> 3, part8 = F.bid & 7;
      unsigned zz = 0u; asm volatile("" : "+v"(zz)); const u32x4 zv = {zz, zz, zz, zz};
      if (e < 32) for (int s = pst[e] + tot[e] + part8 * 8 + F.wave; s < pend[e]; s += 64) {
          if (F.lane == 0) F.slotw()[s] = 0.f;
#pragma unroll
          for (int j = 0; j < 2; ++j) *(u32x4*)((unsigned char*)F.amoe() + (size_t)s * 2048 + j * 1024 + F.lane * 16) = zv; } }
}

__global__ void __launch_bounds__(NTHR, 2) fwd_kernel(Params p) {
    extern __shared__ __attribute__((aligned(16))) unsigned char lds_raw[];
    Frame F;
    F.L = (LAS unsigned char*)lds_raw; F.lb = (unsigned)(uintptr_t)F.L;
    F.tid = threadIdx.x; F.lane = F.tid & 63; F.wave = __builtin_amdgcn_readfirstlane(F.tid >> 6); F.bid = blockIdx.x; F.G = gridDim.x;
    unsigned char* ws = p.ws; F.ws = ws;

    volatile LAS unsigned* xbw = (volatile LAS unsigned*)(F.L + LDS_MISC);
    if (F.tid == 0) { xbw[0] = 0u; xbw[1] = 0u; }
    __syncthreads();
    const int lo = p.ph_lo, hi = p.ph_hi;
    const bool multi = (hi - lo) > 1;
    XcdBarrier bar; bar.bar = (unsigned*)(ws + WS_BAR); bar.x = 0; bar.st = xbw;
    if (multi) bar = xcd_barrier_post((unsigned*)(ws + WS_BAR), xbw);
#ifndef PH_MASK
#define PH_MASK 0xFFF
#endif
#ifndef TM
#define TM (p.tmask)
#endif
#define IN(k) (lo <= (k) && (k) < hi)
#define ON(j) (((PH_MASK) >> (j)) & 1)
#define SEAM(k) do { if (IN(k) && IN((k) + 1)) xcd_barrier(bar); } while (0)

    if (ON(0) && IN(0)) { phase_prologue(p, F.fresh()); } SEAM(0);
#ifdef EXTRA_BARRIERS
    if (hi - lo > 1) for (int eb = 0; eb < EXTRA_BARRIERS; ++eb) xcd_barrier(bar);
#endif
    for (int l = 0; l < 2; ++l) {
        const int pb = 1 + 11 * l;
        if (ON(1) && IN(pb + 0)) { if (l == 0) phase_rows<0>(p, F.fresh()); else phase_rows<1>(p, F.fresh()); } SEAM(pb + 0);
        if (ON(2) && IN(pb + 1)) {
            pg8::Gemm g{F.h(), F.win() + (size_t)l * NPAD * 2048, NT, NPAD, 2048}; pg8::StaticOrder S; S.init(NT, NPAD, F.G, F.bid);
            pg8::EpiProj E{F.proj(), F.gates()};
            pg8::gemm_phase<pg8::EpiProj, pg8::StaticOrder>(F.L, g, S, E, nullptr);
        } SEAM(pb + 1);
        if (ON(3) && IN(pb + 2)) { phase_prep(p, F.fresh(), l); } SEAM(pb + 2);
        if (ON(4) && IN(pb + 3)) {
            const Frame Fq = F.fresh(); const int ntask = l == 0 ? 1040 : 1024;
            if (TM & 1) for (int t = F.bid; t < ntask; t += F.G) na_task(p, Fq, l, t);
            if (TM & 2) for (int t = F.bid; t < NCH * 4; t += F.G) ml_state_task(p, Fq, t >> 2, t & 3);
            if (TM & 4) for (int t = F.bid; t < NCH * 2; t += F.G) ss_state_task(p, Fq, l, t >> 1, t & 1);
        } SEAM(pb + 3);
        if (ON(5) && IN(pb + 4)) { phase_scan(F.fresh()); } SEAM(pb + 4);
        if (ON(6) && IN(pb + 5)) {
            const Frame Fq = F.fresh(); const int nc = l == 0 ? NCH : 256;
            if (TM & 8) for (int t = F.bid; t < nc * 4; t += F.G) ml_out_task(p, Fq, l, t >> 2, t & 3);
            if (TM & 16) for (int t = F.bid; t < nc * 2; t += F.G) ss_out_task(p, Fq, l, t >> 1, t & 1);
        } SEAM(pb + 5);
        if (ON(7) && IN(pb + 6)) {
            const int M = l == 0 ? NT : T;
            pg8::Gemm g{F.mix(), F.wout() + (size_t)l * 2048 * 2048, M, 2048, 2048}; pg8::StaticOrder S; S.init(M, 2048, F.G, F.bid);
            const float* gl = F.mod() + ((size_t)l * 2 + 0) * 12288 + 2 * 2048; const float* gc = F.mod() + ((size_t)l * 2 + 1) * 12288 + 2 * 2048;
            if (l == 0) { pg8::EpiRes<true> E{p.x, p.ctx, F.xbuf(), gl, gc}; pg8::gemm_phase<pg8::EpiRes<true>, pg8::StaticOrder>(F.L, g, S, E, nullptr); }
            else { pg8::EpiRes<false> E{nullptr, nullptr, F.xbuf(), gl, gc}; pg8::gemm_phase<pg8::EpiRes<false>, pg8::StaticOrder>(F.L, g, S, E, nullptr); }
        } SEAM(pb + 6);
        if (ON(8) && IN(pb + 7)) { phase_route(p, F.fresh(), l); } SEAM(pb + 7);
        if (ON(9) && IN(pb + 8)) { phase_slot(p, F.fresh(), l); } SEAM(pb + 8);
        if (ON(10) && IN(pb + 9)) {
            pg8::Gemm g{F.amoe(), (const bf16_t*)((const unsigned char*)F.w13() + (size_t)l * NEXP * 2048 * 2048), NSLOT, 2048, 2048};
            pg8::MoeOrder S{F.mte(), F.mte()[MAXMT] * 8, F.G, F.bid};
            pg8::EpiGateUp E{(unsigned char*)F.hid()};
            pg8::gemm_phase<pg8::EpiGateUp, pg8::MoeOrder, false, 1, SC_W13, SC_X>(F.L, g, S, E, nullptr);
        } SEAM(pb + 9);
        if (ON(11) && IN(pb + 10)) {
            pg8::Gemm g{F.hid(), (const bf16_t*)((const unsigned char*)F.w2() + (size_t)l * NEXP * 2048 * 1024), NSLOT, 2048, 1024};
            pg8::MoeOrder S{F.mte(), F.mte()[MAXMT] * 8, F.G, F.bid};
            pg8::EpiDown E{(unsigned char*)F.ymoe(), F.slotw()};
            pg8::gemm_phase<pg8::EpiDown, pg8::MoeOrder, false, 1, SC_W2, SC_X2>(F.L, g, S, E, nullptr);
        } SEAM(pb + 10);
    }
    if (ON(1) && IN(23)) { phase_rows<2>(p, F.fresh()); }
#undef IN
#undef SEAM
}

constexpr int NPHASE = 24;
#ifndef N_LAUNCH_MODE
#define N_LAUNCH_MODE 1
#endif

extern "C" void kernel_launch(void* const* d_in, const int* in_sizes, int n_in, void* d_out, int out_size, void* d_ws, size_t ws_size, hipStream_t stream) {
    static int grid = 0;
    if (grid == 0) {
        if (n_in != 27 || ws_size < WS_END) { fprintf(stderr, "kernel_launch: unexpected inputs (n_in %d) or workspace %zu < %zu\n", n_in, ws_size, (size_t)WS_END); grid = -1; return; }
        int dev = 0, cus = 0, per_cu = 0;
        hipGetDevice(&dev); hipDeviceGetAttribute(&cus, hipDeviceAttributeMultiprocessorCount, dev);
        if (hipFuncSetAttribute((const void*)fwd_kernel, hipFuncAttributeMaxDynamicSharedMemorySize, LDS_BYTES) != hipSuccess) { fprintf(stderr, "kernel_launch: hipFuncSetAttribute failed\n"); grid = -1; return; }
        hipOccupancyMaxActiveBlocksPerMultiprocessor(&per_cu, (const void*)fwd_kernel, NTHR, LDS_BYTES);
        (void)hipGetLastError();
        if (cus < 256 || per_cu < 1) { fprintf(stderr, "kernel_launch: needs 256 CUs with one resident workgroup each (cus %d, per_cu %d)\n", cus, per_cu); grid = -1; return; }
        grid = 256;
    }
    if (grid < 0) return;
    hipMemsetAsync((char*)d_ws + WS_BAR, 0, 65536, stream);
    Params p{};
    const float** pp = (const float**)&p;
    for (int i = 0; i < 27; ++i) pp[i] = (const float*)d_in[i];
    p.out = (float*)d_out; p.ws = (unsigned char*)d_ws;
#if N_LAUNCH_MODE == 1
    p.ph_lo = 0; p.ph_hi = NPHASE; p.tmask = 31; p.pad = 0;
    hipLaunchKernelGGL(fwd_kernel, dim3(grid), dim3(NTHR), LDS_BYTES, stream, p);
#ifdef PROBE_LIST
    { const int pl[] = PROBE_LIST; for (int pv : pl) { const int ph = pv & 255; p.tmask = ((pv >> 8) & 255) ? ((pv >> 8) & 255) : 31; p.pad = pv >> 16; p.ph_lo = ph; p.ph_hi = ph + 1; hipLaunchKernelGGL(fwd_kernel, dim3(grid), dim3(NTHR), LDS_BYTES, stream, p); } }
#endif
#else
    p.tmask = 31; p.pad = 0; for (int ph = 0; ph < NPHASE; ++ph) { p.ph_lo = ph; p.ph_hi = ph + 1; hipLaunchKernelGGL(fwd_kernel, dim3(grid), dim3(NTHR), LDS_BYTES, stream, p); }
#endif
}
```

```cpp
#include <hip/hip_runtime.h>
#include <stdint.h>
#include <stdio.h>

#ifdef PROBE_LIST
#define DBG(x) (p.pad & (x))
#else
#define DBG(x) 0
#endif
#define LAS __attribute__((address_space(3)))
#define DI __device__ __forceinline__
typedef unsigned short bf16_t;
typedef short bf16x8 __attribute__((ext_vector_type(8)));
typedef short bf16x4 __attribute__((ext_vector_type(4)));
typedef float f32x4 __attribute__((ext_vector_type(4)));
typedef float f32x2 __attribute__((ext_vector_type(2)));
typedef unsigned u32x4 __attribute__((ext_vector_type(4)));
typedef unsigned u32x2 __attribute__((ext_vector_type(2)));
typedef __bf16 bfv2 __attribute__((ext_vector_type(2)));

constexpr int D = 2048, T = 16384, CTXL = 256, NT = T + CTXL;
constexpr int INC = 6688, NPROJ = 6656, NPAD = 6912;
constexpr int QO = 0, KO = 1024, VO = 2048, MQO = 3072, MKO = 3584, MVO = 4096, MOO = 4608, ZO = 5120, XBO = 5632;
constexpr int NCH = 260;
constexpr int NEXP = 32, FF = 1024;
constexpr int MAXMT = 162, NSLOT = MAXMT * 256;
constexpr int NTHR = 512;
constexpr int LDS_BYTES = 155648;
constexpr int LDS_MISC = LDS_BYTES - 256;

constexpr size_t al256(size_t x) { return (x + 255) & ~(size_t)255; }
constexpr size_t WS_BAR   = 0;
constexpr size_t WS_MODP  = 65536;
constexpr size_t WS_MOD   = WS_MODP  + al256((size_t)2 * 8 * 2 * 12288 * 4);
constexpr size_t WS_ROPE  = WS_MOD   + al256((size_t)2 * 2 * 12288 * 4);
constexpr size_t WS_TOKE  = WS_ROPE  + al256((size_t)(256 + 64) * 32 * 2 * 4);
constexpr size_t WS_TOKW  = WS_TOKE  + al256((size_t)NT * 2 * 4);
constexpr size_t WS_TOKR  = WS_TOKW  + al256((size_t)NT * 2 * 4);
constexpr size_t WS_TOKS  = WS_TOKR  + al256((size_t)NT * 2 * 4);
constexpr size_t WS_CNT   = WS_TOKS  + al256((size_t)NT * 2 * 4);
constexpr size_t WS_MTE   = WS_CNT   + al256((size_t)256 * 32 * 4);
constexpr size_t WS_SLOTW = WS_MTE   + al256((size_t)(MAXMT + 2) * 4);
constexpr size_t WS_GATES = WS_SLOTW + al256((size_t)NSLOT * 4);
constexpr size_t WS_MLG   = WS_GATES + al256((size_t)NT * 32 * 4);
constexpr size_t WS_DT    = WS_MLG   + al256((size_t)NT * 16 * 4);
constexpr size_t WS_DECML = WS_DT    + al256((size_t)NT * 16 * 4);
constexpr size_t WS_DECSS = WS_DECML + al256((size_t)8 * NCH * 4);
constexpr size_t WS_MVEC  = WS_DECSS + al256((size_t)16 * NCH * 4);
constexpr size_t WS_RSTD  = WS_MVEC  + al256((size_t)2 * 2 * 2048 * 4);
constexpr size_t WS_CRG   = WS_RSTD  + al256((size_t)NT * 4);
constexpr size_t WS_RWT   = WS_CRG   + al256((size_t)2 * 72 * 4);
constexpr size_t WS_WIN   = WS_RWT   + al256((size_t)2 * 36 * 2048 * 2);
constexpr size_t WS_WOUT  = WS_WIN   + (size_t)2 * NPAD * D * 2;
constexpr size_t WS_W13   = WS_WOUT  + (size_t)2 * D * D * 2;
constexpr size_t WS_W2    = WS_W13   + (size_t)2 * NEXP * 2048 * D * 2;
constexpr size_t WS_H     = WS_W2    + (size_t)2 * NEXP * D * FF * 2;
constexpr size_t WS_XBUF  = WS_H     + (size_t)NT * D * 2;
constexpr size_t WS_PROJ  = WS_XBUF  + (size_t)NT * D * 4;
constexpr size_t WS_XBCC  = WS_PROJ  + (size_t)NT * NPROJ * 2;
constexpr size_t WS_MIX   = WS_XBCC  + (size_t)NT * 1024 * 2;
constexpr size_t WS_STML  = WS_MIX   + (size_t)NT * D * 2;
constexpr size_t WS_STSS  = WS_STML  + (size_t)8 * NCH * 16512 * 4;
constexpr size_t WS_END   = WS_STSS  + (size_t)16 * NCH * 8192 * 4;
constexpr size_t WS_AMOE  = WS_PROJ;
constexpr size_t WS_HID   = WS_AMOE + (size_t)NSLOT * D * 2;
constexpr size_t WS_YMOE  = WS_MIX;
static_assert(WS_HID + (size_t)NSLOT * FF * 2 <= WS_MIX, "moe alias 1");
static_assert(WS_YMOE + (size_t)NSLOT * D * 2 <= WS_STSS, "moe alias 2");

struct Params {
    const float *x, *c, *ctx, *c_ctx, *w_mod, *b_mod, *norm1_w, *norm2_w, *w_in, *w_out, *na_rpb, *ml_gate_b, *ml_norm_w,
                *conv_w, *conv_b, *dt_bias, *a_log, *ssm_d, *ssm_norm_w, *rg_w, *rg_b, *re_w, *re_b, *w1, *w3, *w2, *final_w;
    float* out; unsigned char* ws; int ph_lo, ph_hi, tmask, pad;
};

DI unsigned pk2(float lo, float hi) { f32x2 v = {lo, hi}; bfv2 b = __builtin_convertvector(v, bfv2); return __builtin_bit_cast(unsigned, b); }
DI float bflo(unsigned u) { return __uint_as_float(u << 16); }
DI float bfhi(unsigned u) { return __uint_as_float(u & 0xffff0000u); }
DI float bf2f(bf16_t b) { return __uint_as_float(((unsigned)b) << 16); }
DI bf16_t f2bf(float f) { return (bf16_t)(pk2(f, 0.f) & 0xffffu); }
DI float wsum(float v) { v += __shfl_xor(v, 32); v += __shfl_xor(v, 16); v += __shfl_xor(v, 8); v += __shfl_xor(v, 4); v += __shfl_xor(v, 2); v += __shfl_xor(v, 1); return v; }
DI float gsum4(float v) { v += __shfl_xor(v, 16); v += __shfl_xor(v, 32); return v; }
DI f32x4 mfma16(bf16x8 a, bf16x8 b, f32x4 c) { return __builtin_amdgcn_mfma_f32_16x16x32_bf16(a, b, c, 0, 0, 0); }
DI float siluf(float v) { return v / (1.0f + __expf(-v)); }
DI float sigmf(float v) { return 1.0f / (1.0f + __expf(-v)); }
DI bf16x8 pack8(const float (&v)[8]) { u32x4 p; p.x = pk2(v[0], v[1]); p.y = pk2(v[2], v[3]); p.z = pk2(v[4], v[5]); p.w = pk2(v[6], v[7]); return __builtin_bit_cast(bf16x8, p); }
DI void unpack8(u32x4 u, float (&v)[8]) { v[0] = bflo(u.x); v[1] = bfhi(u.x); v[2] = bflo(u.y); v[3] = bfhi(u.y); v[4] = bflo(u.z); v[5] = bfhi(u.z); v[6] = bflo(u.w); v[7] = bfhi(u.w); }
DI bf16x8 frag_row(LAS unsigned char* L, unsigned tb, unsigned pb, int r0, int k0, int lane) {
    return *(LAS bf16x8*)(L + tb + (unsigned)(r0 + (lane & 15)) * pb + (unsigned)(k0 + 8 * (lane >> 4)) * 2u);
}
DI bf16x8 frag_tr(unsigned lbase, unsigned tb, unsigned pb, int rA, int rB, int c0, int lane) {
    const int q = (lane & 15) >> 2, pq = lane & 3;
    const unsigned a0 = lbase + tb + (unsigned)(rA + q) * pb + (unsigned)(c0 + 4 * pq) * 2u;
    const unsigned a1 = lbase + tb + (unsigned)(rB + q) * pb + (unsigned)(c0 + 4 * pq) * 2u;
    bf16x4 lo, hi;
    asm volatile("ds_read_b64_tr_b16 %0, %2\n\tds_read_b64_tr_b16 %1, %3\n\ts_waitcnt lgkmcnt(0)" : "=&v"(lo), "=&v"(hi) : "v"(a0), "v"(a1) : "memory");
    bf16x8 r; r[0] = lo[0]; r[1] = lo[1]; r[2] = lo[2]; r[3] = lo[3]; r[4] = hi[0]; r[5] = hi[1]; r[6] = hi[2]; r[7] = hi[3]; return r;
}
DI float wscan(float v, int rev, int lane) {
#pragma unroll
    for (int off = 1; off < 64; off <<= 1) {
        const float t = rev ? __shfl_down(v, off) : __shfl_up(v, off);
        const bool ok = rev ? (lane + off < 64) : (lane >= off);
        v += ok ? t : 0.f;
    }
    return v;
}
DI void frag_tr_x4(bf16x8 (&f)[4], unsigned lbase, unsigned tb, unsigned pb, int rA, int rB, int c0, int lane) {
    const int q = (lane & 15) >> 2, pq = lane & 3;
    const unsigned a0 = lbase + tb + (unsigned)(rA + q) * pb + (unsigned)(c0 + 4 * pq) * 2u;
    const unsigned a1 = lbase + tb + (unsigned)(rB + q) * pb + (unsigned)(c0 + 4 * pq) * 2u;
    bf16x4 l0, l1, l2, l3, h0, h1, h2, h3;
    asm volatile("ds_read_b64_tr_b16 %0, %8\n\tds_read_b64_tr_b16 %1, %8 offset:32\n\tds_read_b64_tr_b16 %2, %8 offset:64\n\tds_read_b64_tr_b16 %3, %8 offset:96\n\t"
                 "ds_read_b64_tr_b16 %4, %9\n\tds_read_b64_tr_b16 %5, %9 offset:32\n\tds_read_b64_tr_b16 %6, %9 offset:64\n\tds_read_b64_tr_b16 %7, %9 offset:96\n\ts_waitcnt lgkmcnt(0)"
                 : "=&v"(l0), "=&v"(l1), "=&v"(l2), "=&v"(l3), "=&v"(h0), "=&v"(h1), "=&v"(h2), "=&v"(h3) : "v"(a0), "v"(a1) : "memory");
    f[0] = __builtin_shufflevector(l0, h0, 0, 1, 2, 3, 4, 5, 6, 7); f[1] = __builtin_shufflevector(l1, h1, 0, 1, 2, 3, 4, 5, 6, 7);
    f[2] = __builtin_shufflevector(l2, h2, 0, 1, 2, 3, 4, 5, 6, 7); f[3] = __builtin_shufflevector(l3, h3, 0, 1, 2, 3, 4, 5, 6, 7);
}
DI unsigned pk4_fp8(float a, float b, float c, float d) { int w = 0; w = __builtin_amdgcn_cvt_pk_fp8_f32(a, b, w, false); w = __builtin_amdgcn_cvt_pk_fp8_f32(c, d, w, true); return (unsigned)w; }
constexpr float FS_W13 = 64.f, FS_W2 = 32.f, FS_X = 4.f, FS_Y = 8.f;
constexpr int SC_W13 = 127 - 4, SC_W2 = 127 - 4, SC_X = 127 - 4, SC_X2 = 127 - 3;
DI f32x4 unpk4_fp8(unsigned w) { const f32x2 lo = __builtin_amdgcn_cvt_pk_f32_fp8((int)w, false), hi = __builtin_amdgcn_cvt_pk_f32_fp8((int)w, true); return (f32x4){lo[0], lo[1], hi[0], hi[1]}; }

namespace pg8 {
#define PG8_LAS __attribute__((address_space(3)))
typedef unsigned short bf16_t;
typedef short bf16x8 __attribute__((ext_vector_type(8)));
typedef float f32x4 __attribute__((ext_vector_type(4)));
typedef unsigned u32x4 __attribute__((ext_vector_type(4)));
constexpr int BM = 256, BK = 64, HALF = 128, HTB = HALF * BK * 2, STAGE_BYTES = 8 * HTB, NXCD = 8, WGM = 8;
__host__ __device__ __forceinline__ int lds_byte(int r, int c) { const int st = (r >> 4) * 2 + (c >> 5), rr = r & 15, cc = c & 31, ob = rr * 64 + cc * 2; return st * 1024 + (ob ^ (((ob >> 9) & 1) << 5)); }
__host__ __device__ __forceinline__ void stage_rc(int b, int& R, int& C) { const int st = b / 1024, sb = b % 1024, swz = sb ^ (((sb >> 9) & 1) << 5); R = (st >> 1) * 16 + swz / 64; C = (st & 1) * 32 + (swz % 64) / 2; }
__host__ __device__ __forceinline__ int perm32(int rho) { const int n = rho >> 4, i = rho & 15; return 8 * (i >> 2) + 4 * n + (i & 3); }
struct Unit { int pm, pn; };
struct Gemm { const bf16_t* A; const bf16_t* Bt; int M, N, K; };
struct StaticOrder {
    int nM, nN, nwg, G, c;
    __host__ __device__ void init(int M, int N, int G_, int c_) { nM = M / BM; nN = N / BM; nwg = nM * nN; G = G_; c = c_; }
    __host__ __device__ bool next(int i, Unit& u) const {
        const long L = (long)i * G + c; if (L >= nwg) return false;
        int wgid = (int)L; { const int q = nwg / NXCD, r = nwg % NXCD, xcd = wgid % NXCD, off = wgid / NXCD; wgid = (xcd < r ? xcd * (q + 1) : r * (q + 1) + (xcd - r) * q) + off; }
        const int nig = WGM * nN, gid = wgid / nig, fm = gid * WGM, gsz = (nM - fm) < WGM ? (nM - fm) : WGM;
        u.pm = fm + ((wgid % nig) % gsz); u.pn = (wgid % nig) / gsz; return true;
    }
    __device__ __forceinline__ void a_ready(const Unit&) const {}
    __device__ __forceinline__ void done(const Unit&) const {}
};
struct MoeOrder {
    const int* mte; int nunits, G, c;
    __device__ bool next(int i, Unit& u) const { const int mtiles = nunits >> 3, x = c & 7, m0 = (x * mtiles) >> 3, m1 = ((x + 1) * mtiles) >> 3;
        const int Lx = (c >> 3) + (G >> 3) * i; if (Lx >= (m1 - m0) * 8) return false; const int mt = m0 + (Lx >> 3); u.pm = mt; u.pn = mte[mt] * 8 + (Lx & 7); return true; }
    __device__ __forceinline__ void a_ready(const Unit&) const {}
    __device__ __forceinline__ void done(const Unit&) const {}
};
DI unsigned pk2(float lo, float hi) { return ::pk2(lo, hi); }
DI unsigned pk4_fp8(float a, float b, float c, float d) { return ::pk4_fp8(a, b, c, d); }
using ::FS_X; using ::FS_Y;

struct EpiProj {
    static constexpr bool PERM = true, AFTER_DRAIN = false;
    bf16_t* O; float* gates;
    __device__ __forceinline__ void operator()(const f32x4 (&acc)[2][2][4][2], const Unit& u, int wr, int wc, int fr, int fq) const {
        const int row0 = u.pm * BM + wr * 64 + fr;
        if (u.pn < 26) {
            const int col0 = u.pn * BM + wc * 32 + 8 * fq;
#pragma unroll
            for (int ai = 0; ai < 2; ++ai)
#pragma unroll
                for (int m = 0; m < 4; ++m) { bf16_t* rowp = O + (size_t)(row0 + ai * HALF + m * 16) * 6656 + col0;
#pragma unroll
                    for (int bj = 0; bj < 2; ++bj) { const f32x4 v0 = acc[ai][bj][m][0], v1 = acc[ai][bj][m][1];
                        u32x4 w; w.x = pk2(v0[0], v0[1]); w.y = pk2(v0[2], v0[3]); w.z = pk2(v1[0], v1[1]); w.w = pk2(v1[2], v1[3]);
                        *(u32x4*)(rowp + bj * HALF) = w; } }
        } else if (wc == 0) {
#pragma unroll
            for (int ai = 0; ai < 2; ++ai)
#pragma unroll
                for (int m = 0; m < 4; ++m) { float* rowp = gates + (size_t)(row0 + ai * HALF + m * 16) * 32 + 8 * fq;
                    *(f32x4*)(rowp) = acc[ai][0][m][0]; *(f32x4*)(rowp + 4) = acc[ai][0][m][1]; }
        }
    }
};
template <bool BF32> struct EpiRes {
    static constexpr bool PERM = true, AFTER_DRAIN = false;
    const float* base_lat; const float* base_ctx; bf16_t* out; const float* g_lat; const float* g_ctx;
    __device__ __forceinline__ void operator()(const f32x4 (&acc)[2][2][4][2], const Unit& u, int wr, int wc, int fr, int fq) const {
        const bool isctx = u.pm >= 64;
        const float* base = isctx ? base_ctx - (size_t)16384 * 2048 : base_lat; const float* gv = isctx ? g_ctx : g_lat;
        const int row0 = u.pm * BM + wr * 64 + fr, col0 = u.pn * BM + wc * 32 + 8 * fq;
        f32x4 gg[2][2];
#pragma unroll
        for (int bj = 0; bj < 2; ++bj)
#pragma unroll
            for (int n = 0; n < 2; ++n) gg[bj][n] = *(const f32x4*)(gv + col0 + bj * HALF + n * 4);
        constexpr int MB = BF32 ? 2 : 4;
#pragma unroll
        for (int ai = 0; ai < 2; ++ai)
#pragma unroll
          for (int mb = 0; mb < 4; mb += MB) {
            f32x4 bf[MB][2][2]; u32x4 bq[MB][2];
#pragma unroll
            for (int mi = 0; mi < MB; ++mi) { const size_t off = (size_t)(row0 + ai * HALF + (mb + mi) * 16) * 2048 + col0;
#pragma unroll
                for (int bj = 0; bj < 2; ++bj) {
                    if constexpr (BF32) { bf[mi][bj][0] = *(const f32x4*)(base + off + bj * HALF); bf[mi][bj][1] = *(const f32x4*)(base + off + bj * HALF + 4); }
                    else bq[mi][bj] = *(const u32x4*)(out + off + bj * HALF); } }
#pragma unroll
            for (int mi = 0; mi < MB; ++mi) { const int m = mb + mi; const size_t off = (size_t)(row0 + ai * HALF + m * 16) * 2048 + col0;
#pragma unroll
                for (int bj = 0; bj < 2; ++bj) { f32x4 b0, b1;
                    if constexpr (BF32) { b0 = bf[mi][bj][0]; b1 = bf[mi][bj][1]; }
                    else { const u32x4 q = bq[mi][bj]; b0 = (f32x4){__uint_as_float(q.x << 16), __uint_as_float(q.x & 0xffff0000u), __uint_as_float(q.y << 16), __uint_as_float(q.y & 0xffff0000u)};
                           b1 = (f32x4){__uint_as_float(q.z << 16), __uint_as_float(q.z & 0xffff0000u), __uint_as_float(q.w << 16), __uint_as_float(q.w & 0xffff0000u)}; }
                    const f32x4 v0 = b0 + gg[bj][0] * acc[ai][bj][m][0], v1 = b1 + gg[bj][1] * acc[ai][bj][m][1];
                    u32x4 w; w.x = pk2(v0[0], v0[1]); w.y = pk2(v0[2], v0[3]); w.z = pk2(v1[0], v1[1]); w.w = pk2(v1[2], v1[3]);
                    *(u32x4*)(out + off + bj * HALF) = w; } }
          }
    }
};
struct EpiGateUp {
    static constexpr bool PERM = true, AFTER_DRAIN = false;
    unsigned char* O;
    __device__ __forceinline__ void operator()(const f32x4 (&acc)[2][2][4][2], const Unit& u, int wr, int wc, int fr, int fq) const {
        const int row0 = u.pm * BM + wr * 64 + fr, col0 = (u.pn & 7) * 128 + wc * 32 + 8 * fq;
#pragma unroll
        for (int ai = 0; ai < 2; ++ai)
#pragma unroll
            for (int m = 0; m < 4; ++m) { float h[8];
#pragma unroll
                for (int n = 0; n < 2; ++n)
#pragma unroll
                    for (int j = 0; j < 4; ++j) { const float gt = acc[ai][0][m][n][j], up = acc[ai][1][m][n][j]; h[n * 4 + j] = gt / (1.0f + __expf(-gt)) * up * FS_X; }
                u32x2 w; w.x = pk4_fp8(h[0], h[1], h[2], h[3]); w.y = pk4_fp8(h[4], h[5], h[6], h[7]);
                *(u32x2*)(O + (size_t)(row0 + ai * HALF + m * 16) * 1024 + col0) = w; }
    }
};
struct EpiDown {
    static constexpr bool PERM = true, AFTER_DRAIN = false;
    unsigned char* O; const float* sw;
    __device__ __forceinline__ void operator()(const f32x4 (&acc)[2][2][4][2], const Unit& u, int wr, int wc, int fr, int fq) const {
        const int row0 = u.pm * BM + wr * 64 + fr, col0 = (u.pn & 7) * BM + wc * 32 + 8 * fq;
#pragma unroll
        for (int ai = 0; ai < 2; ++ai)
#pragma unroll
            for (int m = 0; m < 4; ++m) { const int row = row0 + ai * HALF + m * 16; const float s = FS_Y; unsigned char* rowp = O + (size_t)row * 2048 + col0;
#pragma unroll
                for (int bj = 0; bj < 2; ++bj) { const f32x4 v0 = acc[ai][bj][m][0] * s, v1 = acc[ai][bj][m][1] * s;
                    u32x2 w; w.x = pk4_fp8(v0[0], v0[1], v0[2], v0[3]); w.y = pk4_fp8(v1[0], v1[1], v1[2], v1[3]);
                    *(u32x2*)(rowp + bj * HALF) = w; } }
    }
};

template <class Epi, class Sched, bool STAMP = false, int ES = 2, int SCW = 127, int SCX = 127>
__device__ __forceinline__ void gemm_phase(PG8_LAS unsigned char* lds, const Gemm g, const Sched& S, const Epi& E, unsigned long long* stamps) {
    int tid_ = threadIdx.x; asm volatile("" : "+v"(tid_)); const int tid = tid_, wid = __builtin_amdgcn_readfirstlane(tid >> 6), lane = tid & 63, wr = wid >> 2, wc = wid & 3, fr = lane & 15, fq = lane >> 4;
    const int K = g.K * ES / 2  , nt = K / BK;
    int ts_lo = 0, ts_hi = 0, nts = 0; const unsigned long long rt_entry = STAMP ? (unsigned long long)wall_clock64() : 0ull;
#define PG8_STAMP() do { if (STAMP && wid == 0 && nts < 64) { const unsigned long long _c = (unsigned long long)clock64(); \
        ts_lo = (lane == nts) ? (int)(unsigned)_c : ts_lo; ts_hi = (lane == nts) ? (int)(unsigned)(_c >> 32) : ts_hi; ++nts; } } while (0)
    PG8_STAMP();
    unsigned voffA[2], voffB[2];
#pragma unroll
    for (int i = 0; i < 2; ++i) { int R, C; stage_rc(tid * 16 + i * 8192, R, C); const int Rb = Epi::PERM ? ((R & ~31) + perm32(R & 31)) : R;
        voffA[i] = (unsigned)(R * K + C) * 2u; voffB[i] = (unsigned)(Rb * K + C) * 2u; }
    const size_t kstep = (size_t)(BK * 2);
    const size_t hstep = (size_t)HALF * K * 2;
    const size_t tstep = 2 * hstep;
    const unsigned ldsw = (unsigned)wid * 1024u;
    const int aoff = lds_byte(wr * 64 + fr, fq * 8), boff = lds_byte(wc * 32 + fr, fq * 8);
#define PG8_SA(b, h) (((b) * 2 + (h)) * HTB)
#define PG8_SB(b, h) ((4 + (b) * 2 + (h)) * HTB)
#define PG8_STAGE(bufoff, gbase, voff) do { _Pragma("unroll") for (int _i = 0; _i < 2; ++_i) \
        __builtin_amdgcn_global_load_lds((const unsigned*)((const char*)(gbase) + (voff)[_i]), (PG8_LAS unsigned*)(lds + (bufoff) + ldsw + _i * 8192), 16, 0, 0); } while (0)
#define PG8_LDA(dst, b, h) do { _Pragma("unroll") for (int m = 0; m < 4; ++m) { \
        if constexpr (ES == 2) { _Pragma("unroll") for (int k = 0; k < 2; ++k) dst[m][k] = *(const PG8_LAS bf16x8*)(lds + PG8_SA(b, h) + aoff + m * 2048 + k * 1024); } \
        else { const v4i_ lo_ = *(const PG8_LAS v4i_*)(lds + PG8_SA(b, h) + aoff + m * 2048), hi_ = *(const PG8_LAS v4i_*)(lds + PG8_SA(b, h) + aoff + m * 2048 + 1024); dst##8[m] = __builtin_shufflevector(lo_, hi_, 0, 1, 2, 3, 4, 5, 6, 7); } } } while (0)
#define PG8_LDB(dst, b, h) do { _Pragma("unroll") for (int n = 0; n < 2; ++n) { \
        if constexpr (ES == 2) { _Pragma("unroll") for (int k = 0; k < 2; ++k) dst[n][k] = *(const PG8_LAS bf16x8*)(lds + PG8_SB(b, h) + boff + n * 2048 + k * 1024); } \
        else { const v4i_ lo_ = *(const PG8_LAS v4i_*)(lds + PG8_SB(b, h) + boff + n * 2048), hi_ = *(const PG8_LAS v4i_*)(lds + PG8_SB(b, h) + boff + n * 2048 + 1024); dst##8[n] = __builtin_shufflevector(lo_, hi_, 0, 1, 2, 3, 4, 5, 6, 7); } } } while (0)
#define PG8_MMA(ai, bj, At, Bt) do { __builtin_amdgcn_s_setprio(1); _Pragma("unroll") for (int m = 0; m < 4; ++m) _Pragma("unroll") for (int n = 0; n < 2; ++n) { \
        if constexpr (ES == 2) { _Pragma("unroll") for (int k = 0; k < 2; ++k) acc[ai][bj][m][n] = __builtin_amdgcn_mfma_f32_16x16x32_bf16(Bt[n][k], At[m][k], acc[ai][bj][m][n], 0, 0, 0); } \
        else asm volatile("v_mfma_scale_f32_16x16x128_f8f6f4 %0, %1, %2, %0, %3, %4 op_sel_hi:[0,0,0]" : "+v"(acc[ai][bj][m][n]) : "v"(Bt##8[n]), "v"(At##8[m]), "v"(scw_), "v"(scx_)); } \
        __builtin_amdgcn_s_setprio(0); } while (0)
#define PG8_WAIT_V(n) asm volatile("s_waitcnt vmcnt(" #n ")" ::: "memory")
#define PG8_WAIT_L(n) asm volatile("s_waitcnt lgkmcnt(" #n ")" ::: "memory")
#define PG8_BAR __builtin_amdgcn_s_barrier()
#define PG8_SCHED __builtin_amdgcn_sched_barrier(0)
    Unit cur, nxt; int ui = 0;
    if (!S.next(0, cur)) return;
    f32x4 acc[2][2][4][2];
#pragma unroll
    for (int a = 0; a < 2; ++a)
#pragma unroll
        for (int b = 0; b < 2; ++b)
#pragma unroll
            for (int m = 0; m < 4; ++m)
#pragma unroll
                for (int n = 0; n < 2; ++n) acc[a][b][m][n] = (f32x4){0.f, 0.f, 0.f, 0.f};
    typedef int v4i_ __attribute__((ext_vector_type(4))); typedef int v8i_ __attribute__((ext_vector_type(8)));
    bf16x8 At[4][2], B0[2][2], B1[2][2]; v8i_ At8[4], B08[2], B18[2]; const int scw_ = SCW * 0x01010101, scx_ = SCX * 0x01010101;
    const char* cA = (const char*)g.A + (size_t)cur.pm * tstep; const char* cB = (const char*)g.Bt + (size_t)cur.pn * tstep;
    S.a_ready(cur);
    PG8_STAGE(PG8_SB(0, 0), cB, voffB); PG8_STAGE(PG8_SA(0, 0), cA, voffA); PG8_STAGE(PG8_SB(0, 1), cB + hstep, voffB); PG8_STAGE(PG8_SA(0, 1), cA + hstep, voffA);
    if (wr == 1) PG8_BAR;
    PG8_WAIT_V(4); PG8_BAR;
    PG8_STAGE(PG8_SB(1, 0), cB + kstep, voffB); PG8_STAGE(PG8_SA(1, 0), cA + kstep, voffA); PG8_STAGE(PG8_SB(1, 1), cB + hstep + kstep, voffB);
    PG8_WAIT_V(6); PG8_BAR;
    PG8_STAMP();
    for (;;) {
        const bool has_next = S.next(ui + 1, nxt);
        const char* nA = has_next ? (const char*)g.A + (size_t)nxt.pm * tstep : cA; const char* nB = has_next ? (const char*)g.Bt + (size_t)nxt.pn * tstep : cB;
        for (int t = 0; t < nt; t += 2) {
            const bool last = (t == nt - 2);
            const char* a1 = cA + (size_t)(t + 1) * kstep;
            const char* a2 = last ? nA : cA + (size_t)(t + 2) * kstep; const char* b2 = last ? nB : cB + (size_t)(t + 2) * kstep;
            const char* a3 = a2 + kstep; const char* b3 = b2 + kstep;
            if (last && has_next) S.a_ready(nxt);
            PG8_LDB(B0, 0, 0); PG8_SCHED; PG8_LDA(At, 0, 0); PG8_STAGE(PG8_SA(1, 1), a1 + hstep, voffA);
            PG8_WAIT_L(8); PG8_BAR; PG8_WAIT_L(0); PG8_MMA(0, 0, At, B0); PG8_BAR; PG8_SCHED;
            PG8_LDB(B1, 0, 1); PG8_STAGE(PG8_SB(0, 0), b2, voffB);
            PG8_BAR; PG8_WAIT_L(0); PG8_MMA(0, 1, At, B1); PG8_BAR;
            PG8_LDA(At, 0, 1); PG8_STAGE(PG8_SA(0, 0), a2, voffA);
            PG8_BAR; PG8_WAIT_L(0); PG8_MMA(1, 0, At, B0); PG8_BAR; PG8_SCHED;
            PG8_STAGE(PG8_SB(0, 1), b2 + hstep, voffB);
            PG8_WAIT_V(6); PG8_BAR; PG8_MMA(1, 1, At, B1); PG8_BAR;
            PG8_LDB(B0, 1, 0); PG8_SCHED; PG8_LDA(At, 1, 0); PG8_STAGE(PG8_SA(0, 1), a2 + hstep, voffA);
            PG8_WAIT_L(8); PG8_BAR; PG8_WAIT_L(0); PG8_MMA(0, 0, At, B0); PG8_BAR; PG8_SCHED;
            PG8_LDB(B1, 1, 1); PG8_STAGE(PG8_SB(1, 0), b3, voffB);
            PG8_BAR; PG8_WAIT_L(0); PG8_MMA(0, 1, At, B1); PG8_BAR;
            PG8_LDA(At, 1, 1); PG8_STAGE(PG8_SA(1, 0), a3, voffA);
            PG8_BAR; PG8_WAIT_L(0); PG8_MMA(1, 0, At, B0); PG8_BAR; PG8_SCHED;
            PG8_STAGE(PG8_SB(1, 1), b3 + hstep, voffB);
            PG8_WAIT_V(6); PG8_BAR; PG8_MMA(1, 1, At, B1); PG8_BAR;
        }
        PG8_STAMP();
        if constexpr (ES == 1) { asm volatile("s_nop 15\n\ts_nop 15\n\ts_nop 15" ::: "memory"); __builtin_amdgcn_sched_barrier(0); }
        if constexpr (!Epi::AFTER_DRAIN) { E(acc, cur, wr, wc, fr, fq); S.done(cur); }
        PG8_STAMP();
        if (!has_next) break;
#pragma unroll
        for (int a = 0; a < 2; ++a)
#pragma unroll
            for (int b = 0; b < 2; ++b)
#pragma unroll
                for (int m = 0; m < 4; ++m)
#pragma unroll
                    for (int n = 0; n < 2; ++n) acc[a][b][m][n] = (f32x4){0.f, 0.f, 0.f, 0.f};
        cur = nxt; cA = nA; cB = nB; ++ui;
    }
    PG8_WAIT_V(0);
    if (wr == 0) PG8_BAR;
    PG8_BAR;
    if constexpr (Epi::AFTER_DRAIN) { E.fused(acc, cur, wr, wc, fr, fq, lds, wid, lane); S.done(cur); }
    PG8_STAMP();
    if (STAMP && wid == 0) { stamps[lane] = lane < nts ? (((unsigned long long)(unsigned)ts_hi << 32) | (unsigned)ts_lo) : 0ull;
        if (lane == 62) stamps[62] = rt_entry; if (lane == 63) stamps[63] = (unsigned long long)wall_clock64(); }
#undef PG8_STAMP
#undef PG8_SA
#undef PG8_SB
#undef PG8_STAGE
#undef PG8_LDA
#undef PG8_LDB
#undef PG8_MMA
#undef PG8_WAIT_V
#undef PG8_WAIT_L
#undef PG8_BAR
#undef PG8_SCHED
}
}

#define XB_TMO      128
#define XB_XCNT(j)  (256  + 64 * (j))
#define XB_XSUB(j)  (1280 + 64 * (j))
#define XB_XGEN(j)  (2304 + 64 * (j))
#define XB_TOP      3328
#define XB_TOPGEN   3392
#define XCD_BAR_WORDS 3456
#define XB_SPIN_CAP (1u << 18)
__device__ __forceinline__ unsigned xb_ld(unsigned* p)              { return __hip_atomic_load(p, __ATOMIC_RELAXED, __HIP_MEMORY_SCOPE_AGENT); }
__device__ __forceinline__ unsigned xb_add(unsigned* p, unsigned v) { return __hip_atomic_fetch_add(p, v, __ATOMIC_RELAXED, __HIP_MEMORY_SCOPE_AGENT); }
__device__ __forceinline__ unsigned xb_xcc_id() { return (unsigned)__builtin_amdgcn_s_getreg((3 << 11) | 20) & 0xFu; }
#define XB_SPIN(cond, bar) do { unsigned _sp = 0; while (cond) { __builtin_amdgcn_s_sleep(1); \
    if ((++_sp & 255u) == 0u) { if (xb_ld(&(bar)[XB_TMO])) break; if (_sp > XB_SPIN_CAP) { atomicAdd(&(bar)[XB_TMO], 1u); break; } } } } while (0)
struct XcdBarrier { unsigned* bar; unsigned x; volatile LAS unsigned* st; };
__device__ __forceinline__ XcdBarrier xcd_barrier_post(unsigned* bar, volatile LAS unsigned* st) {
    XcdBarrier b; b.bar = bar; b.x = xb_xcc_id(); b.st = st;
    if (threadIdx.x == 0) (void)xb_add(&bar[XB_XCNT(b.x)], 1u);
    return b;
}
__device__ __forceinline__ void xcd_barrier_complete(unsigned* bar, unsigned x, unsigned& nloc, unsigned& nx) {
    const unsigned G = gridDim.x * gridDim.y * gridDim.z;
    unsigned sum, cnt, mine, sp = 0u;
    for (;;) {
        sum = 0u; cnt = 0u; mine = 0u;
#pragma unroll
        for (unsigned j = 0; j < 16; ++j) { const unsigned c = xb_ld(&bar[XB_XCNT(j)]); sum += c; cnt += (c > 0u) ? 1u : 0u; mine = (j == x) ? c : mine; }
        if (sum == G) break;
        __builtin_amdgcn_s_sleep(1);
        if ((++sp & 255u) == 0u) { if (xb_ld(&bar[XB_TMO])) break; if (sp > XB_SPIN_CAP) { atomicAdd(&bar[XB_TMO], 1u); break; } }
    }
    nloc = mine > 0u ? mine : 1u; nx = cnt > 0u ? cnt : 1u;
}
__device__ __forceinline__ void xcd_barrier(const XcdBarrier& b) {
    asm volatile("s_waitcnt vmcnt(0)" ::: "memory");
    __syncthreads();
    if (threadIdx.x == 0) {
        unsigned* bar = b.bar;
        __builtin_amdgcn_s_waitcnt(0);
        unsigned nloc = b.st[0], nx = b.st[1];
        if (nloc == 0u) { xcd_barrier_complete(bar, b.x, nloc, nx); b.st[0] = nloc; b.st[1] = nx; }
        const unsigned old = xb_add(&bar[XB_XSUB(b.x)], 1u);
        const unsigned gen = old / nloc;
        if (old + 1u == (gen + 1u) * nloc) {
            __builtin_amdgcn_fence(__ATOMIC_RELEASE, "agent");
            asm volatile("s_waitcnt vmcnt(0)" ::: "memory");
            const unsigned og = xb_add(&bar[XB_TOP], 1u);
            const unsigned tg = og / nx;
            if (og + 1u == (tg + 1u) * nx) xb_add(&bar[XB_TOPGEN], 1u);
            else XB_SPIN(xb_ld(&bar[XB_TOPGEN]) == tg, bar);
            __builtin_amdgcn_fence(__ATOMIC_ACQUIRE, "agent");
            xb_add(&bar[XB_XGEN(b.x)], 1u);
            asm volatile("s_waitcnt vmcnt(0)" ::: "memory");
        } else {
            XB_SPIN(xb_ld(&bar[XB_XGEN(b.x)]) == gen, bar);
            __builtin_amdgcn_fence(__ATOMIC_ACQUIRE, "agent");
            asm volatile("s_waitcnt vmcnt(0)" ::: "memory");
        }
    }
    __syncthreads();
}

struct Frame {
    LAS unsigned char* L; unsigned lb; int tid, lane, wave, bid, G; unsigned char* ws;
    DI Frame fresh() const { Frame f = *this; asm volatile("" : "+v"(f.tid), "+s"(f.wave), "+s"(f.bid), "+s"(f.lb), "+s"(f.G)); f.lane = f.tid & 63; f.L = (LAS unsigned char*)(uintptr_t)f.lb; return f; }
    DI float* modp() const { return (float*)(ws + WS_MODP); }
    DI float* mod() const { return (float*)(ws + WS_MOD); }
    DI float* rope() const { return (float*)(ws + WS_ROPE); }
    DI float* tokw() const { return (float*)(ws + WS_TOKW); }
    DI float* slotw() const { return (float*)(ws + WS_SLOTW); }
    DI float* gates() const { return (float*)(ws + WS_GATES); }
    DI float* mlg() const { return (float*)(ws + WS_MLG); }
    DI float* dt() const { return (float*)(ws + WS_DT); }
    DI float* decml() const { return (float*)(ws + WS_DECML); }
    DI float* decss() const { return (float*)(ws + WS_DECSS); }
    DI bf16_t* xbuf() const { return (bf16_t*)(ws + WS_XBUF); }
    DI bf16_t* stml() const { return (bf16_t*)(ws + WS_STML); }
    DI bf16_t* stss() const { return (bf16_t*)(ws + WS_STSS); }
    DI int* toke() const { return (int*)(ws + WS_TOKE); }
    DI int* tokr() const { return (int*)(ws + WS_TOKR); }
    DI int* toks() const { return (int*)(ws + WS_TOKS); }
    DI int* cnt() const { return (int*)(ws + WS_CNT); }
    DI int* mte() const { return (int*)(ws + WS_MTE); }
    DI bf16_t* rwt() const { return (bf16_t*)(ws + WS_RWT); }
    DI float* mvec() const { return (float*)(ws + WS_MVEC); }
    DI float* rstd() const { return (float*)(ws + WS_RSTD); }
    DI float* crg() const { return (float*)(ws + WS_CRG); }
    DI bf16_t* win() const { return (bf16_t*)(ws + WS_WIN); }
    DI bf16_t* wout() const { return (bf16_t*)(ws + WS_WOUT); }
    DI bf16_t* w13() const { return (bf16_t*)(ws + WS_W13); }
    DI bf16_t* w2() const { return (bf16_t*)(ws + WS_W2); }
    DI bf16_t* h() const { return (bf16_t*)(ws + WS_H); }
    DI bf16_t* proj() const { return (bf16_t*)(ws + WS_PROJ); }
    DI bf16_t* xbcc() const { return (bf16_t*)(ws + WS_XBCC); }
    DI bf16_t* mix() const { return (bf16_t*)(ws + WS_MIX); }
    DI bf16_t* amoe() const { return (bf16_t*)(ws + WS_AMOE); }
    DI bf16_t* hid() const { return (bf16_t*)(ws + WS_HID); }
    DI bf16_t* ymoe() const { return (bf16_t*)(ws + WS_YMOE); }
};

constexpr int NJ_ADA = 768, NJ_WIN = 2 * 27 * 32, NJ_WOUT = 2 * 8 * 32, NJ_W13 = 64 * 8 * 16, NJ_W2 = 64 * 8 * 8;
constexpr int NJ_TOTAL = NJ_ADA + 1 + NJ_WIN + NJ_WOUT + NJ_W13 + NJ_W2;
DI int win_col(int n) { return n < 5120 ? n : (n < 6656 ? n + 16 : (n < 6672 ? n - 1536 : (n < 6688 ? n : -1))); }

DI void cvt_fp8_job(const Params& p, const Frame& F, int j) {
    const int lane = F.lane, w = F.wave, n4 = lane & 7, kr = lane >> 3;
    LAS unsigned char* WT = F.L + w * 4608;
    const int c4 = w * 32 + n4 * 4;
    int K, ldS; const float* sp; unsigned char* dst; int n0, k0; float fs;
    if (j < NJ_W13) { const int le = j / 128, r = j % 128; const int jt = r / 16; n0 = jt * 256; k0 = (r % 16) * 128; K = 2048; ldS = 1024; fs = FS_W13;
        sp = (c4 < 128 ? p.w1 + (size_t)le * 2048 * 1024 + jt * 128 + c4 : p.w3 + (size_t)le * 2048 * 1024 + jt * 128 + (c4 - 128)) + (size_t)(k0 + 4 * kr) * ldS; dst = (unsigned char*)F.w13() + (size_t)le * 2048 * 2048; }
    else { j -= NJ_W13; const int le = j / 64, r = j % 64; n0 = (r / 8) * 256; k0 = (r % 8) * 128; K = 1024; ldS = 2048; fs = FS_W2;
        sp = p.w2 + (size_t)le * 1024 * 2048 + n0 + c4 + (size_t)(k0 + 4 * kr) * ldS; dst = (unsigned char*)F.w2() + (size_t)le * 2048 * 1024; }
    f32x4 v[4][4];
#pragma unroll
    for (int i = 0; i < 4; ++i)
#pragma unroll
        for (int r = 0; r < 4; ++r) v[i][r] = *(const f32x4*)(sp + (size_t)(32 * i + r) * ldS);
#pragma unroll
    for (int i = 0; i < 4; ++i)
#pragma unroll
        for (int c = 0; c < 4; ++c) *(LAS unsigned*)(WT + (n4 * 4 + c) * 144 + 32 * i + 4 * kr) = pk4_fp8(v[i][0][c] * fs, v[i][1][c] * fs, v[i][2][c] * fs, v[i][3][c] * fs);
    __builtin_amdgcn_wave_barrier();
#pragma unroll
    for (int i = 0; i < 4; ++i) { const int ci = lane + 64 * i, n = ci >> 3, k16 = ci & 7;
        const u32x4 o = *(LAS u32x4*)(WT + n * 144 + k16 * 16);
        *(u32x4*)(dst + (size_t)(n0 + w * 32 + n) * K + k0 + k16 * 16) = o; }
    __builtin_amdgcn_wave_barrier();
}
DI void cvt_fp8_range(const Params& p, const Frame& F, int lo, int hi, int rank, int nranks) {
    __syncthreads();
#pragma unroll 1
    for (int j = lo + rank; j < hi; j += nranks) cvt_fp8_job(p, F, j);
}
constexpr int BG4 = 3, BG6 = 7, BG7 = 7, BG1 = 8, BG15 = 3;
constexpr int BGJ_A = 4096, BGJ_B = BGJ_A + 240 * BG4, BGJ_C = BGJ_B + 240 * BG6, BGJ_D = BGJ_C + 37 * BG1, BGJ_E0 = BGJ_D + 37 * BG1, BGJ_E = BGJ_E0 + 240 * BG15;
constexpr int BGJ_W2 = NJ_W13 + NJ_W2 - 248 * BG7;
static_assert(BGJ_E <= NJ_W13, "deferred job ranges");
DI void cvt_fp8_vrange(const Params& p, const Frame& F, int lo1, int n1, int lo2, int vlo, int vhi, int rank, int nranks) {
    __syncthreads();
#pragma unroll 1
    for (int v = vlo + rank; v < vhi; v += nranks) cvt_fp8_job(p, F, v < n1 ? lo1 + v : lo2 + (v - n1));
}
DI void cvt_fp8_tail(const Params& p, const Frame& F, int lo1, int n1, int lo2, int n2, int nunits, int quota) {
    const int mtiles = nunits >> 3, nb = F.G >> 3, rounds = (mtiles * 8 + F.G - 1) / F.G, x = F.bid & 7, loc = F.bid >> 3;
    int n_idle = 0, rank = -1;
#pragma unroll 1
    for (int y = 0; y < 8; ++y) { const int U = ((((y + 1) * mtiles) >> 3) - ((y * mtiles) >> 3)) * 8; int idle = nb * rounds - U; idle = idle > nb ? nb : (idle < 0 ? 0 : idle);
        if (y == x && loc >= nb - idle) rank = n_idle + loc - (nb - idle);
        n_idle += idle; }
    int split = n_idle * quota; if (split > n1 + n2) split = n1 + n2;
    if (rank >= 0) cvt_fp8_vrange(p, F, lo1, n1, lo2, 0, split, rank, n_idle);
    cvt_fp8_vrange(p, F, lo1, n1, lo2, split, n1 + n2, F.bid, F.G);
}
constexpr int BGJ_L0B = NJ_W13 + NJ_W2 / 2, BGJ_L0A = BGJ_L0B - 384, BGJ_W2X = BGJ_W2 + 384;

DI void phase_prologue(const Params& p, const Frame& F) {
    LAS float* TL = (LAS float*)F.L;
    for (int job = F.bid; job < (DBG(64) ? 0 : NJ_ADA); job += F.G) {
        __syncthreads();
        {
            const int l = job / 384, kq = (job / 48) & 7, cb = job % 48;
            LAS float* sl = TL; LAS float* sc = TL + 512; LAS float* red = TL + 1024;
            if (F.tid < 256) { const int k = kq * 256 + F.tid; const float a = p.c[k], b = p.c_ctx[k]; sl[F.tid] = siluf(a); sc[F.tid] = siluf(b); }
            __syncthreads();
            const int cg = F.tid & 63, ks = F.tid >> 6;
            f32x4 a0 = {0.f, 0.f, 0.f, 0.f}, a1 = {0.f, 0.f, 0.f, 0.f};
            const float* wp = p.w_mod + ((size_t)l * 2048 + kq * 256 + ks * 32) * 12288 + cb * 256 + cg * 4;
#pragma unroll 16
            for (int k = 0; k < 32; ++k) { const f32x4 w = *(const f32x4*)(wp + (size_t)k * 12288); a0 += sl[ks * 32 + k] * w; a1 += sc[ks * 32 + k] * w; }
            *(LAS f32x4*)(red + (ks * 2 + 0) * 256 + cg * 4) = a0; *(LAS f32x4*)(red + (ks * 2 + 1) * 256 + cg * 4) = a1;
            __syncthreads();
            { const int which = F.tid >> 8, col = F.tid & 255; float s = 0.f;
#pragma unroll
              for (int k8 = 0; k8 < 8; ++k8) s += red[(k8 * 2 + which) * 256 + col];
              F.modp()[((size_t)(l * 8 + kq) * 2 + which) * 12288 + cb * 256 + col] = s; }
        }
    }
    for (int i = F.bid * NTHR + F.tid; i < 320 * 32; i += F.G * NTHR) { const int pos = i >> 5, f = i & 31; const int pp = pos < 256 ? pos : pos - 256;
        const float inv = expf(-logf(10000.0f) * (float)f / 32.0f); float sn, cs; sincosf((float)pp * inv, &sn, &cs);
        F.rope()[(size_t)pos * 64 + f] = cs; F.rope()[(size_t)pos * 64 + 32 + f] = sn; }
    for (int i = F.bid * NTHR + F.tid; i < 2 * 36 * 2048; i += F.G * NTHR) { const int l = i / (36 * 2048), o = (i / 2048) % 36, k = i & 2047;
        F.rwt()[i] = f2bf(o < 4 ? p.rg_w[((size_t)l * 2048 + k) * 4 + o] : p.re_w[((size_t)l * 2048 + k) * 32 + (o - 4)]); }
    __syncthreads();
    const int lane = F.lane, w = F.wave, n4 = lane & 7, kr = lane >> 3;
    LAS unsigned char* WT = F.L + w * 4608;
    const int c4 = w * 32 + n4 * 4;
#pragma unroll 1
    for (int job = F.bid; job < (DBG(128) ? 0 : NJ_WIN + NJ_WOUT); job += F.G) {
        int j = job; int kind, K, ldS; const float* s0; bf16_t* dst; int n0, k0;
        if (j < NJ_WIN) { kind = 0; const int l = j / (27 * 32), r = j % (27 * 32); n0 = (r / 32) * 256; k0 = (r % 32) * 64; K = 2048; ldS = INC; s0 = p.w_in + (size_t)l * 2048 * INC; dst = F.win() + (size_t)l * NPAD * 2048; }
        else { j -= NJ_WIN; kind = 1; const int l = j / 256, r = j % 256; n0 = (r / 32) * 256; k0 = (r % 32) * 64; K = 2048; ldS = 2048; s0 = p.w_out + (size_t)l * 2048 * 2048 + n0; dst = F.wout() + (size_t)l * 2048 * 2048; }
        const float* sp;
        if (kind == 0) { const int sc = win_col(n0 + c4); sp = sc >= 0 ? s0 + (size_t)(k0 + 2 * kr) * ldS + sc : nullptr; }
        else sp = s0 + (size_t)(k0 + 2 * kr) * ldS + c4;
        f32x4 va[4], vb[4];
#pragma unroll
        for (int i = 0; i < 4; ++i) { va[i] = sp ? *(const f32x4*)(sp + (size_t)(16 * i) * ldS) : (f32x4){0.f, 0.f, 0.f, 0.f}; vb[i] = sp ? *(const f32x4*)(sp + (size_t)(16 * i + 1) * ldS) : (f32x4){0.f, 0.f, 0.f, 0.f}; }
#pragma unroll
        for (int i = 0; i < 4; ++i)
#pragma unroll
            for (int c = 0; c < 4; ++c) *(LAS unsigned*)(WT + (n4 * 4 + c) * 144 + (16 * i + 2 * kr) * 2) = pk2(va[i][c], vb[i][c]);
        __builtin_amdgcn_wave_barrier();
#pragma unroll
        for (int i = 0; i < 4; ++i) { const int ci = lane + 64 * i, n = ci >> 3, k8 = ci & 7;
            const u32x4 o = *(LAS u32x4*)(WT + n * 144 + k8 * 16);
            *(u32x4*)(dst + (size_t)(n0 + w * 32 + n) * K + k0 + k8 * 8) = o; }
        __builtin_amdgcn_wave_barrier();
    }
    cvt_fp8_range(p, F, 0, BGJ_A, F.bid, F.G);
    cvt_fp8_range(p, F, NJ_W13, BGJ_L0A, F.bid, F.G);
}

DI float mod_from_partials(const Params& p, const Frame& F, int l, int which, int idx) {
    float s = p.b_mod[(size_t)l * 12288 + idx];
#pragma unroll
    for (int kq = 0; kq < 8; ++kq) s += F.modp()[((size_t)(l * 8 + kq) * 2 + which) * 12288 + idx];
    return s;
}

template <int MODE> DI void phase_rows(const Params& p, const Frame& F) {
    constexpr int l = MODE == 0 ? 0 : 1;
    LAS float* nw = (LAS float*)F.L; LAS float* scl = nw + 2048; LAS float* shf = scl + 4096; LAS float* g2v = shf + 4096;
    __syncthreads();
#pragma unroll 2
    for (int k4 = 0; k4 < 4; ++k4) { const int i = F.tid + NTHR * k4;
        nw[i] = MODE == 2 ? p.final_w[i] : p.norm1_w[l * 2048 + i];
        if (MODE != 2) { for (int w = 0; w < 2; ++w) { scl[w * 2048 + i] = 1.0f + mod_from_partials(p, F, l, w, 2048 + i); shf[w * 2048 + i] = mod_from_partials(p, F, l, w, i); } }
        if (MODE != 0) { for (int w = 0; w < 2; ++w) g2v[w * 2048 + i] = F.mod()[((size_t)(MODE - 1) * 2 + w) * 12288 + 5 * 2048 + i]; }
    }
    if (MODE != 2) {
        for (int i = F.bid * NTHR + F.tid; i < 2 * 12288; i += F.G * NTHR) F.mod()[(size_t)l * 2 * 12288 + i] = mod_from_partials(p, F, l, i / 12288, i % 12288);
        for (int i = F.bid * NTHR + F.tid; i < 2 * 2048; i += F.G * NTHR) F.mvec()[(size_t)l * 2 * 2048 + i] = p.norm2_w[l * 2048 + (i & 2047)] * (1.0f + mod_from_partials(p, F, l, i >> 11, 4 * 2048 + (i & 2047)));
    }
    __syncthreads();
    const int nrows = MODE == 2 ? T : NT;
    constexpr int NB = 2;
    int sl[NB][2]; float tw[NB][2];
#pragma unroll
    for (int b = 0; b < NB; ++b) { sl[b][0] = sl[b][1] = 0; tw[b][0] = tw[b][1] = 0.f;
        if (MODE != 0) { const int row = F.bid * 8 + F.wave + b * F.G * 8;
            if (row < nrows) { sl[b][0] = F.toks()[row * 2]; sl[b][1] = F.toks()[row * 2 + 1]; tw[b][0] = F.tokw()[row * 2]; tw[b][1] = F.tokw()[row * 2 + 1]; } } }
#pragma unroll 1
    for (int row0 = F.bid * 8 + F.wave; row0 < nrows; row0 += F.G * 8 * NB) {
        f32x4 v[NB][8]; bool ok[NB]; unsigned ya[NB][8], yb[NB][8];
#pragma unroll
        for (int b = 0; b < NB; ++b) { const int row = row0 + b * F.G * 8; ok[b] = row < nrows;
            if (ok[b]) {
                if (MODE == 0) { const float* src = row >= T ? p.ctx + (size_t)(row - T) * 2048 : p.x + (size_t)row * 2048;
#pragma unroll
                    for (int j = 0; j < 8; ++j) v[b][j] = *(const f32x4*)(src + j * 256 + F.lane * 4); }
                else {
#pragma unroll
                    for (int j = 0; j < 8; ++j) { const u32x2 q = *(const u32x2*)(F.xbuf() + (size_t)row * 2048 + j * 256 + F.lane * 4); v[b][j] = (f32x4){bflo(q.x), bfhi(q.x), bflo(q.y), bfhi(q.y)}; } } } }
        if (MODE != 0) {
#pragma unroll
            for (int b = 0; b < NB; ++b) if (ok[b]) { const unsigned char* y0 = (const unsigned char*)F.ymoe() + (size_t)sl[b][0] * 2048 + F.lane * 4; const unsigned char* y1 = (const unsigned char*)F.ymoe() + (size_t)sl[b][1] * 2048 + F.lane * 4;
#pragma unroll
                for (int j = 0; j < 8; ++j) { ya[b][j] = *(const unsigned*)(y0 + j * 256); yb[b][j] = *(const unsigned*)(y1 + j * 256); } } }
        int sln[NB][2]; float twn[NB][2]; float twc[NB][2];
#pragma unroll
        for (int b = 0; b < NB; ++b) { twc[b][0] = tw[b][0]; twc[b][1] = tw[b][1]; sln[b][0] = sln[b][1] = 0; twn[b][0] = twn[b][1] = 0.f;
            if (MODE != 0) { const int row = row0 + F.G * 8 * NB + b * F.G * 8;
                if (row < nrows) { sln[b][0] = F.toks()[row * 2]; sln[b][1] = F.toks()[row * 2 + 1]; twn[b][0] = F.tokw()[row * 2]; twn[b][1] = F.tokw()[row * 2 + 1]; } } }
#pragma unroll
        for (int b = 0; b < NB; ++b) { sl[b][0] = sln[b][0]; sl[b][1] = sln[b][1]; tw[b][0] = twn[b][0]; tw[b][1] = twn[b][1]; }
#pragma unroll
        for (int b = 0; b < NB; ++b) if (ok[b]) { const int row = row0 + b * F.G * 8; const int w = row >= T ? 1 : 0;
            if (MODE != 0) {
#pragma unroll
                for (int j = 0; j < 8; ++j) { const int c = j * 256 + F.lane * 4; const f32x4 g = *(LAS f32x4*)(g2v + w * 2048 + c) * (1.0f / FS_Y); v[b][j] += g * (twc[b][0] * unpk4_fp8(ya[b][j]) + twc[b][1] * unpk4_fp8(yb[b][j])); }
                if (MODE == 1) {
#pragma unroll
                    for (int j = 0; j < 8; ++j) { u32x2 q; q.x = pk2(v[b][j][0], v[b][j][1]); q.y = pk2(v[b][j][2], v[b][j][3]); *(u32x2*)(F.xbuf() + (size_t)row * 2048 + j * 256 + F.lane * 4) = q; } } }
            float ss = 0.f;
#pragma unroll
            for (int j = 0; j < 8; ++j) ss += v[b][j][0] * v[b][j][0] + v[b][j][1] * v[b][j][1] + v[b][j][2] * v[b][j][2] + v[b][j][3] * v[b][j][3];
            ss = wsum(ss);
            const float rstd = rsqrtf(ss * (1.0f / 2048.0f) + 1e-6f);
#pragma unroll
            for (int j = 0; j < 8; ++j) { const int c = j * 256 + F.lane * 4; const f32x4 nwv = *(LAS f32x4*)(nw + c);
                f32x4 o = v[b][j] * rstd * nwv;
                if (MODE == 2) *(f32x4*)(p.out + (size_t)row * 2048 + c) = o;
                else { o = o * *(LAS f32x4*)(scl + w * 2048 + c) + *(LAS f32x4*)(shf + w * 2048 + c);
                    u32x2 pk; pk.x = pk2(o[0], o[1]); pk.y = pk2(o[2], o[3]); *(u32x2*)(F.h() + (size_t)row * 2048 + c) = pk; } } }
    }
}

DI void phase_prep(const Params& p, const Frame& F, int l) {
    const int lane = F.lane;
    {   const int head = lane >> 4, half = (lane >> 3) & 1, i4 = (lane & 7) * 4;
        const int colq = MQO + head * 128 + half * 64 + i4, colk = MKO + head * 128 + half * 64 + i4;
        const float gbias = lane < 16 ? p.ml_gate_b[l * 16 + lane] : (lane < 32 ? p.dt_bias[l * 16 + lane - 16] : 0.f);
#pragma unroll 1
        for (int row0 = F.bid * 8 + F.wave; row0 < NT; row0 += F.G * 8 * 4) {
            u32x2 qa[4], qb[4], ka[4], kb[4]; f32x4 cs[4], sn[4]; float gv[4]; bool ok[4];
#pragma unroll
            for (int b = 0; b < 4; ++b) { const int row = row0 + b * F.G * 8; ok[b] = row < NT;
                if (ok[b]) { const bf16_t* pr = F.proj() + (size_t)row * NPROJ;
                    qa[b] = *(const u32x2*)(pr + colq); qb[b] = *(const u32x2*)(pr + colq + 32); ka[b] = *(const u32x2*)(pr + colk); kb[b] = *(const u32x2*)(pr + colk + 32);
                    if (row < T) { const int pos = half ? 256 + (row & 63) : (row >> 6); cs[b] = *(const f32x4*)(F.rope() + (size_t)pos * 64 + i4); sn[b] = *(const f32x4*)(F.rope() + (size_t)pos * 64 + 32 + i4); }
                    else { cs[b] = (f32x4){1.f, 1.f, 1.f, 1.f}; sn[b] = (f32x4){0.f, 0.f, 0.f, 0.f}; }
                    gv[b] = lane < 32 ? F.gates()[(size_t)row * 32 + lane] : 0.f; } }
#pragma unroll
            for (int b = 0; b < 4; ++b) if (ok[b]) { const int row = row0 + b * F.G * 8; bf16_t* pr = F.proj() + (size_t)row * NPROJ;
#pragma unroll
                for (int j = 0; j < 2; ++j) { const u32x2 a = j ? ka[b] : qa[b], bb = j ? kb[b] : qb[b]; const float sc = j ? 0.08838834764831845f : 1.0f;
                    const float x1[4] = {bflo(a.x), bfhi(a.x), bflo(a.y), bfhi(a.y)}, x2[4] = {bflo(bb.x), bfhi(bb.x), bflo(bb.y), bfhi(bb.y)}; float o1[4], o2[4];
#pragma unroll
                    for (int e = 0; e < 4; ++e) { o1[e] = (x1[e] * cs[b][e] - x2[e] * sn[b][e]) * sc; o2[e] = (x1[e] * sn[b][e] + x2[e] * cs[b][e]) * sc; }
                    u32x2 wa, wb; wa.x = pk2(o1[0], o1[1]); wa.y = pk2(o1[2], o1[3]); wb.x = pk2(o2[0], o2[1]); wb.y = pk2(o2[2], o2[3]);
                    *(u32x2*)(pr + (j ? colk : colq)) = wa; *(u32x2*)(pr + (j ? colk : colq) + 32) = wb; }
                if (lane < 16) { float v = gv[b] + gbias;
                    if ((lane >> 2) & 1) v = fminf(v, 0.f) - __logf(1.0f + __expf(-fabsf(v)));
                    F.mlg()[(size_t)row * 16 + lane] = v; }
                else if (lane < 32) { const int idx = lane - 16; const float v = gv[b] + gbias;
                    F.dt()[(size_t)row * 16 + idx] = fmaxf(v, 0.f) + __logf(1.0f + __expf(-fabsf(v))); } }
        }
    }
    { const int idx = F.bid * 8 + F.wave;
      if (idx < 72) { const int which = idx / 36, o = idx % 36; const float* sh = F.mod() + ((size_t)l * 2 + which) * 12288 + 3 * 2048; const bf16_t* wr = F.rwt() + ((size_t)l * 36 + o) * 2048; float s = 0.f;
          u32x4 wq[4]; f32x4 sa[4], sb[4];
#pragma unroll
          for (int jj = 0; jj < 4; ++jj) { const int c16 = lane + 64 * jj; wq[jj] = *(const u32x4*)(wr + c16 * 8); sa[jj] = *(const f32x4*)(sh + c16 * 8); sb[jj] = *(const f32x4*)(sh + c16 * 8 + 4); }
#pragma unroll
          for (int jj = 0; jj < 4; ++jj) { float wv[8]; unpack8(wq[jj], wv);
              const f32x4 s0 = sa[jj], s1 = sb[jj];
              s += wv[0] * s0[0] + wv[1] * s0[1] + wv[2] * s0[2] + wv[3] * s0[3] + wv[4] * s1[0] + wv[5] * s1[1] + wv[6] * s1[2] + wv[7] * s1[3]; }
          s = wsum(s); if (lane == 0) F.crg()[l * 72 + idx] = s; } }
    if (!DBG(16384))
    for (int item = F.bid * 8 + F.wave; item < (T / 8) * 2 + CTXL * 2; item += F.G * 8) {
        const bool lat = item < (T / 8) * 2; const int ci = item - (T / 8) * 2;
        const int ch = ((item & 1) * 64 + lane) * 8, nr = lat ? 8 : 1;
        const int t0 = lat ? (item >> 1) * 8 : T + (ci >> 1); const int tl0 = lat ? t0 : t0 - T, nseq = lat ? T : CTXL, rb = lat ? 0 : T;
        float wgt[4][8], bia[8];
        { const f32x4 b0 = *(const f32x4*)(p.conv_b + l * 1024 + ch), b1 = *(const f32x4*)(p.conv_b + l * 1024 + ch + 4);
          bia[0] = b0[0]; bia[1] = b0[1]; bia[2] = b0[2]; bia[3] = b0[3]; bia[4] = b1[0]; bia[5] = b1[1]; bia[6] = b1[2]; bia[7] = b1[3]; }
#pragma unroll
        for (int tap = 0; tap < 4; ++tap) { const f32x4 w0 = *(const f32x4*)(p.conv_w + ((size_t)l * 4 + tap) * 1024 + ch), w1 = *(const f32x4*)(p.conv_w + ((size_t)l * 4 + tap) * 1024 + ch + 4);
            wgt[tap][0] = w0[0]; wgt[tap][1] = w0[1]; wgt[tap][2] = w0[2]; wgt[tap][3] = w0[3]; wgt[tap][4] = w1[0]; wgt[tap][5] = w1[1]; wgt[tap][6] = w1[2]; wgt[tap][7] = w1[3]; }
        u32x4 xr[11];
#pragma unroll
        for (int r = 0; r < 11; ++r) { const int tt = tl0 + r - 2; xr[r] = (tt >= 0 && tt < nseq && r < nr + 3) ? *(const u32x4*)(F.proj() + (size_t)(rb + tt) * NPROJ + XBO + ch) : (u32x4){0u, 0u, 0u, 0u}; }
#pragma unroll
        for (int r = 0; r < 8; ++r) { float acc[8];
#pragma unroll
            for (int e = 0; e < 8; ++e) acc[e] = bia[e];
#pragma unroll
            for (int tap = 0; tap < 4; ++tap) { float xv[8]; unpack8(xr[r + tap], xv);
#pragma unroll
                for (int e = 0; e < 8; ++e) acc[e] += wgt[tap][e] * xv[e]; }
#pragma unroll
            for (int e = 0; e < 8; ++e) acc[e] = siluf(acc[e]);
            if (r < nr) *(u32x4*)(F.xbcc() + (size_t)(t0 + r) * 1024 + ch) = __builtin_bit_cast(u32x4, pack8(acc)); }
    }
}

DI void na_block64(const Params& p, LAS unsigned char* L, unsigned lb, unsigned ktA, unsigned vtA, int kbA, bool actA, const LAS float* rpA,
                   unsigned ktB, unsigned vtB, int kbB, bool actB, const LAS float* rpB, bool masked, int qc, int cs, int lane,
                   const bf16x8 (&qf)[4], f32x4 (&o)[8], float& m_run, float& l_run) {
    constexpr unsigned PB = 272, PVB = 288; const int g = lane >> 4;
    f32x4 s0 = {0.f, 0.f, 0.f, 0.f}, s1 = s0, s2 = s0, s3 = s0;
    if (actA && !DBG(8)) {
#pragma unroll
        for (int ks = 0; ks < 4; ++ks) { s0 = mfma16(frag_row(L, ktA, PB, kbA, ks * 32, lane), qf[ks], s0); s1 = mfma16(frag_row(L, ktA, PB, kbA + 16, ks * 32, lane), qf[ks], s1); } }
    if (actB && !DBG(8)) {
#pragma unroll
        for (int ks = 0; ks < 4; ++ks) { s2 = mfma16(frag_row(L, ktB, PB, kbB, ks * 32, lane), qf[ks], s2); s3 = mfma16(frag_row(L, ktB, PB, kbB + 16, ks * 32, lane), qf[ks], s3); } }
    float sv[16];
#pragma unroll
    for (int e = 0; e < 4; ++e) { sv[e] = s0[e]; sv[4 + e] = s1[e]; sv[8 + e] = s2[e]; sv[12 + e] = s3[e]; }
    if (masked) {
#pragma unroll
        for (int e = 0; e < 8; ++e) { const int kc = kbA + (e < 4 ? 4 * g + e : 16 + 4 * g + (e - 4)); const bool valid = (unsigned)(kc - cs) < 16u; const int bi = valid ? kc - qc + 15 : 0;
            const float ba = actA ? rpA[bi] : 0.f, bb = actB ? rpB[bi] : 0.f;
            sv[e] = (valid && actA) ? sv[e] + ba : -INFINITY; sv[8 + e] = (valid && actB) ? sv[8 + e] + bb : -INFINITY; } }
    float mx = sv[0];
#pragma unroll
    for (int e = 1; e < 16; ++e) mx = fmaxf(mx, sv[e]);
    mx = fmaxf(mx, __shfl_xor(mx, 16)); mx = fmaxf(mx, __shfl_xor(mx, 32));
    const float m_new = fmaxf(m_run, mx), alpha = __builtin_amdgcn_exp2f(m_run - m_new);
    float pa[8], pb[8], ps = 0.f;
#pragma unroll
    for (int e = 0; e < 8; ++e) { pa[e] = __builtin_amdgcn_exp2f(sv[e] - m_new); pb[e] = __builtin_amdgcn_exp2f(sv[8 + e] - m_new); ps += pa[e] + pb[e]; }
    l_run = l_run * alpha + ps; m_run = m_new;
    const bf16x8 pfa = pack8(pa), pfb = pack8(pb);
#pragma unroll
    for (int i = 0; i < 8; ++i) o[i] *= alpha;
    if (actA && !DBG(4)) {
#pragma unroll
        for (int hf = 0; hf < 2; ++hf) { bf16x8 vf[4]; frag_tr_x4(vf, lb, vtA, PVB, kbA + 4 * g, kbA + 16 + 4 * g, hf * 64, lane);
#pragma unroll
            for (int i = 0; i < 4; ++i) o[hf * 4 + i] = mfma16(vf[i], pfa, o[hf * 4 + i]); } }
    if (actB && !DBG(4)) {
#pragma unroll
        for (int hf = 0; hf < 2; ++hf) { bf16x8 vf[4]; frag_tr_x4(vf, lb, vtB, PVB, kbB + 4 * g, kbB + 16 + 4 * g, hf * 64, lane);
#pragma unroll
            for (int i = 0; i < 4; ++i) o[hf * 4 + i] = mfma16(vf[i], pfb, o[hf * 4 + i]); } }
}
DI void na_task(const Params& p, const Frame& F, int l, int task) {
    constexpr unsigned BUF = 71680, TIL = 35840, RPB = 143360, PB = 272, PVB = 288;
    LAS unsigned char* L = F.L; const int lane = F.lane, g = lane >> 4, n = lane & 15;
    const bool isctx = task >= 1024;
    const int r0 = isctx ? 0 : (task >> 3) * 2, head = task & 7;
    const int rsel = F.wave >> 2, qt = F.wave & 3, rw = r0 + rsel;
    const int rsA = r0 - 4 < 0 ? 0 : (r0 - 4 > 248 ? 248 : r0 - 4), rsB = r0 - 3 < 0 ? 0 : (r0 - 3 > 248 ? 248 : r0 - 3);
    const int rsw = rsel ? rsB : rsA;
    const int nwin = isctx ? 0 : rsB + 8 - rsA, nwp = (nwin + 1) >> 1;
    const int qrow = isctx ? T + ((task - 1024) >> 3) * 128 + rsel * 64 : rw * 64;
    const bf16_t* proj = F.proj();
    bf16x8 qa[4];
#pragma unroll
    for (int ks = 0; ks < 4; ++ks) qa[ks] = *(const bf16x8*)(proj + (size_t)(qrow + qt * 16 + n) * NPROJ + QO + head * 128 + ks * 32 + g * 8);
    f32x4 oa[8];
#pragma unroll
    for (int i = 0; i < 8; ++i) oa[i] = (f32x4){0.f, 0.f, 0.f, 0.f};
    float ma = -INFINITY, la = 0.f;
    const int cb = qt == 0 ? 0 : (qt == 1 ? 8 : (qt == 2 ? 24 : 32));
    const int qc = qt * 16 + n, cs = qc - 8 < 0 ? 0 : (qc - 8 > 48 ? 48 : qc - 8);
    const int nsteps = nwp + 2;
    u32x4 pre[8];
    const bf16_t* gp = proj + (size_t)(F.tid >> 4) * NPROJ + KO + head * 128 + (F.tid & 15) * 8;
    const unsigned lp = (unsigned)(F.tid >> 4) * PB + (unsigned)(F.tid & 15) * 16u, lpv = 17408u + (unsigned)(F.tid >> 4) * PVB + (unsigned)(F.tid & 15) * 16u;
#define NA_TOK(step, t) ((step) < nwp ? (rsA + ((2 * (step) + (t)) < nwin ? 2 * (step) + (t) : 2 * (step))) * 64 : T + (2 * ((step) - nwp) + (t)) * 64)
#define NA_LOAD(step) do { const bf16_t* g0_ = gp + (size_t)NA_TOK(step, 0) * NPROJ; const bf16_t* g1_ = gp + (size_t)NA_TOK(step, 1) * NPROJ; _Pragma("unroll") for (int i = 0; i < 8; ++i) \
        pre[i] = *(const u32x4*)(((i >> 2) ? g1_ : g0_) + (size_t)((i & 1) * 32) * NPROJ + ((i >> 1) & 1) * 1024); } while (0)
#define NA_STORE(bufo) do { _Pragma("unroll") for (int i = 0; i < 8; ++i) *(LAS u32x4*)(L + (bufo) + (i >> 2) * TIL + (((i >> 1) & 1) ? lpv + (i & 1) * 32 * PVB : lp + (i & 1) * 32 * PB)) = pre[i]; } while (0)
    NA_LOAD(0);
    float rpv = 0.f;
    if (!isctx && F.tid < 465) rpv = p.na_rpb[((size_t)(l * 8 + head)) * 465 + F.tid];
    __builtin_amdgcn_sched_barrier(0);
#pragma unroll
    for (int ks = 0; ks < 4; ++ks) { float qv[8]; unpack8(__builtin_bit_cast(u32x4, qa[ks]), qv);
#pragma unroll
        for (int e = 0; e < 8; ++e) qv[e] *= 0.12751743f;
        qa[ks] = pack8(qv); }
    __syncthreads();
    if (!isctx && F.tid < 465) { LAS float* rp = (LAS float*)(L + RPB); rp[F.tid] = rpv * 1.44269504f; }
#pragma unroll 1
    for (int step = 0; step < nsteps; ++step) {
        const unsigned bufo = (step & 1) * BUF;
        NA_STORE(bufo);
        if (step + 1 < nsteps && !DBG(1)) NA_LOAD(step + 1);
        __syncthreads();
        if (DBG(2)) continue;
        unsigned t0 = bufo, t1 = bufo + TIL;
        asm volatile("" : "+v"(t0), "+v"(t1));
        if (step < nwp) { const int kr0 = rsA + 2 * step, kr1 = kr0 + 1;
            const bool a0 = kr0 >= rsw && kr0 < rsw + 8, a1 = (2 * step + 1 < nwin) && kr1 >= rsw && kr1 < rsw + 8;
            const LAS float* rpw = (const LAS float*)(L + RPB);
            if (a0 || a1) na_block64(p, L, F.lb, t0, t0 + 17408, cb, a0, rpw + (a0 ? kr0 - rw + 7 : 0) * 31, t1, t1 + 17408, cb, a1, rpw + (a1 ? kr1 - rw + 7 : 0) * 31, true, qc, cs, lane, qa, oa, ma, la);
        } else {
#pragma unroll 1
            for (int tt = 0; tt < 2; ++tt) { unsigned tb = tt ? t1 : t0; asm volatile("" : "+v"(tb));
                na_block64(p, L, F.lb, tb, tb + 17408, 0, true, nullptr, tb, tb + 17408, 32, true, nullptr, false, qc, cs, lane, qa, oa, ma, la); }
        }
    }
#undef NA_TOK
#undef NA_LOAD
#undef NA_STORE
    const float inva = 1.0f / gsum4(la);
#pragma unroll
    for (int dvt = 0; dvt < 8; ++dvt) { u32x2 w; w.x = pk2(oa[dvt][0] * inva, oa[dvt][1] * inva); w.y = pk2(oa[dvt][2] * inva, oa[dvt][3] * inva);
        *(u32x2*)(F.mix() + (size_t)(qrow + qt * 16 + n) * 2048 + head * 128 + dvt * 16 + 4 * g) = w; }
}

DI void ml_state_task(const Params& p, const Frame& F, int tc, int h) {
    constexpr unsigned KT = 0, VF = 17408, VB = 34816, WF = 52224, PB = 272;
    LAS unsigned char* L = F.L; const int lane = F.lane, g = lane >> 4, n = lane & 15;
    LAS float* Wt = (LAS float*)(L + WF);
    __syncthreads();
    u32x4 fk[2], fv[2];
#pragma unroll
    for (int i = 0; i < 2; ++i) { const int ci = F.tid + NTHR * i, row = ci >> 4, c16 = ci & 15; const size_t tok = (size_t)tc * 64 + row;
        fk[i] = *(const u32x4*)(F.proj() + tok * NPROJ + MKO + h * 128 + c16 * 8); fv[i] = *(const u32x4*)(F.proj() + tok * NPROJ + MVO + h * 128 + c16 * 8); }
    __builtin_amdgcn_sched_barrier(0);
    if (F.wave < 2) { const int d = F.wave, tok = tc * 64 + lane;
        const float ig = F.mlg()[(size_t)tok * 16 + d * 8 + h], lf = F.mlg()[(size_t)tok * 16 + d * 8 + 4 + h];
        const float b = wscan(lf, d, lane); const float G = __shfl(b, d ? 0 : 63);
        Wt[d * 64 + lane] = __expf(G - b + ig);
        if (lane == 0) F.decml()[(d * 4 + h) * NCH + tc] = __expf(G); }
    __syncthreads();
#pragma unroll
    for (int i = 0; i < 2; ++i) { const int ci = F.tid + NTHR * i, row = ci >> 4, c16 = ci & 15;
        const u32x4 kv = fk[i];
        *(LAS u32x4*)(L + KT + row * PB + c16 * 16) = kv;
        float v[8], a[8], b[8]; unpack8(fv[i], v);
        const float wf = Wt[row], wb = Wt[64 + row];
#pragma unroll
        for (int e = 0; e < 8; ++e) { a[e] = v[e] * wf; b[e] = v[e] * wb; }
        *(LAS bf16x8*)(L + VF + row * PB + c16 * 16) = pack8(a); *(LAS bf16x8*)(L + VB + row * PB + c16 * 16) = pack8(b); }
    __syncthreads();
    const int w = F.wave;
    const bf16x8 k0 = frag_tr(F.lb, KT, PB, 8 * g, 8 * g + 4, 16 * w, lane), k1 = frag_tr(F.lb, KT, PB, 32 + 8 * g, 32 + 8 * g + 4, 16 * w, lane);
#pragma unroll
    for (int d = 0; d < 2; ++d) { const unsigned vt = d ? VB : VF;
        bf16_t* dst = F.stml() + ((size_t)(d * 4 + h) * NCH + tc) * 16512;
#pragma unroll 1
        for (int jh = 0; jh < 2; ++jh) { bf16x8 y0[4], y1[4];
            frag_tr_x4(y0, F.lb, vt, PB, 8 * g, 8 * g + 4, 64 * jh, lane); frag_tr_x4(y1, F.lb, vt, PB, 32 + 8 * g, 32 + 8 * g + 4, 64 * jh, lane);
#pragma unroll
            for (int q = 0; q < 4; ++q) { f32x4 acc = {0.f, 0.f, 0.f, 0.f}; acc = mfma16(k0, y0[q], acc); acc = mfma16(k1, y1[q], acc);
                u32x2 pk; pk.x = pk2(acc[0], acc[1]); pk.y = pk2(acc[2], acc[3]);
                *(u32x2*)(dst + (size_t)(64 * jh + 16 * q + n) * 128 + 16 * w + 4 * g) = pk; } } }
    if (F.tid < 256) { const int d = F.tid >> 7, dk = F.tid & 127; float sacc = 0.f;
        for (int t = 0; t < 64; ++t) sacc += Wt[d * 64 + t] * bf2f(*(LAS bf16_t*)(L + KT + t * PB + dk * 2));
        F.stml()[((size_t)(d * 4 + h) * NCH + tc) * 16512 + 16384 + dk] = f2bf(sacc); }
}

DI void ml_out_task(const Params& p, const Frame& F, int l, int tc, int h) {
    constexpr unsigned QT = 0, KT = 17408, VT = 34816, CF = 54272, CB = 93440, GA = 132608, PB = 272, PV = 304;
    LAS unsigned char* L = F.L; const int lane = F.lane, g = lane >> 4, n = lane & 15;
    LAS float* Bg = (LAS float*)(L + GA);
    LAS float* Ig = Bg + 128;
    __syncthreads();
    if (F.wave < 2) { const int d = F.wave, tok = tc * 64 + lane;
        const float ig = F.mlg()[(size_t)tok * 16 + d * 8 + h], lf = F.mlg()[(size_t)tok * 16 + d * 8 + 4 + h];
        Bg[d * 64 + lane] = wscan(lf, d, lane); Ig[d * 64 + lane] = ig; }
    if (!DBG(256)) {
    u32x4 fq[2], fk[2], fv[2], cv[2][5];
#pragma unroll
    for (int i = 0; i < 2; ++i) { const int ci = F.tid + NTHR * i, row = ci >> 4, c16 = ci & 15; const size_t tok = (size_t)tc * 64 + row;
        fq[i] = *(const u32x4*)(F.proj() + tok * NPROJ + MQO + h * 128 + c16 * 8);
        fk[i] = *(const u32x4*)(F.proj() + tok * NPROJ + MKO + h * 128 + c16 * 8);
        fv[i] = *(const u32x4*)(F.proj() + tok * NPROJ + MVO + h * 128 + c16 * 8); }
#pragma unroll
    for (int d = 0; d < 2; ++d) { const bf16_t* src = F.stml() + ((size_t)(d * 4 + h) * NCH + tc) * 16512;
#pragma unroll
        for (int i = 0; i < 4; ++i) cv[d][i] = *(const u32x4*)(src + (size_t)(F.tid + NTHR * i) * 8);
        cv[d][4] = F.tid < 16 ? *(const u32x4*)(src + (size_t)(2048 + F.tid) * 8) : (u32x4){0u, 0u, 0u, 0u}; }
    __builtin_amdgcn_sched_barrier(0);
#pragma unroll
    for (int i = 0; i < 2; ++i) { const int ci = F.tid + NTHR * i, row = ci >> 4, c16 = ci & 15;
        *(LAS u32x4*)(L + QT + row * PB + c16 * 16) = fq[i]; *(LAS u32x4*)(L + KT + row * PB + c16 * 16) = fk[i]; *(LAS u32x4*)(L + VT + row * PV + c16 * 16) = fv[i]; }
    if (F.tid < 128) { const int row = F.tid >> 1, hf = F.tid & 1; u32x4 v = {0u, 0u, 0u, 0u}; if (!hf) v.x = 0x3f80u; *(LAS u32x4*)(L + VT + row * PV + 256 + hf * 16) = v; }
#pragma unroll
    for (int d = 0; d < 2; ++d) { const unsigned ct = d ? CB : CF;
#pragma unroll
        for (int i = 0; i < 4; ++i) { const int ci = F.tid + NTHR * i; *(LAS u32x4*)(L + ct + (ci >> 4) * PB + (ci & 15) * 16) = cv[d][i]; }
        if (F.tid < 16) *(LAS u32x4*)(L + ct + 128 * PB + F.tid * 16) = cv[d][4];
        for (int i = F.tid; i < 15 * 17; i += NTHR) { const int row = 129 + i / 17, c = i % 17; *(LAS u32x4*)(L + ct + row * PB + c * 16) = (u32x4){0u, 0u, 0u, 0u}; } }
    }
    __syncthreads();
    if (DBG(512)) return;
    const int d = F.wave >> 2, qt = F.wave & 3;
    u32x2 mopf[8];
    if (d == 0) {
#pragma unroll
        for (int it = 0; it < 8; ++it) mopf[it] = *(const u32x2*)(F.proj() + ((size_t)tc * 64 + 16 * qt + n) * NPROJ + MOO + h * 128 + 16 * it + 4 * g); }
    bf16x8 qf[4];
#pragma unroll
    for (int ks = 0; ks < 4; ++ks) qf[ks] = frag_row(L, QT, PB, 16 * qt, 32 * ks, lane);
    const int t = 16 * qt + n; const float bt = Bg[d * 64 + t];
    float wv[4][4];
    { f32x4 sa[4];
#pragma unroll
      for (int st = 0; st < 4; ++st) sa[st] = (f32x4){0.f, 0.f, 0.f, 0.f};
#pragma unroll
      for (int ks = 0; ks < 4; ++ks)
#pragma unroll
        for (int st = 0; st < 4; ++st) sa[st] = mfma16(frag_row(L, KT, PB, 16 * st, 32 * ks, lane), qf[ks], sa[st]);
#pragma unroll
      for (int st = 0; st < 4; ++st) { const f32x4 bs = *(LAS f32x4*)(Bg + d * 64 + 16 * st + 4 * g), is = *(LAS f32x4*)(Ig + d * 64 + 16 * st + 4 * g);
#pragma unroll
        for (int e = 0; e < 4; ++e) { const int s = 16 * st + 4 * g + e; const bool valid = d ? (s >= t) : (s <= t);
            wv[st][e] = valid ? sa[st][e] * __expf(bt - bs[e] + is[e]) : 0.f; } } }
    f32x4 num[9];
#pragma unroll
    for (int it = 0; it < 9; ++it) num[it] = (f32x4){0.f, 0.f, 0.f, 0.f};
#pragma unroll
    for (int kk = 0; kk < 2; ++kk) {
        const bool need = d ? (2 * kk + 1 >= qt) : (2 * kk <= qt);
        if (need) { float pv[8];
#pragma unroll
            for (int e = 0; e < 4; ++e) { pv[e] = wv[2 * kk][e]; pv[4 + e] = wv[2 * kk + 1][e]; }
            const bf16x8 pf = pack8(pv);
#pragma unroll
            for (int hf = 0; hf < 2; ++hf) { bf16x8 vf[4]; frag_tr_x4(vf, F.lb, VT, PV, 32 * kk + 4 * g, 32 * kk + 16 + 4 * g, 64 * hf, lane);
#pragma unroll
                for (int q = 0; q < 4; ++q) num[hf * 4 + q] = mfma16(vf[q], pf, num[hf * 4 + q]); }
            num[8] = mfma16(frag_tr(F.lb, VT, PV, 32 * kk + 4 * g, 32 * kk + 16 + 4 * g, 128, lane), pf, num[8]); }
    }
    const unsigned ct = d ? CB : CF; const float eb = __expf(bt);
    { f32x4 ia[9];
#pragma unroll
      for (int it = 0; it < 9; ++it) ia[it] = (f32x4){0.f, 0.f, 0.f, 0.f};
#pragma unroll
      for (int ks = 0; ks < 4; ++ks)
#pragma unroll
        for (int it = 0; it < 9; ++it) ia[it] = mfma16(frag_row(L, ct, PB, 16 * it, 32 * ks, lane), qf[ks], ia[it]);
#pragma unroll
      for (int it = 0; it < 9; ++it) num[it] += eb * ia[it]; }
    const float den = __shfl(num[8][0], n);
    const float dn = 1.0f / fmaxf(fabsf(den), 1.0f);
#pragma unroll
    for (int it = 0; it < 8; ++it) num[it] *= dn;
    __syncthreads();
    LAS float* HX = (LAS float*)(L + CF);
    if (d == 1) {
#pragma unroll
        for (int it = 0; it < 8; ++it) *(LAS f32x4*)(HX + t * 132 + 16 * it + 4 * g) = num[it]; }
    __syncthreads();
    if (d == 0 && (l == 0 || tc < 256)) {
        float sm = 0.f;
#pragma unroll
        for (int it = 0; it < 8; ++it) { num[it] += *(LAS f32x4*)(HX + t * 132 + 16 * it + 4 * g); sm += num[it][0] + num[it][1] + num[it][2] + num[it][3]; }
        const float mean = gsum4(sm) * (1.0f / 128.0f); float vs = 0.f;
#pragma unroll
        for (int it = 0; it < 8; ++it) { num[it] -= mean; vs += num[it][0] * num[it][0] + num[it][1] * num[it][1] + num[it][2] * num[it][2] + num[it][3] * num[it][3]; }
        const float rstd = rsqrtf(gsum4(vs) * (1.0f / 128.0f) + 1e-6f);
        const size_t tok = (size_t)tc * 64 + t;
        f32x4 nwa[8];
#pragma unroll
        for (int it = 0; it < 8; ++it) nwa[it] = *(const f32x4*)(p.ml_norm_w + l * 512 + h * 128 + 16 * it + 4 * g);
#pragma unroll
        for (int it = 0; it < 8; ++it) { const int c = h * 128 + 16 * it + 4 * g;
            const u32x2 mo = mopf[it]; const f32x4 nwv = nwa[it];
            const float o0 = num[it][0] * rstd * nwv[0] * sigmf(bflo(mo.x)), o1 = num[it][1] * rstd * nwv[1] * sigmf(bfhi(mo.x));
            const float o2 = num[it][2] * rstd * nwv[2] * sigmf(bflo(mo.y)), o3 = num[it][3] * rstd * nwv[3] * sigmf(bfhi(mo.y));
            u32x2 w; w.x = pk2(o0, o1); w.y = pk2(o2, o3); *(u32x2*)(F.mix() + tok * 2048 + 1024 + c) = w; }
    }
}

DI void ss_state_task(const Params& p, const Frame& F, int l, int tc, int gi) {
    constexpr unsigned BT = 0, XS = 17408, WA = 91136, PB = 272, PX = 144;
    LAS unsigned char* L = F.L; const int lane = F.lane, g = lane >> 4, n = lane & 15, w = F.wave;
    LAS float* Wt = (LAS float*)(L + WA);
    const int hl = w & 3, d = w >> 2, hh = gi * 4 + hl;
    __syncthreads();
    u32x4 fb[2], fx[8];
#pragma unroll
    for (int i = 0; i < 2; ++i) { const int ci = F.tid + NTHR * i, row = ci >> 4, c16 = ci & 15; fb[i] = *(const u32x4*)(F.xbcc() + ((size_t)tc * 64 + row) * 1024 + 512 + gi * 128 + c16 * 8); }
#pragma unroll
    for (int i = 0; i < 8; ++i) { const int ci = F.tid + NTHR * i, ww = ci >> 9, row = (ci >> 3) & 63, c8 = ci & 7; fx[i] = *(const u32x4*)(F.xbcc() + ((size_t)tc * 64 + row) * 1024 + (gi * 4 + (ww & 3)) * 64 + c8 * 8); }
    __builtin_amdgcn_sched_barrier(0);
    { const int tok = tc * 64 + lane; const float dt = F.dt()[(size_t)tok * 16 + d * 8 + hh], a = -__expf(p.a_log[(l * 2 + d) * 8 + hh]);
      const float la = wscan(dt * a, d, lane); const float G = __shfl(la, d ? 0 : 63);
      Wt[w * 64 + lane] = __expf(G - la) * dt;
      if (lane == 0) F.decss()[(d * 8 + hh) * NCH + tc] = __expf(G); }
    __syncthreads();
#pragma unroll
    for (int i = 0; i < 2; ++i) { const int ci = F.tid + NTHR * i, row = ci >> 4, c16 = ci & 15;
        *(LAS u32x4*)(L + BT + row * PB + c16 * 16) = fb[i]; }
#pragma unroll
    for (int i = 0; i < 8; ++i) { const int ci = F.tid + NTHR * i, ww = ci >> 9, row = (ci >> 3) & 63, c8 = ci & 7; float v[8];
        unpack8(fx[i], v);
        const float ws = Wt[ww * 64 + row];
#pragma unroll
        for (int e = 0; e < 8; ++e) v[e] *= ws;
        *(LAS bf16x8*)(L + XS + ww * 9216 + row * PX + c8 * 16) = pack8(v); }
    __syncthreads();
    bf16_t* dst = F.stss() + ((size_t)(d * 8 + hh) * NCH + tc) * 8192;
    const unsigned xt = XS + w * 9216;
    bf16x8 x0[4], x1[4];
    frag_tr_x4(x0, F.lb, xt, PX, 8 * g, 8 * g + 4, 0, lane); frag_tr_x4(x1, F.lb, xt, PX, 32 + 8 * g, 32 + 8 * g + 4, 0, lane);
#pragma unroll 1
    for (int ih = 0; ih < 2; ++ih) { bf16x8 b0[4], b1[4];
        frag_tr_x4(b0, F.lb, BT, PB, 8 * g, 8 * g + 4, 64 * ih, lane); frag_tr_x4(b1, F.lb, BT, PB, 32 + 8 * g, 32 + 8 * g + 4, 64 * ih, lane);
#pragma unroll
        for (int q = 0; q < 4; ++q)
#pragma unroll
            for (int jt = 0; jt < 4; ++jt) { f32x4 acc = {0.f, 0.f, 0.f, 0.f}; acc = mfma16(b0[q], x0[jt], acc); acc = mfma16(b1[q], x1[jt], acc);
                u32x2 pk; pk.x = pk2(acc[0], acc[1]); pk.y = pk2(acc[2], acc[3]);
                *(u32x2*)(dst + (size_t)(16 * jt + n) * 128 + 64 * ih + 16 * q + 4 * g) = pk; } }
}

DI void ss_out_task(const Params& p, const Frame& F, int l, int tc, int gi) {
    constexpr unsigned CT = 0, BT = 17408, XT = 34816, SS = 68608, LA = 138240, DS = 140288, SQ = 142336, PB = 272, PX = 528;
    LAS unsigned char* L = F.L; const int lane = F.lane, g = lane >> 4, n = lane & 15, w = F.wave;
    LAS float* La = (LAS float*)(L + LA); LAS float* Dt = (LAS float*)(L + DS); LAS float* Sq = (LAS float*)(L + SQ);
    __syncthreads();
    u32x4 fc[2], fb[2], fx[4];
#pragma unroll
    for (int i = 0; i < 2; ++i) { const int ci = F.tid + NTHR * i, row = ci >> 4, c16 = ci & 15; const size_t tok = (size_t)tc * 64 + row;
        fc[i] = *(const u32x4*)(F.xbcc() + tok * 1024 + 768 + gi * 128 + c16 * 8); fb[i] = *(const u32x4*)(F.xbcc() + tok * 1024 + 512 + gi * 128 + c16 * 8); }
#pragma unroll
    for (int i = 0; i < 4; ++i) { const int ci = F.tid + NTHR * i, row = ci >> 5, c32 = ci & 31; fx[i] = *(const u32x4*)(F.xbcc() + ((size_t)tc * 64 + row) * 1024 + gi * 256 + c32 * 8); }
    __builtin_amdgcn_sched_barrier(0);
    { const int hl = w & 3, d = w >> 2, hh = gi * 4 + hl; const int tok = tc * 64 + lane;
      const float dt = F.dt()[(size_t)tok * 16 + d * 8 + hh], a = -__expf(p.a_log[(l * 2 + d) * 8 + hh]);
      La[w * 64 + lane] = wscan(dt * a, d, lane); Dt[w * 64 + lane] = dt; }
#pragma unroll
    for (int i = 0; i < 2; ++i) { const int ci = F.tid + NTHR * i, row = ci >> 4, c16 = ci & 15;
        *(LAS u32x4*)(L + CT + row * PB + c16 * 16) = fc[i]; *(LAS u32x4*)(L + BT + row * PB + c16 * 16) = fb[i]; }
#pragma unroll
    for (int i = 0; i < 4; ++i) { const int ci = F.tid + NTHR * i, row = ci >> 5, c32 = ci & 31;
        *(LAS u32x4*)(L + XT + row * PX + c32 * 16) = fx[i]; }
    __syncthreads();
    const int qt = w & 3, hp2 = w >> 2, t = 16 * qt + n;
    u32x2 zpf[2][4];
#pragma unroll
    for (int a = 0; a < 2; ++a)
#pragma unroll
        for (int it = 0; it < 4; ++it) zpf[a][it] = *(const u32x2*)(F.proj() + ((size_t)tc * 64 + t) * NPROJ + ZO + (gi * 4 + 2 * hp2 + a) * 64 + 16 * it + 4 * g);
    bf16x8 cf[4];
#pragma unroll
    for (int ks = 0; ks < 4; ++ks) cf[ks] = frag_row(L, CT, PB, 16 * qt, 32 * ks, lane);
    f32x4 ga[4];
#pragma unroll
    for (int st = 0; st < 4; ++st) ga[st] = (f32x4){0.f, 0.f, 0.f, 0.f};
#pragma unroll
    for (int ks = 0; ks < 4; ++ks)
#pragma unroll
        for (int st = 0; st < 4; ++st) ga[st] = mfma16(frag_row(L, BT, PB, 16 * st, 32 * ks, lane), cf[ks], ga[st]);
    f32x4 y[2][4];
#pragma unroll
    for (int a = 0; a < 2; ++a)
#pragma unroll
        for (int it = 0; it < 4; ++it) y[a][it] = (f32x4){0.f, 0.f, 0.f, 0.f};
#pragma unroll 1
    for (int d = 0; d < 2; ++d) {
        __syncthreads();
        { u32x4 sv[8];
#pragma unroll
          for (int i = 0; i < 8; ++i) { const int ci = F.tid + NTHR * i, hl = ci >> 10, r = ci & 1023; sv[i] = *(const u32x4*)(F.stss() + ((size_t)(d * 8 + gi * 4 + hl) * NCH + tc) * 8192 + (size_t)r * 8); }
#pragma unroll
          for (int i = 0; i < 8; ++i) { const int ci = F.tid + NTHR * i, hl = ci >> 10, r = ci & 1023; *(LAS u32x4*)(L + SS + hl * 17408 + (r >> 4) * PB + (r & 15) * 16) = sv[i]; } }
        __syncthreads();
#pragma unroll
        for (int a = 0; a < 2; ++a) { const int hl = 2 * hp2 + a, wi = d * 4 + hl; const float lat = La[wi * 64 + t];
            float wv[4][4];
#pragma unroll
            for (int st = 0; st < 4; ++st) { const f32x4 ls = *(LAS f32x4*)(La + wi * 64 + 16 * st + 4 * g), ds = *(LAS f32x4*)(Dt + wi * 64 + 16 * st + 4 * g);
#pragma unroll
                for (int e = 0; e < 4; ++e) { const int s = 16 * st + 4 * g + e; const bool valid = d ? (s >= t) : (s <= t);
                    wv[st][e] = valid ? ga[st][e] * __expf(lat - ls[e]) * ds[e] : 0.f; } }
            const float el = __expf(lat);
            { f32x4 ia[4];
#pragma unroll
              for (int it = 0; it < 4; ++it) ia[it] = (f32x4){0.f, 0.f, 0.f, 0.f};
#pragma unroll
              for (int ks = 0; ks < 4; ++ks)
#pragma unroll
                for (int it = 0; it < 4; ++it) ia[it] = mfma16(frag_row(L, SS + hl * 17408, PB, 16 * it, 32 * ks, lane), cf[ks], ia[it]);
#pragma unroll
              for (int it = 0; it < 4; ++it) y[a][it] += el * ia[it]; }
#pragma unroll
            for (int kk = 0; kk < 2; ++kk) { float pv[8];
#pragma unroll
                for (int e = 0; e < 4; ++e) { pv[e] = wv[2 * kk][e]; pv[4 + e] = wv[2 * kk + 1][e]; }
                const bf16x8 pf = pack8(pv);
                bf16x8 xf[4]; frag_tr_x4(xf, F.lb, XT, PX, 32 * kk + 4 * g, 32 * kk + 16 + 4 * g, hl * 64, lane);
#pragma unroll
                for (int it = 0; it < 4; ++it) y[a][it] = mfma16(xf[it], pf, y[a][it]); }
        }
    }
    const size_t tok = (size_t)tc * 64 + t; float ssq = 0.f;
#pragma unroll
    for (int a = 0; a < 2; ++a) { const int hl = 2 * hp2 + a, hh = gi * 4 + hl; const float dsk = p.ssm_d[l * 8 + hh];
#pragma unroll
        for (int it = 0; it < 4; ++it) { const int pi = 16 * it + 4 * g;
            const u32x2 xv = *(LAS u32x2*)(L + XT + t * PX + (hl * 64 + pi) * 2); const u32x2 zv = zpf[a][it];
            f32x4 v = y[a][it];
            v[0] = (v[0] + dsk * bflo(xv.x)) * siluf(bflo(zv.x)); v[1] = (v[1] + dsk * bfhi(xv.x)) * siluf(bfhi(zv.x));
            v[2] = (v[2] + dsk * bflo(xv.y)) * siluf(bflo(zv.y)); v[3] = (v[3] + dsk * bfhi(xv.y)) * siluf(bfhi(zv.y));
            y[a][it] = v; ssq += v[0] * v[0] + v[1] * v[1] + v[2] * v[2] + v[3] * v[3]; } }
    ssq = gsum4(ssq);
    if (g == 0) Sq[hp2 * 64 + t] = ssq;
    __syncthreads();
    if (l == 0 || tc < 256) {
        const float rstd = rsqrtf((Sq[t] + Sq[64 + t]) * (1.0f / 256.0f) + 1e-6f);
        f32x4 nwa[2][4];
#pragma unroll
        for (int a = 0; a < 2; ++a)
#pragma unroll
            for (int it = 0; it < 4; ++it) nwa[a][it] = *(const f32x4*)(p.ssm_norm_w + l * 512 + (gi * 4 + 2 * hp2 + a) * 64 + 16 * it + 4 * g);
#pragma unroll
        for (int a = 0; a < 2; ++a) { const int hh = gi * 4 + 2 * hp2 + a;
#pragma unroll
            for (int it = 0; it < 4; ++it) { const int c = hh * 64 + 16 * it + 4 * g; const f32x4 nwv = nwa[a][it]; const f32x4 v = y[a][it] * rstd * nwv;
                u32x2 wq; wq.x = pk2(v[0], v[1]); wq.y = pk2(v[2], v[3]); *(u32x2*)(F.mix() + tok * 2048 + 1536 + c) = wq; } }
    }
}

DI void phase_scan(const Frame& F) {
    int item;
    if (F.tid < 128) item = F.bid * 128 + F.tid; else if (F.tid == 128 && F.bid < 128) item = 32768 + F.bid; else return;
    bf16_t* base; const float* dec; int d; size_t stride;
    if (item < 16512) { const int ch = item / 2064, e = item % 2064; base = F.stml() + (size_t)ch * NCH * 16512 + e * 8; dec = F.decml() + ch * NCH; d = ch >> 2; stride = 16512; }
    else { const int it2 = item - 16512, ch = it2 >> 10, e = it2 & 1023; base = F.stss() + (size_t)ch * NCH * 8192 + e * 8; dec = F.decss() + ch * NCH; d = ch >> 3; stride = 8192; }
    float s[8];
#pragma unroll
    for (int e = 0; e < 8; ++e) s[e] = 0.f;
#pragma unroll 1
    for (int p0 = 0; p0 < NCH; p0 += 26) {
        u32x4 tmp[26]; float dc[26]; int tcs[26];
#pragma unroll
        for (int j = 0; j < 26; ++j) { const int pp = p0 + j; const int tc = d ? 259 - pp : (pp < 4 ? 256 + pp : pp - 4); tcs[j] = tc;
            tmp[j] = *(const u32x4*)(base + (size_t)tc * stride); dc[j] = dec[tc]; }
#pragma unroll
        for (int j = 0; j < 26; ++j) { *(u32x4*)(base + (size_t)tcs[j] * stride) = __builtin_bit_cast(u32x4, pack8(s)); float t[8]; unpack8(tmp[j], t);
#pragma unroll
            for (int e = 0; e < 8; ++e) s[e] = dc[j] * s[e] + t[e]; }
    }
}

DI void phase_route(const Params& p, const Frame& F, int l) {
    constexpr unsigned RP = 4112, LC = 36 * RP, MVO = LC + 128, CRO = MVO + 4096;
    LAS unsigned char* L = F.L; const int lane = F.lane, g = lane >> 4, n = lane & 15;
    LAS int* lcnt = (LAS int*)(L + LC); LAS bf16_t* MV = (LAS bf16_t*)(L + MVO); LAS float* CR = (LAS float*)(L + CRO);
    __syncthreads();
    if (!DBG(1024)) { const bf16_t* rw = F.rwt() + (size_t)l * 36 * 2048; u32x4 fv[18];
#pragma unroll
      for (int i = 0; i < 18; ++i) fv[i] = *(const u32x4*)(rw + (size_t)(F.tid + NTHR * i) * 8);
#pragma unroll
      for (int i = 0; i < 18; ++i) { const int ci = F.tid + NTHR * i; *(LAS u32x4*)(L + (ci >> 8) * RP + (ci & 255) * 16) = fv[i]; } }
    if (F.tid < 32) lcnt[F.tid] = 0;
    { float mq[4];
#pragma unroll
      for (int k4 = 0; k4 < 4; ++k4) mq[k4] = F.mvec()[(size_t)(l * 2) * 2048 + F.tid + NTHR * k4];
#pragma unroll
      for (int k4 = 0; k4 < 4; ++k4) MV[F.tid + NTHR * k4] = f2bf(mq[k4]); }
    __syncthreads();
    if (F.tid < 72) CR[F.tid] = F.crg()[l * 72 + F.tid];
    __syncthreads();
    const int nrows = l == 0 ? NT : T;
    const int r0 = (F.wave * F.G + F.bid) * 16;
    if (r0 < nrows && !DBG(4096)) {
        const int which = r0 >= T ? 1 : 0;
        f32x4 acc[3];
#pragma unroll
        for (int nt = 0; nt < 3; ++nt) acc[nt] = (f32x4){0.f, 0.f, 0.f, 0.f};
        float ssq = 0.f;
        const bf16_t* ap = F.xbuf() + (size_t)(r0 + n) * 2048 + 8 * g;
        const float* mg = F.mvec() + ((size_t)l * 2 + 1) * 2048 + 8 * g;
        const unsigned bo0 = (unsigned)n * RP + 16u * g, bo1 = (unsigned)(16 + n) * RP + 16u * g, bo2 = (unsigned)(32 + n > 35 ? 35 : 32 + n) * RP + 16u * g;
        auto step = [&](int ks, float (&xv)[8], const float (&mv)[8]) {
#pragma unroll
            for (int e = 0; e < 8; ++e) { ssq += xv[e] * xv[e]; xv[e] *= mv[e]; }
            const bf16x8 a = pack8(xv);
            acc[0] = mfma16(*(LAS bf16x8*)(L + bo0 + ks * 64), a, acc[0]); acc[1] = mfma16(*(LAS bf16x8*)(L + bo1 + ks * 64), a, acc[1]); acc[2] = mfma16(*(LAS bf16x8*)(L + bo2 + ks * 64), a, acc[2]); };
        if (!which) {
#pragma unroll 1
            for (int k0 = 0; k0 < 64; k0 += 16) { u32x4 xq[16];
#pragma unroll
                for (int j = 0; j < 16; ++j) xq[j] = *(const u32x4*)(ap + (k0 + j) * 32);
                __builtin_amdgcn_sched_barrier(0);
#pragma unroll
                for (int j = 0; j < 16; ++j) { const int ks = k0 + j; float xv[8], mv[8]; unpack8(xq[j], xv); unpack8(*(LAS u32x4*)(MV + ks * 32 + 8 * g), mv); step(ks, xv, mv); } }
        } else {
#pragma unroll 1
            for (int k0 = 0; k0 < 64; k0 += 8) { u32x4 xq[8]; f32x4 ma[8], mb[8];
#pragma unroll
                for (int j = 0; j < 8; ++j) { xq[j] = *(const u32x4*)(ap + (k0 + j) * 32); ma[j] = *(const f32x4*)(mg + (k0 + j) * 32); mb[j] = *(const f32x4*)(mg + (k0 + j) * 32 + 4); }
                __builtin_amdgcn_sched_barrier(0);
#pragma unroll
                for (int j = 0; j < 8; ++j) { float xv[8]; unpack8(xq[j], xv); const float mv[8] = {ma[j][0], ma[j][1], ma[j][2], ma[j][3], mb[j][0], mb[j][1], mb[j][2], mb[j][3]}; step(k0 + j, xv, mv); } }
        }
        const float rstd = rsqrtf(gsum4(ssq) * (1.0f / 2048.0f) + 1e-6f);
        const LAS float* cr = CR + which * 36;
        float gl[4];
#pragma unroll
        for (int r = 0; r < 4; ++r) gl[r] = rstd * __shfl(acc[0][r], n) + cr[r] + p.rg_b[l * 4 + r];
        int gs = 0; float gm = gl[0];
#pragma unroll
        for (int o = 1; o < 4; ++o) { if (gl[o] > gm) { gm = gl[o]; gs = o; } }
        float gden = 0.f;
#pragma unroll
        for (int o = 0; o < 4; ++o) gden += __expf(gl[o] - gm);
        const float gw = 1.0f / gden;
        float le[8];
#pragma unroll
        for (int i = 0; i < 8; ++i) { const int o = 4 + 8 * gs + i, nt = o >> 4, src = n + 16 * ((o >> 2) & 3);
            const float t0 = __shfl(acc[0][i & 3], src), t1 = __shfl(acc[1][i & 3], src), t2 = __shfl(acc[2][i & 3], src);
            le[i] = rstd * (nt == 0 ? t0 : (nt == 1 ? t1 : t2)) + cr[o] + p.re_b[l * 32 + gs * 8 + i]; }
        int i1 = 0; float v1 = le[0];
#pragma unroll
        for (int i = 1; i < 8; ++i) if (le[i] > v1) { v1 = le[i]; i1 = i; }
        int i2 = -1; float v2 = -INFINITY;
#pragma unroll
        for (int i = 0; i < 8; ++i) if (i != i1 && le[i] > v2) { v2 = le[i]; i2 = i; }
        const float w1 = 1.0f / (1.0f + __expf(v2 - v1)), w2 = 1.0f - w1;
        if (g == 0) { const int row = r0 + n, e1 = gs * 8 + i1, e2 = gs * 8 + i2;
            const int r1 = atomicAdd((int*)(lcnt + e1), 1), r2 = atomicAdd((int*)(lcnt + e2), 1);
            F.toke()[row * 2] = e1; F.toke()[row * 2 + 1] = e2; F.tokw()[row * 2] = w1 * gw; F.tokw()[row * 2 + 1] = w2 * gw; F.tokr()[row * 2] = r1; F.tokr()[row * 2 + 1] = r2;
            F.rstd()[row] = rstd; }
    }
    __syncthreads();
    if (F.tid < 32) F.cnt()[F.bid * 32 + F.tid] = lcnt[F.tid];
}

DI void phase_slot(const Params& p, const Frame& F, int l) {
    LAS int* tot = (LAS int*)F.L; LAS int* pre = tot + 32; LAS int* pst = tot + 64; LAS int* pend = tot + 96; LAS int* part = tot + 128;
    __syncthreads();
    { const int e = F.tid & 31, pt = F.tid >> 5; int t = 0, pr = 0;
      int cq[16];
#pragma unroll
      for (int j = 0; j < 16; ++j) cq[j] = F.cnt()[(pt * 16 + j) * 32 + e];
      __builtin_amdgcn_sched_barrier(0);
#pragma unroll
      for (int j = 0; j < 16; ++j) { const int b = pt * 16 + j, c = cq[j]; t += c; pr += (b < F.bid) ? c : 0; }
      part[(pt * 2) * 32 + e] = t; part[(pt * 2 + 1) * 32 + e] = pr; }
    __syncthreads();
    if (F.tid < 32) { int t = 0, pr = 0; for (int pt = 0; pt < 16; ++pt) { t += part[(pt * 2) * 32 + F.tid]; pr += part[(pt * 2 + 1) * 32 + F.tid]; } tot[F.tid] = t; pre[F.tid] = pr; }
    __syncthreads();
    if (F.tid == 0) { int acc = 0; for (int e = 0; e < 32; ++e) { pst[e] = acc; acc += (tot[e] + 255) & ~255; pend[e] = acc; } }
    __syncthreads();
    if (F.bid == 0 && F.tid == 0) { int idx = 0; for (int e = 0; e < 32; ++e) { const int nt = (pend[e] - pst[e]) >> 8; for (int k = 0; k < nt; ++k) F.mte()[idx++] = e; } F.mte()[MAXMT] = idx; }
    const int nrows = l == 0 ? NT : T;
#pragma unroll 1
    for (int pass = 0; pass < 2; ++pass) {
      const int r0 = (((F.wave & 3) + 4 * pass) * F.G + F.bid) * 16 + (F.wave >> 2) * 8;
      if (r0 < nrows) {
        const int which = r0 >= T ? 1 : 0;
        const float* mp = F.mvec() + ((size_t)l * 2 + which) * 2048; const float* sp = F.mod() + ((size_t)l * 2 + which) * 12288 + 3 * 2048;
        float mv[2][16], sv[2][16];
#pragma unroll
        for (int j = 0; j < 2; ++j)
#pragma unroll
            for (int q = 0; q < 4; ++q) { const f32x4 a = *(const f32x4*)(mp + j * 1024 + F.lane * 16 + q * 4), b = *(const f32x4*)(sp + j * 1024 + F.lane * 16 + q * 4);
#pragma unroll
                for (int e = 0; e < 4; ++e) { mv[j][q * 4 + e] = a[e] * FS_X; sv[j][q * 4 + e] = b[e] * FS_X; } }
        int s1v = 0, s2v = 0; float rsv = 0.f;
        if (F.lane < 8) { const int row = r0 + F.lane; const int e1 = F.toke()[row * 2], e2 = F.toke()[row * 2 + 1];
            s1v = pst[e1] + pre[e1] + F.tokr()[row * 2]; s2v = pst[e2] + pre[e2] + F.tokr()[row * 2 + 1]; rsv = F.rstd()[row];
            F.toks()[row * 2] = s1v; F.toks()[row * 2 + 1] = s2v; }
        const bf16_t* __restrict__ xb = F.xbuf() + (size_t)r0 * 2048 + F.lane * 16;
        unsigned char* __restrict__ am = (unsigned char*)F.amoe() + F.lane * 16;
#pragma unroll 1
        for (int rb = 0; rb < 8; rb += 4) {
            u32x4 xr[4][4];
#pragma unroll
            for (int q = 0; q < 4; ++q)
#pragma unroll
                for (int j = 0; j < 2; ++j) { xr[q][2 * j] = *(const u32x4*)(xb + (size_t)(rb + q) * 2048 + j * 1024); xr[q][2 * j + 1] = *(const u32x4*)(xb + (size_t)(rb + q) * 2048 + j * 1024 + 8); }
#pragma unroll
            for (int q = 0; q < 4; ++q) { const int rr = rb + q; const int s1 = __shfl(s1v, rr), s2 = __shfl(s2v, rr); const float rs = __shfl(rsv, rr);
#pragma unroll
                for (int j = 0; j < 2; ++j) { float a[8], b[8]; unpack8(xr[q][2 * j], a); unpack8(xr[q][2 * j + 1], b);
#pragma unroll
                    for (int e = 0; e < 8; ++e) { a[e] = a[e] * rs * mv[j][e] + sv[j][e]; b[e] = b[e] * rs * mv[j][8 + e] + sv[j][8 + e]; }
                    u32x4 v; v.x = pk4_fp8(a[0], a[1], a[2], a[3]); v.y = pk4_fp8(a[4], a[5], a[6], a[7]); v.z = pk4_fp8(b[0], b[1], b[2], b[3]); v.w = pk4_fp8(b[4], b[5], b[6], b[7]);
                    *(u32x4*)(am + (size_t)s1 * 2048 + j * 1024) = v; *(u32x4*)(am + (size_t)s2 * 2048 + j * 1024) = v; } } }
      }
    }
    { const int e = F.bid >> 3, part8 = F.bid & 7;
      unsigned zz = 0u; asm volatile("" : "+v"(zz)); const u32x4 zv = {zz, zz, zz, zz};
      if (e < 32) for (int s = pst[e] + tot[e] + part8 * 8 + F.wave; s < pend[e]; s += 64) {
#pragma unroll
          for (int j = 0; j < 2; ++j) *(u32x4*)((unsigned char*)F.amoe() + (size_t)s * 2048 + j * 1024 + F.lane * 16) = zv; } }
}

__global__ void __launch_bounds__(NTHR, 2) fwd_kernel(Params p) {
    extern __shared__ __attribute__((aligned(16))) unsigned char lds_raw[];
    Frame F;
    F.L = (LAS unsigned char*)lds_raw; F.lb = (unsigned)(uintptr_t)F.L;
    F.tid = threadIdx.x; F.lane = F.tid & 63; F.wave = __builtin_amdgcn_readfirstlane(F.tid >> 6); F.bid = blockIdx.x; F.G = gridDim.x;
    unsigned char* ws = p.ws; F.ws = ws;

    volatile LAS unsigned* xbw = (volatile LAS unsigned*)(F.L + LDS_MISC);
    if (F.tid == 0) { xbw[0] = 0u; xbw[1] = 0u; }
    __syncthreads();
    const int lo = p.ph_lo, hi = p.ph_hi;
    const bool multi = (hi - lo) > 1;
    XcdBarrier bar; bar.bar = (unsigned*)(ws + WS_BAR); bar.x = 0; bar.st = xbw;
    if (multi) bar = xcd_barrier_post((unsigned*)(ws + WS_BAR), xbw);
#ifndef PH_MASK
#define PH_MASK 0xFFF
#endif
#ifndef TM
#define TM (p.tmask)
#endif
#define IN(k) (lo <= (k) && (k) < hi)
#define ON(j) (((PH_MASK) >> (j)) & 1)
#ifdef PROBE_LIST
    unsigned long long* tsp = (unsigned long long*)(ws + 57344);
    if (multi && F.bid == 0 && F.tid == 0) tsp[0] = __builtin_amdgcn_s_memrealtime();
    if (lo == 31 && F.bid == 0 && F.tid == 0) { const unsigned long long d = tsp[p.pad + 1] - tsp[p.pad], t0 = __builtin_amdgcn_s_memrealtime();
        while (__builtin_amdgcn_s_memrealtime() - t0 < d) __builtin_amdgcn_s_sleep(8); }
#define SEAM(k) do { if (IN(k) && IN((k) + 1)) { xcd_barrier(bar); if (F.bid == 0 && F.tid == 0) tsp[(k) + 1] = __builtin_amdgcn_s_memrealtime(); } } while (0)
#else
#define SEAM(k) do { if (IN(k) && IN((k) + 1)) xcd_barrier(bar); } while (0)
#endif

    if (ON(0) && IN(0)) { phase_prologue(p, F.fresh()); } SEAM(0);
#ifdef EXTRA_BARRIERS
    if (hi - lo > 1) for (int eb = 0; eb < EXTRA_BARRIERS; ++eb) xcd_barrier(bar);
#endif
    for (int l = 0; l < 2; ++l) {
        const int pb = 1 + 11 * l;
        if (ON(1) && IN(pb + 0)) { if (l == 0) phase_rows<0>(p, F.fresh()); else phase_rows<1>(p, F.fresh()); } SEAM(pb + 0);
        if (ON(2) && IN(pb + 1)) {
            pg8::Gemm g{F.h(), F.win() + (size_t)l * NPAD * 2048, NT, NPAD, 2048}; pg8::StaticOrder S; S.init(NT, NPAD, F.G, F.bid);
            pg8::EpiProj E{F.proj(), F.gates()};
            pg8::gemm_phase<pg8::EpiProj, pg8::StaticOrder>(F.L, g, S, E, nullptr);
            if (F.bid >= 219 && BG1 > 0) cvt_fp8_range(p, F.fresh(), l == 0 ? BGJ_C : BGJ_D, l == 0 ? BGJ_D : BGJ_E0, F.bid - 219, 37);
        } SEAM(pb + 1);
        if (ON(3) && IN(pb + 2)) { phase_prep(p, F.fresh(), l); } SEAM(pb + 2);
        if (ON(4) && IN(pb + 3)) {
            const Frame Fq = F.fresh(); const int ntask = l == 0 ? 1040 : 1024;
            if (TM & 1) for (int t = F.bid; t < ntask; t += F.G) na_task(p, Fq, l, t);
            if (TM & 2) for (int t = F.bid; t < NCH * 4; t += F.G) ml_state_task(p, Fq, t >> 2, t & 3);
            if (TM & 4) for (int t = F.bid; t < NCH * 2; t += F.G) ss_state_task(p, Fq, l, t >> 1, t & 1);
            if (F.bid >= 16) cvt_fp8_range(p, Fq, l == 0 ? BGJ_A : BGJ_E0, l == 0 ? BGJ_B : BGJ_E, F.bid - 16, 240);
        } SEAM(pb + 3);
        if (ON(5) && IN(pb + 4)) { phase_scan(F.fresh()); } SEAM(pb + 4);
        if (ON(6) && IN(pb + 5)) {
            const Frame Fq = F.fresh(); const int nc = l == 0 ? NCH : 256;
            if (TM & 8) for (int t = F.bid; t < nc * 4; t += F.G) ml_out_task(p, Fq, l, t >> 2, t & 3);
            if (TM & 16) for (int t = F.bid; t < nc * 2; t += F.G) ss_out_task(p, Fq, l, t >> 1, t & 1);
            if (l == 0 && F.bid >= 16) cvt_fp8_range(p, Fq, BGJ_B, BGJ_C, F.bid - 16, 240);
        } SEAM(pb + 5);
        if (ON(7) && IN(pb + 6)) {
            const int M = l == 0 ? NT : T;
            pg8::Gemm g{F.mix(), F.wout() + (size_t)l * 2048 * 2048, M, 2048, 2048}; pg8::StaticOrder S; S.init(M, 2048, F.G, F.bid);
            const float* gl = F.mod() + ((size_t)l * 2 + 0) * 12288 + 2 * 2048; const float* gc = F.mod() + ((size_t)l * 2 + 1) * 12288 + 2 * 2048;
            if (l == 0) { pg8::EpiRes<true> E{p.x, p.ctx, F.xbuf(), gl, gc}; pg8::gemm_phase<pg8::EpiRes<true>, pg8::StaticOrder>(F.L, g, S, E, nullptr);
                if (F.bid >= 8) cvt_fp8_vrange(p, F.fresh(), BGJ_L0A, 384, BGJ_W2X, 0, 384 + NJ_W13 + NJ_W2 - BGJ_W2X, F.bid - 8, 248); }
            else { pg8::EpiRes<false> E{nullptr, nullptr, F.xbuf(), gl, gc}; pg8::gemm_phase<pg8::EpiRes<false>, pg8::StaticOrder>(F.L, g, S, E, nullptr); }
        } SEAM(pb + 6);
        if (ON(8) && IN(pb + 7)) { phase_route(p, F.fresh(), l); } SEAM(pb + 7);
        if (ON(9) && IN(pb + 8)) { phase_slot(p, F.fresh(), l); } SEAM(pb + 8);
        if (ON(10) && IN(pb + 9)) {
            pg8::Gemm g{F.amoe(), (const bf16_t*)((const unsigned char*)F.w13() + (size_t)l * NEXP * 2048 * 2048), NSLOT, 2048, 2048};
            pg8::MoeOrder S{F.mte(), F.mte()[MAXMT] * 8, F.G, F.bid};
            pg8::EpiGateUp E{(unsigned char*)F.hid()};
            pg8::gemm_phase<pg8::EpiGateUp, pg8::MoeOrder, false, 1, SC_W13, SC_X>(F.L, g, S, E, nullptr);
            if (l == 0) cvt_fp8_tail(p, F.fresh(), BGJ_E, NJ_W13 - BGJ_E, 0, 0, F.mte()[MAXMT] * 8, 5);
            else cvt_fp8_tail(p, F.fresh(), BGJ_W2, BGJ_W2X - BGJ_W2, 0, 0, F.mte()[MAXMT] * 8, 5);
        } SEAM(pb + 9);
        if (ON(11) && IN(pb + 10)) {
            pg8::Gemm g{F.hid(), (const bf16_t*)((const unsigned char*)F.w2() + (size_t)l * NEXP * 2048 * 1024), NSLOT, 2048, 1024};
            pg8::MoeOrder S{F.mte(), F.mte()[MAXMT] * 8, F.G, F.bid};
            pg8::EpiDown E{(unsigned char*)F.ymoe(), F.slotw()};
            pg8::gemm_phase<pg8::EpiDown, pg8::MoeOrder, false, 1, SC_W2, SC_X2>(F.L, g, S, E, nullptr);
            if (l == 0) cvt_fp8_tail(p, F.fresh(), NJ_W13 + NJ_W2 / 2, BGJ_W2 - (NJ_W13 + NJ_W2 / 2), 0, 0, F.mte()[MAXMT] * 8, 4);
        } SEAM(pb + 10);
    }
    if (ON(1) && IN(23)) { phase_rows<2>(p, F.fresh()); }
#undef IN
#undef SEAM
}

constexpr int NPHASE = 24;
#ifndef N_LAUNCH_MODE
#define N_LAUNCH_MODE 1
#endif

extern "C" void kernel_launch(void* const* d_in, const int* in_sizes, int n_in, void* d_out, int out_size, void* d_ws, size_t ws_size, hipStream_t stream) {
    static int grid = 0;
    if (grid == 0) {
        if (n_in != 27 || ws_size < WS_END) { fprintf(stderr, "kernel_launch: unexpected inputs (n_in %d) or workspace %zu < %zu\n", n_in, ws_size, (size_t)WS_END); grid = -1; return; }
        int dev = 0, cus = 0, per_cu = 0;
        hipGetDevice(&dev); hipDeviceGetAttribute(&cus, hipDeviceAttributeMultiprocessorCount, dev);
        if (hipFuncSetAttribute((const void*)fwd_kernel, hipFuncAttributeMaxDynamicSharedMemorySize, LDS_BYTES) != hipSuccess) { fprintf(stderr, "kernel_launch: hipFuncSetAttribute failed\n"); grid = -1; return; }
        hipOccupancyMaxActiveBlocksPerMultiprocessor(&per_cu, (const void*)fwd_kernel, NTHR, LDS_BYTES);
        (void)hipGetLastError();
        if (cus < 256 || per_cu < 1) { fprintf(stderr, "kernel_launch: needs 256 CUs with one resident workgroup each (cus %d, per_cu %d)\n", cus, per_cu); grid = -1; return; }
        grid = 256;
    }
    if (grid < 0) return;
    hipMemsetAsync((char*)d_ws + WS_BAR, 0, 65536, stream);
    Params p{};
    const float** pp = (const float**)&p;
    for (int i = 0; i < 27; ++i) pp[i] = (const float*)d_in[i];
    p.out = (float*)d_out; p.ws = (unsigned char*)d_ws;
#if N_LAUNCH_MODE == 1
    p.ph_lo = 0; p.ph_hi = NPHASE; p.tmask = 31; p.pad = 0;
    hipLaunchKernelGGL(fwd_kernel, dim3(grid), dim3(NTHR), LDS_BYTES, stream, p);
#ifdef PROBE_LIST
    { const int pl[] = PROBE_LIST; for (int pv : pl) { const int ph = pv & 255; p.tmask = ((pv >> 8) & 255) ? ((pv >> 8) & 255) : 31; p.pad = pv >> 16; p.ph_lo = ph; p.ph_hi = ph + 1; hipLaunchKernelGGL(fwd_kernel, dim3(grid), dim3(NTHR), LDS_BYTES, stream, p); } }
#endif
#else
    p.tmask = 31; p.pad = 0; for (int ph = 0; ph < NPHASE; ++ph) { p.ph_lo = ph; p.ph_hi = ph + 1; hipLaunchKernelGGL(fwd_kernel, dim3(grid), dim3(NTHR), LDS_BYTES, stream, p); }
#endif
}
```
